# Optimizing an MI355X kernel written in HIP

```python
import jax, jax.numpy as jnp
from jax import lax
import numpy as np

D_MODEL = 1024
BATCH = 4
SEQ = 8192
DEPTH = 4

CHUNK = 64
D_MIX = D_MODEL
D_A = D_MIX // 2
D_B = D_MIX - D_A
A_HEADS = 4
A_BLOCK = 128
A_HEAD_DIM = D_A // A_HEADS
B_HEADS = 4
B_DK = D_B // 2
B_DV = D_B
B_HEAD_K = B_DK // B_HEADS
B_HEAD_V = B_DV // B_HEADS
B_GATE_RANK = 16
B_GATE_TAU = 16.0
D_FF = 4 * D_MODEL
D_IN = 2 * D_A + 2 * B_DK + 2 * B_DV + B_GATE_RANK
EPS = 1e-6

kernel_name = "hybrid_gmlp_gla_sqrelu_sandwich"


def rmsnorm(x, g):
    xf = x.astype(jnp.float32)
    xf = xf * lax.rsqrt(jnp.mean(xf * xf, axis=-1, keepdims=True) + EPS)
    return (xf * g.astype(jnp.float32)).astype(x.dtype)


def layernorm(x, g, b):
    xf = x.astype(jnp.float32)
    mu = jnp.mean(xf, axis=-1, keepdims=True)
    xc = xf - mu
    xf = xc * lax.rsqrt(jnp.mean(xc * xc, axis=-1, keepdims=True) + EPS)
    return (xf * g.astype(jnp.float32) + b.astype(jnp.float32)).astype(x.dtype)


def gmlp_mixer(zu, zv, ln_g, ln_b, ws, bs, out_g):
    bsz, s, _ = zu.shape
    u = jax.nn.gelu(zu)
    v = layernorm(jax.nn.gelu(zv), ln_g, ln_b)
    n_blk = s // A_BLOCK
    v = v.reshape(bsz, n_blk, A_BLOCK, A_HEADS, A_HEAD_DIM)
    pos = jnp.arange(A_BLOCK) // CHUNK
    mask = pos[:, None] >= pos[None, :]
    w = jnp.where(mask[None], ws, jnp.zeros_like(ws))
    mixed = jnp.einsum('hij,bnjhc->bnihc', w, v) + jnp.transpose(bs)[None, None, :, :, None]
    out = u * mixed.reshape(bsz, s, D_A)
    return rmsnorm(out, out_g)


def gla_mixer(zq, zk, zv, zg, zlr, gate_w, gate_b, out_g):
    dt = zq.dtype
    bsz, s, _ = zq.shape
    n_c = s // CHUNK
    f32 = jnp.float32
    q = zq.astype(f32) * (B_HEAD_K ** -0.5)
    k = zk.astype(f32)
    v = zv.astype(f32)
    log_a = jax.nn.log_sigmoid(zlr.astype(f32) @ gate_w.astype(f32) + gate_b.astype(f32)) / B_GATE_TAU

    def to_chunks(t, d):
        return jnp.transpose(t.reshape(bsz, n_c, CHUNK, B_HEADS, d), (0, 3, 1, 2, 4))

    q, k, log_a = to_chunks(q, B_HEAD_K), to_chunks(k, B_HEAD_K), to_chunks(log_a, B_HEAD_K)
    v = to_chunks(v, B_HEAD_V)
    cum = jnp.cumsum(log_a, axis=-2)
    last = cum[..., -1:, :]
    qe = q * jnp.exp(cum)
    ke = k * jnp.exp(-cum)
    kd = k * jnp.exp(last - cum)

    tril = jnp.tril(jnp.ones((CHUNK, CHUNK), dtype=bool))
    scores = jnp.einsum('bhnid,bhnjd->bhnij', qe, ke)
    scores = jnp.where(tril, scores, 0.0)
    o_intra = jnp.einsum('bhnij,bhnjv->bhniv', scores, v)

    upd = jnp.einsum('bhnjd,bhnjv->bhndv', kd, v)
    dec = jnp.exp(last[..., 0, :])

    def step(state, inp):
        d_c, u_c = inp
        return d_c[..., None] * state + u_c, state

    s0 = jnp.zeros((bsz, B_HEADS, B_HEAD_K, B_HEAD_V), f32)
    _, s_prev = lax.scan(step, s0, (jnp.moveaxis(dec, 2, 0), jnp.moveaxis(upd, 2, 0)))
    s_prev = jnp.moveaxis(s_prev, 0, 2)
    o_inter = jnp.einsum('bhnid,bhndv->bhniv', qe, s_prev)

    o = jnp.transpose(o_intra + o_inter, (0, 2, 3, 1, 4))
    o = o.reshape(bsz, s, B_HEADS, B_HEAD_V)
    o = rmsnorm(o, out_g.reshape(B_HEADS, B_HEAD_V)).reshape(bsz, s, B_DV)
    return (o * jax.nn.silu(zg.astype(f32))).astype(dt)


def setup_inputs(seed: int = 0) -> dict:
    key = jax.random.key(seed)
    ks = jax.random.split(key, 20)
    n = jax.random.normal

    def gain(k, d):
        return 1.0 + 0.05 * n(k, (DEPTH, d), jnp.float32)

    return {
        "x": n(ks[0], (BATCH, SEQ, D_MODEL), jnp.float32),
        "pre_mix_g": gain(ks[1], D_MODEL),
        "w_in": n(ks[2], (DEPTH, D_MODEL, D_IN), jnp.float32) * D_MODEL ** -0.5,
        "gmlp_ln_g": gain(ks[3], D_A),
        "gmlp_ln_b": 0.02 * n(ks[4], (DEPTH, D_A), jnp.float32),
        "gmlp_ws": n(ks[5], (DEPTH, A_HEADS, A_BLOCK, A_BLOCK), jnp.float32) * A_BLOCK ** -0.5,
        "gmlp_bs": 1.0 + 0.1 * n(ks[6], (DEPTH, A_HEADS, A_BLOCK), jnp.float32),
        "gmlp_out_g": gain(ks[7], D_A),
        "gla_gate_w": n(ks[8], (DEPTH, B_GATE_RANK, B_DK), jnp.float32) * B_GATE_RANK ** -0.5,
        "gla_gate_b": 0.5 * n(ks[9], (DEPTH, B_DK), jnp.float32),
        "gla_out_g": gain(ks[10], B_DV),
        "w_out": n(ks[11], (DEPTH, D_MIX, D_MODEL), jnp.float32) * D_MIX ** -0.5,
        "post_mix_g": gain(ks[12], D_MODEL),
        "pre_ff_g": gain(ks[13], D_MODEL),
        "w_ff1": n(ks[14], (DEPTH, D_MODEL, D_FF), jnp.float32) * D_MODEL ** -0.5,
        "w_ff2": n(ks[15], (DEPTH, D_FF, D_MODEL), jnp.float32) * D_FF ** -0.5,
        "post_ff_g": gain(ks[16], D_MODEL),
    }


def reference(x, pre_mix_g, w_in, gmlp_ln_g, gmlp_ln_b, gmlp_ws, gmlp_bs, gmlp_out_g,
              gla_gate_w, gla_gate_b, gla_out_g, w_out, post_mix_g, pre_ff_g,
              w_ff1, w_ff2, post_ff_g):
    cuts = [D_A, 2 * D_A, 2 * D_A + B_DK, 2 * D_A + 2 * B_DK,
            2 * D_A + 2 * B_DK + B_DV, 2 * D_A + 2 * B_DK + 2 * B_DV]
    h = x
    for l in range(DEPTH):
        y = rmsnorm(h, pre_mix_g[l])
        z = y @ w_in[l]
        zu, zv, zq, zk, zvb, zg, zlr = jnp.split(z, cuts, axis=-1)
        a = gmlp_mixer(zu, zv, gmlp_ln_g[l], gmlp_ln_b[l], gmlp_ws[l], gmlp_bs[l], gmlp_out_g[l])
        b = gla_mixer(zq, zk, zvb, zg, zlr, gla_gate_w[l], gla_gate_b[l], gla_out_g[l])
        m = jnp.concatenate([a, b], axis=-1) @ w_out[l]
        h = h + rmsnorm(m, post_mix_g[l])
        f = rmsnorm(h, pre_ff_g[l]) @ w_ff1[l]
        f = jnp.square(jax.nn.relu(f)) @ w_ff2[l]
        h = h + rmsnorm(f, post_ff_g[l])
    return h
```

```cpp
#include <hip/hip_runtime.h>
#include <hip/hip_cooperative_groups.h>
#include <cstdio>
#include <cstdint>
namespace cg = cooperative_groups;
namespace pg8 {
#define PG8_LAS __attribute__((address_space(3)))
typedef unsigned short bf16_t;
typedef short bf16x8 __attribute__((ext_vector_type(8)));
typedef float f32x4 __attribute__((ext_vector_type(4)));
typedef unsigned u32x4 __attribute__((ext_vector_type(4)));
constexpr int BM = 256, BK = 64, HALF = 128, HTB = HALF * BK * 2  , STAGE_BYTES = 8 * HTB, NXCD = 8, WGM = 8;

__host__ __device__ __forceinline__ int lds_byte(int r, int c) { const int st = (r >> 4) * 2 + (c >> 5), rr = r & 15, cc = c & 31, ob = rr * 64 + cc * 2; return st * 1024 + (ob ^ (((ob >> 9) & 1) << 5)); }
__host__ __device__ __forceinline__ void stage_rc(int b, int& R, int& C) { const int st = b / 1024, sb = b % 1024, swz = sb ^ (((sb >> 9) & 1) << 5); R = (st >> 1) * 16 + swz / 64; C = (st & 1) * 32 + (swz % 64) / 2; }
__host__ __device__ __forceinline__ int perm32(int rho) { const int n = rho >> 4, i = rho & 15; return 8 * (i >> 2) + 4 * n + (i & 3); }

struct Unit { int pm, pn; };
struct Gemm { const bf16_t* A; const bf16_t* Bt; int M, N, K; };

struct StaticOrder {
    int nM, nN, nwg, G, c;
    __host__ __device__ void init(int M, int N, int G_, int c_) { nM = M / BM; nN = N / BM; nwg = nM * nN; G = G_; c = c_; }
    __host__ __device__ bool next(int i, Unit& u) const {
        const long L = (long)i * G + c; if (L >= nwg) return false;
        int wgid = (int)L; { const int q = nwg / NXCD, r = nwg % NXCD, xcd = wgid % NXCD, off = wgid / NXCD; wgid = (xcd < r ? xcd * (q + 1) : r * (q + 1) + (xcd - r) * q) + off; }
        const int nig = WGM * nN, gid = wgid / nig, fm = gid * WGM, gsz = (nM - fm) < WGM ? (nM - fm) : WGM;
        u.pm = fm + ((wgid % nig) % gsz); u.pn = (wgid % nig) / gsz; return true;
    }
    __device__ __forceinline__ void a_ready(const Unit&) const {}
    __device__ __forceinline__ void done(const Unit&) const {}
};

typedef __bf16 hwbf2e __attribute__((ext_vector_type(2)));
typedef float hwf2e __attribute__((ext_vector_type(2)));
__device__ __forceinline__ unsigned cvt_pk_bf16(float lo, float hi) { const hwf2e v = {lo, hi}; return __builtin_bit_cast(unsigned, __builtin_convertvector(v, hwbf2e)); }
__device__ __forceinline__ float gelu_tanh(float x) {
    const float u = x * (0.7978845608028654f + 0.035677408136300125f * x * x);
    const float e = __builtin_amdgcn_exp2f(u * -2.885390081777927f);
    return x * __builtin_amdgcn_rcpf(1.0f + e);
}
template <int ACT> struct EpiAct {
    static constexpr bool PERM = true, AFTER_DRAIN = false;
    bf16_t* O; int ldc; int act_tiles;
    __device__ __forceinline__ void operator()(const f32x4 (&acc)[2][2][4][2], const Unit& u, int wr, int wc, int fr, int fq) const {
        const int row0 = u.pm * BM + wr * 64 + fr; const int col0 = u.pn * BM + wc * 32 + 8 * fq;
        const bool act = (ACT == 1) ? (u.pn < act_tiles) : true;
#pragma unroll
        for (int ai = 0; ai < 2; ++ai)
#pragma unroll
            for (int m = 0; m < 4; ++m) { bf16_t* rowp = O + (size_t)(row0 + ai * HALF + m * 16) * ldc + col0;
#pragma unroll
                for (int bj = 0; bj < 2; ++bj) { f32x4 v0 = acc[ai][bj][m][0], v1 = acc[ai][bj][m][1];
                    if (ACT == 1) { if (act) {
#pragma unroll
                        for (int e = 0; e < 4; ++e) { v0[e] = gelu_tanh(v0[e]); v1[e] = gelu_tanh(v1[e]); } } }
                    if (ACT == 2) {
#pragma unroll
                        for (int e = 0; e < 4; ++e) { const float a = fmaxf(v0[e], 0.f), b = fmaxf(v1[e], 0.f); v0[e] = a * a; v1[e] = b * b; } }
                    u32x4 w; w.x = cvt_pk_bf16(v0[0], v0[1]); w.y = cvt_pk_bf16(v0[2], v0[3]); w.z = cvt_pk_bf16(v1[0], v1[1]); w.w = cvt_pk_bf16(v1[2], v1[3]);
                    *(u32x4*)(rowp + bj * HALF) = w; } }
    }
};

template <class Epi, class Sched, bool ALIGN_EPI = false, bool SP2 = false>
__device__ __forceinline__ void gemm_phase(PG8_LAS unsigned char* lds, const Gemm g, const Sched& S, const Epi& E, const int tid) {
    const int wid = __builtin_amdgcn_readfirstlane(tid >> 6), lane = tid & 63, wr = wid >> 2, wc = wid & 3, fr = lane & 15, fq = lane >> 4;
    const int K = g.K, nt = K / BK;
    unsigned voffA[2], voffB[2];
#pragma unroll
    for (int i = 0; i < 2; ++i) { int R, C; stage_rc(tid * 16 + i * 8192, R, C); const int Rb = Epi::PERM ? ((R & ~31) + perm32(R & 31)) : R;
        voffA[i] = (unsigned)(R * K + C) * 2u; voffB[i] = (unsigned)(Rb * K + C) * 2u; }
    const size_t kstep = (size_t)(BK * 2);
    const size_t hstep = (size_t)HALF * K * 2;
    const size_t tstep = 2 * hstep;
    const unsigned ldsw = (unsigned)wid * 1024u;
    const int aoff = lds_byte(wr * 64 + fr, fq * 8), boff = lds_byte(wc * 32 + fr, fq * 8);
#define PG8_SA(b, h) (((b) * 2 + (h)) * HTB)
#define PG8_SB(b, h) ((4 + (b) * 2 + (h)) * HTB)
#define PG8_STAGE(bufoff, gbase, voff) do { _Pragma("unroll") for (int _i = 0; _i < 2; ++_i) \
        __builtin_amdgcn_global_load_lds((const unsigned*)((const char*)(gbase) + (voff)[_i]), (PG8_LAS unsigned*)(lds + (bufoff) + ldsw + _i * 8192), 16, 0, 0); } while (0)
#define PG8_LDA(dst, b, h) do { _Pragma("unroll") for (int m = 0; m < 4; ++m) _Pragma("unroll") for (int k = 0; k < 2; ++k) dst[m][k] = *(const PG8_LAS bf16x8*)(lds + PG8_SA(b, h) + aoff + m * 2048 + k * 1024); } while (0)
#define PG8_LDB(dst, b, h) do { _Pragma("unroll") for (int n = 0; n < 2; ++n) _Pragma("unroll") for (int k = 0; k < 2; ++k) dst[n][k] = *(const PG8_LAS bf16x8*)(lds + PG8_SB(b, h) + boff + n * 2048 + k * 1024); } while (0)
#define PG8_MMA(ai, bj, At, Bt) do { __builtin_amdgcn_s_setprio(1); _Pragma("unroll") for (int m = 0; m < 4; ++m) _Pragma("unroll") for (int n = 0; n < 2; ++n) _Pragma("unroll") for (int k = 0; k < 2; ++k) \
        acc[ai][bj][m][n] = __builtin_amdgcn_mfma_f32_16x16x32_bf16(Bt[n][k], At[m][k], acc[ai][bj][m][n], 0, 0, 0); __builtin_amdgcn_s_setprio(0); } while (0)
#define PG8_WAIT_V(n) asm volatile("s_waitcnt vmcnt(" #n ")" ::: "memory")
#define PG8_WAIT_L(n) asm volatile("s_waitcnt lgkmcnt(" #n ")" ::: "memory")
#define PG8_BAR __builtin_amdgcn_s_barrier()
#define PG8_SCHED __builtin_amdgcn_sched_barrier(0)
    Unit cur, nxt; int ui = 0;
    if (!S.next(0, cur)) return;
    f32x4 acc[2][2][4][2];
#pragma unroll
    for (int a = 0; a < 2; ++a)
#pragma unroll
        for (int b = 0; b < 2; ++b)
#pragma unroll
            for (int m = 0; m < 4; ++m)
#pragma unroll
                for (int n = 0; n < 2; ++n) acc[a][b][m][n] = (f32x4){0.f, 0.f, 0.f, 0.f};
    bf16x8 At[4][2], B0[2][2], B1[2][2];
    const char* cA = (const char*)g.A + (size_t)cur.pm * tstep; const char* cB = (const char*)g.Bt + (size_t)cur.pn * tstep;
    S.a_ready(cur);
    if constexpr (SP2) {
        PG8_STAGE(PG8_SB(0, 0), cB, voffB); PG8_STAGE(PG8_SB(0, 1), cB + hstep, voffB); PG8_STAGE(PG8_SA(0, 0), cA, voffA); PG8_STAGE(PG8_SA(0, 1), cA + hstep, voffA);
        if (wr == 1) PG8_BAR;
        PG8_WAIT_V(2); PG8_BAR;
        PG8_STAGE(PG8_SB(1, 0), cB + kstep, voffB); PG8_STAGE(PG8_SA(1, 0), cA + kstep, voffA); PG8_STAGE(PG8_SB(1, 1), cB + hstep + kstep, voffB);
        PG8_WAIT_V(6); PG8_BAR;
    } else {
        PG8_STAGE(PG8_SB(0, 0), cB, voffB); PG8_STAGE(PG8_SA(0, 0), cA, voffA); PG8_STAGE(PG8_SB(0, 1), cB + hstep, voffB); PG8_STAGE(PG8_SA(0, 1), cA + hstep, voffA);
        if (wr == 1) PG8_BAR;
        PG8_WAIT_V(4); PG8_BAR;
        PG8_STAGE(PG8_SB(1, 0), cB + kstep, voffB); PG8_STAGE(PG8_SA(1, 0), cA + kstep, voffA); PG8_STAGE(PG8_SB(1, 1), cB + hstep + kstep, voffB);
        PG8_WAIT_V(6); PG8_BAR;
    }
    for (;;) {
        const bool has_next = S.next(ui + 1, nxt);
        const char* nA = has_next ? (const char*)g.A + (size_t)nxt.pm * tstep : cA; const char* nB = has_next ? (const char*)g.Bt + (size_t)nxt.pn * tstep : cB;
        for (int t = 0; t < nt; t += 2) {
            const bool last = (t == nt - 2);
            const char* a1 = cA + (size_t)(t + 1) * kstep;
            const char* a2 = last ? nA : cA + (size_t)(t + 2) * kstep; const char* b2 = last ? nB : cB + (size_t)(t + 2) * kstep;
            const char* a3 = a2 + kstep; const char* b3 = b2 + kstep;
            if (last && has_next) S.a_ready(nxt);
            if constexpr (SP2) {
            PG8_LDB(B0, 0, 0); PG8_LDB(B1, 0, 1); PG8_SCHED; PG8_LDA(At, 0, 0); PG8_STAGE(PG8_SA(1, 1), a1 + hstep, voffA);
            PG8_WAIT_V(8); PG8_WAIT_L(0); PG8_BAR; PG8_MMA(0, 0, At, B0); PG8_MMA(0, 1, At, B1); PG8_BAR; PG8_SCHED;
            PG8_LDA(At, 0, 1); PG8_STAGE(PG8_SB(0, 0), b2, voffB); PG8_STAGE(PG8_SB(0, 1), b2 + hstep, voffB); PG8_STAGE(PG8_SA(0, 0), a2, voffA);
            PG8_WAIT_V(8); PG8_WAIT_L(0); PG8_BAR; PG8_MMA(1, 0, At, B0); PG8_MMA(1, 1, At, B1); PG8_BAR; PG8_SCHED;
            PG8_LDB(B0, 1, 0); PG8_LDB(B1, 1, 1); PG8_SCHED; PG8_LDA(At, 1, 0); PG8_STAGE(PG8_SA(0, 1), a2 + hstep, voffA);
            PG8_WAIT_V(8); PG8_WAIT_L(0); PG8_BAR; PG8_MMA(0, 0, At, B0); PG8_MMA(0, 1, At, B1); PG8_BAR; PG8_SCHED;
            PG8_LDA(At, 1, 1); PG8_STAGE(PG8_SB(1, 0), b3, voffB); PG8_STAGE(PG8_SB(1, 1), b3 + hstep, voffB); PG8_STAGE(PG8_SA(1, 0), a3, voffA);
            PG8_WAIT_V(8); PG8_WAIT_L(0); PG8_BAR; PG8_MMA(1, 0, At, B0); PG8_MMA(1, 1, At, B1); PG8_BAR; PG8_SCHED;
            } else {
            PG8_LDB(B0, 0, 0); PG8_SCHED; PG8_LDA(At, 0, 0); PG8_STAGE(PG8_SA(1, 1), a1 + hstep, voffA);
            PG8_WAIT_L(8); PG8_BAR; PG8_WAIT_L(0); PG8_MMA(0, 0, At, B0); PG8_BAR; PG8_SCHED;
            PG8_LDB(B1, 0, 1); PG8_STAGE(PG8_SB(0, 0), b2, voffB);
            PG8_BAR; PG8_WAIT_L(0); PG8_MMA(0, 1, At, B1); PG8_BAR;
            PG8_LDA(At, 0, 1); PG8_STAGE(PG8_SA(0, 0), a2, voffA);
            PG8_BAR; PG8_WAIT_L(0); PG8_MMA(1, 0, At, B0); PG8_BAR; PG8_SCHED;
            PG8_STAGE(PG8_SB(0, 1), b2 + hstep, voffB);
            PG8_WAIT_V(6); PG8_BAR; PG8_MMA(1, 1, At, B1); PG8_BAR;
            PG8_LDB(B0, 1, 0); PG8_SCHED; PG8_LDA(At, 1, 0); PG8_STAGE(PG8_SA(0, 1), a2 + hstep, voffA);
            PG8_WAIT_L(8); PG8_BAR; PG8_WAIT_L(0); PG8_MMA(0, 0, At, B0); PG8_BAR; PG8_SCHED;
            PG8_LDB(B1, 1, 1); PG8_STAGE(PG8_SB(1, 0), b3, voffB);
            PG8_BAR; PG8_WAIT_L(0); PG8_MMA(0, 1, At, B1); PG8_BAR;
            PG8_LDA(At, 1, 1); PG8_STAGE(PG8_SA(1, 0), a3, voffA);
            PG8_BAR; PG8_WAIT_L(0); PG8_MMA(1, 0, At, B0); PG8_BAR; PG8_SCHED;
            PG8_STAGE(PG8_SB(1, 1), b3 + hstep, voffB);
            PG8_WAIT_V(6); PG8_BAR; PG8_MMA(1, 1, At, B1); PG8_BAR;
            }
        }
        if constexpr (ALIGN_EPI) { if (wr == 0) PG8_BAR; }
        if constexpr (!Epi::AFTER_DRAIN) { E(acc, cur, wr, wc, fr, fq); S.done(cur); }
        if (!has_next) break;
#pragma unroll
        for (int a = 0; a < 2; ++a)
#pragma unroll
            for (int b = 0; b < 2; ++b)
#pragma unroll
                for (int m = 0; m < 4; ++m)
#pragma unroll
                    for (int n = 0; n < 2; ++n) acc[a][b][m][n] = (f32x4){0.f, 0.f, 0.f, 0.f};
        cur = nxt; cA = nA; cB = nB; ++ui;
        if constexpr (ALIGN_EPI) { if (wr == 1) PG8_BAR; }
    }
    PG8_WAIT_V(0);
    if constexpr (!ALIGN_EPI) { if (wr == 0) PG8_BAR; }
    PG8_BAR;
    if constexpr (Epi::AFTER_DRAIN) { E.fused(acc, cur, wr, wc, fr, fq, lds, wid, lane); S.done(cur); }
#undef PG8_SA
#undef PG8_SB
#undef PG8_STAGE
#undef PG8_LDA
#undef PG8_LDB
#undef PG8_MMA
#undef PG8_WAIT_V
#undef PG8_WAIT_L
#undef PG8_BAR
#undef PG8_SCHED
}
}

#ifndef GMLP_DBG
#define GMLP_DBG 0
#endif
constexpr int NWAVES = 8, NTHR = 512;
constexpr int BATCH = 4, SEQ = 8192, D = 1024, DEPTH = 4, M = BATCH * SEQ;
constexpr int D_IN = 2576, NZ = 2816;
constexpr int FF = 4096;
constexpr int ZU = 0, ZV = 512, ZQ = 1024, ZK = 1280, ZVB = 1536, ZG = 2048, ZP = 2560;
constexpr float EPS = 1e-6f;
constexpr int NCHUNK = M / 64;
constexpr size_t MiB = 1u << 20;
constexpr size_t WS_WM = 1 * MiB;
constexpr size_t WS_DEC = 1 * MiB + 512 * 1024;
constexpr size_t WS_W = 2 * MiB;
constexpr size_t W_IN_B = (size_t)NZ * D * 2, W_OUT_B = (size_t)D * D * 2, W_1_B = (size_t)FF * D * 2, W_2_B = (size_t)D * FF * 2, W_LAYER_B = W_IN_B + W_OUT_B + W_1_B + W_2_B;
constexpr size_t WS_F1 = 96 * MiB;
constexpr size_t WS_Z = 96 * MiB;
constexpr size_t WS_AB = 272 * MiB;
constexpr size_t WS_QE = 336 * MiB;
constexpr size_t WS_Y = 352 * MiB;
constexpr size_t WS_SP = 352 * MiB;
constexpr size_t WS_OI = 384 * MiB;
constexpr size_t WS_MM = 416 * MiB;
constexpr size_t WS_UPD = 416 * MiB;
constexpr size_t WS_HP = 480 * MiB;
constexpr size_t WS_END = 494 * MiB;
static_assert(WS_W + DEPTH * W_LAYER_B <= WS_F1, "weights fit");
constexpr int LDS_BYTES = 149504;

#define GAS __attribute__((address_space(1)))
#define LAS __attribute__((address_space(3)))
typedef unsigned short bf16;
typedef unsigned v4u __attribute__((ext_vector_type(4)));
typedef unsigned v2u __attribute__((ext_vector_type(2)));
typedef float f32x4 __attribute__((ext_vector_type(4)));
typedef short bf16x8 __attribute__((ext_vector_type(8)));
#define LDS_WAIT() asm volatile("s_waitcnt lgkmcnt(0)" ::: "memory")
#define MFMA_DRAIN() asm volatile("s_nop 15\n\ts_nop 15\n\ts_nop 15\n\ts_nop 15\n\ts_nop 15\n\ts_nop 15\n\ts_nop 15\n\ts_nop 15\n\ts_nop 15\n\ts_nop 15\n\ts_nop 15\n\ts_nop 15\n\ts_nop 15\n\ts_nop 15\n\ts_nop 15\n\ts_nop 15" ::: "memory")
#define FRAG_WAIT() __builtin_amdgcn_sched_barrier(0)
#define MFMA16(a, b, c) __builtin_amdgcn_mfma_f32_16x16x32_bf16((a), (b), (c), 0, 0, 0)

__device__ __forceinline__ unsigned f2bf(float f) { unsigned u = __builtin_bit_cast(unsigned, f); return (u + 0x7fffu + ((u >> 16) & 1u)) >> 16; }
typedef __bf16 hwbf2 __attribute__((ext_vector_type(2)));
typedef float hwf2 __attribute__((ext_vector_type(2)));
__device__ __forceinline__ unsigned pk2(float lo, float hi) { const hwf2 v = {lo, hi}; return __builtin_bit_cast(unsigned, __builtin_convertvector(v, hwbf2)); }
__device__ __forceinline__ float bflo(unsigned w) { return __builtin_bit_cast(float, w << 16); }
__device__ __forceinline__ float bfhi(unsigned w) { return __builtin_bit_cast(float, w & 0xffff0000u); }
__device__ __forceinline__ float bf1(bf16 h) { return __builtin_bit_cast(float, (unsigned)h << 16); }
__device__ __forceinline__ void unpack8(const v4u w, float (&o)[8]) { o[0] = bflo(w.x); o[1] = bfhi(w.x); o[2] = bflo(w.y); o[3] = bfhi(w.y); o[4] = bflo(w.z); o[5] = bfhi(w.z); o[6] = bflo(w.w); o[7] = bfhi(w.w); }
__device__ __forceinline__ v4u pack8(const float (&o)[8]) { v4u w; w.x = pk2(o[0], o[1]); w.y = pk2(o[2], o[3]); w.z = pk2(o[4], o[5]); w.w = pk2(o[6], o[7]); return w; }
__device__ __forceinline__ float wave_sum(float v) {
#pragma unroll
    for (int o = 1; o < 64; o <<= 1) v += __shfl_xor(v, o);
    return v;
}
__device__ __forceinline__ float row16_sum(float v) {
#pragma unroll
    for (int o = 1; o < 16; o <<= 1) v += __shfl_xor(v, o);
    return v;
}

__device__ __forceinline__ void row16_sum4_lds(LAS unsigned char* scr, float (&v)[4], int lane) {
    *(LAS f32x4*)(scr + lane * 16) = (f32x4){v[0], v[1], v[2], v[3]};
    asm volatile("s_waitcnt lgkmcnt(0)" ::: "memory");
    f32x4 s = (f32x4){0.f, 0.f, 0.f, 0.f};
#pragma unroll
    for (int k = 0; k < 16; ++k) s += *(const LAS f32x4*)(scr + ((lane & 48) + k) * 16);
    asm volatile("s_waitcnt lgkmcnt(0)" ::: "memory");
    v[0] = s.x; v[1] = s.y; v[2] = s.z; v[3] = s.w;
}

__device__ __forceinline__ float wave_sum_lds(LAS unsigned char* scr, float v, int lane) {
    *(LAS float*)(scr + lane * 4) = v;
    asm volatile("s_waitcnt lgkmcnt(0)" ::: "memory");
    f32x4 s = (f32x4){0.f, 0.f, 0.f, 0.f};
#pragma unroll
    for (int k = 0; k < 16; ++k) s += *(const LAS f32x4*)(scr + k * 16);
    asm volatile("s_waitcnt lgkmcnt(0)" ::: "memory");
    return (s.x + s.y) + (s.z + s.w);
}
__device__ __forceinline__ void wave_sum4_lds(LAS unsigned char* scr, float (&v)[4], int lane) {
    *(LAS f32x4*)(scr + lane * 16) = (f32x4){v[0], v[1], v[2], v[3]};
    asm volatile("s_waitcnt lgkmcnt(0)" ::: "memory");
    f32x4 s = (f32x4){0.f, 0.f, 0.f, 0.f};
#pragma unroll
    for (int k = 0; k < 16; ++k) s += *(const LAS f32x4*)(scr + ((lane & 48) + k) * 16);
    asm volatile("s_waitcnt lgkmcnt(0)" ::: "memory");
    if ((lane & 15) == 0) *(LAS f32x4*)(scr + (lane >> 4) * 16) = s;
    asm volatile("s_waitcnt lgkmcnt(0)" ::: "memory");
    const f32x4 t0 = *(const LAS f32x4*)(scr), t1 = *(const LAS f32x4*)(scr + 16), t2 = *(const LAS f32x4*)(scr + 32), t3 = *(const LAS f32x4*)(scr + 48);
    asm volatile("s_waitcnt lgkmcnt(0)" ::: "memory");
    const f32x4 t = (t0 + t1) + (t2 + t3);
    v[0] = t.x; v[1] = t.y; v[2] = t.z; v[3] = t.w;
}

constexpr int HPR = 4, HP_ROWS = 16;
__device__ __forceinline__ size_t hp_row(int r16) { return (size_t)(r16 >> 2) * SEQ + (size_t)(r16 & 3); }
template <bool IN_BF16, int ACT>
__device__ __forceinline__ void hp_gemv4(LAS unsigned char* lds, const void* in, int K, const float* W, int ldw, int c0, float* out, int ldo, int wave, int lane) {
    const int c = c0 + (wave & 3), kbeg = (wave >> 2) * (K >> 1), steps = (K >> 1) >> 6;
    float acc[16];
#pragma unroll
    for (int r = 0; r < 16; ++r) acc[r] = 0.f;
#pragma unroll 2
    for (int s = 0; s < steps; ++s) { const int k = kbeg + s * 64 + lane;
        const float w = W[(size_t)k * ldw + c];
#pragma unroll
        for (int r = 0; r < 16; ++r) { const float a = IN_BF16 ? bf1(((const bf16*)in)[hp_row(r) * D + k]) : ((const float*)in)[(size_t)r * K + k]; acc[r] += a * w; } }
    LAS unsigned char* scr = lds + wave * 1024;
#pragma unroll
    for (int q = 0; q < 4; ++q) { float v[4] = {acc[4 * q], acc[4 * q + 1], acc[4 * q + 2], acc[4 * q + 3]}; wave_sum4_lds(scr, v, lane); acc[4 * q] = v[0]; acc[4 * q + 1] = v[1]; acc[4 * q + 2] = v[2]; acc[4 * q + 3] = v[3]; }
    LAS float* X = (LAS float*)(lds + 8192);
    if (lane == 0) {
#pragma unroll
        for (int r = 0; r < 16; ++r) X[wave * 16 + r] = acc[r]; }
    __syncthreads();
    if (wave < 4 && lane < 16) { float v = X[wave * 16 + lane] + X[(wave + 4) * 16 + lane]; if (ACT == 2) { v = fmaxf(v, 0.f); v = v * v; } out[(size_t)lane * ldo + c0 + wave] = v; }
    __syncthreads();
}

template <int ACT>
__device__ __forceinline__ void hp_gemv_phase(LAS unsigned char* lds, const float* in32, int K, const float* W, int ldw, int N, float* out, int G, int bid, int wave, int lane, int tid) {
    LAS float* INS = (LAS float*)(lds + 16384);
    const int nch = K >> 10, half = wave >> 2;
    for (int cg = bid; cg < (N >> 2); cg += G) {
        float acc[16];
#pragma unroll
        for (int r = 0; r < 16; ++r) acc[r] = 0.f;
        const int c = 4 * cg + (wave & 3);
        for (int ch = 0; ch < nch; ++ch) {
            if (nch > 1 || cg == bid) {
                __syncthreads();
#pragma unroll
                for (int i = 0; i < 8; ++i) { const int idx = tid + 512 * i, r = idx >> 8, k4 = idx & 255;
                    *(LAS f32x4*)(INS + r * 1024 + 4 * k4) = *(const f32x4*)(in32 + (size_t)r * K + ch * 1024 + 4 * k4); }
                __syncthreads();
            }
            const int kb = ch * 1024 + half * 512 + lane;
            float w8[8];
#pragma unroll
            for (int s = 0; s < 8; ++s) w8[s] = W[(size_t)(kb + s * 64) * ldw + c];
#pragma unroll
            for (int s = 0; s < 8; ++s)
#pragma unroll
                for (int r = 0; r < 16; ++r) acc[r] += INS[r * 1024 + half * 512 + s * 64 + lane] * w8[s];
        }
        LAS unsigned char* scr = lds + wave * 1024;
#pragma unroll
        for (int q = 0; q < 4; ++q) { float v[4] = {acc[4 * q], acc[4 * q + 1], acc[4 * q + 2], acc[4 * q + 3]}; wave_sum4_lds(scr, v, lane); acc[4 * q] = v[0]; acc[4 * q + 1] = v[1]; acc[4 * q + 2] = v[2]; acc[4 * q + 3] = v[3]; }
        LAS float* X = (LAS float*)(lds + 8192);
        if (lane == 0) {
#pragma unroll
            for (int r = 0; r < 16; ++r) X[wave * 16 + r] = acc[r]; }
        __syncthreads();
        if (wave < 4 && lane < 16) { float v = X[wave * 16 + lane] + X[(wave + 4) * 16 + lane]; if (ACT == 2) { v = fmaxf(v, 0.f); v = v * v; } out[(size_t)lane * N + 4 * cg + wave] = v; }
        __syncthreads();
    }
}

__device__ __forceinline__ void p0_transpose_item(const float* W, int ldw, int ncols, int K, bf16* WT, const float* kscale, int qlo, int qhi, LAS float* scr, int item, int lane) {
    const int nblk = ncols / 32, kb = item / nblk, nb = item % nblk, k0 = 64 * kb, n0 = 32 * nb;
    const float cs = (n0 >= qlo && n0 < qhi) ? 0.125f : 1.0f;
    float wreg[32];
#pragma unroll
    for (int i = 0; i < 32; ++i) wreg[i] = W[(size_t)(k0 + 2 * i + (lane >> 5)) * ldw + n0 + (lane & 31)];
#pragma unroll
    for (int i = 0; i < 32; ++i) { const int kk = 2 * i + (lane >> 5); float w = wreg[i]; if (kscale) w *= kscale[k0 + kk]; scr[kk * 33 + (lane & 31)] = w * cs; }
    LDS_WAIT(); asm volatile("" ::: "memory");
    const int c = lane & 7;
#pragma unroll
    for (int j = 0; j < 4; ++j) { const int n = (lane >> 3) + 8 * j; const LAS float* s = scr + (8 * c) * 33 + n;
        v4u o; o.x = pk2(s[0 * 33], s[1 * 33]); o.y = pk2(s[2 * 33], s[3 * 33]); o.z = pk2(s[4 * 33], s[5 * 33]); o.w = pk2(s[6 * 33], s[7 * 33]);
        *(GAS v4u*)(WT + (size_t)(n0 + n) * K + k0 + 8 * c) = o; }
    LDS_WAIT(); asm volatile("" ::: "memory");
}
__device__ __forceinline__ void p0_gate_item(const float* Win, const float* gw, const float* g, bf16* WT, int item, int lane) {
    const int np = item >> 1, k0 = ((item & 1) * 64 + lane) * 8;
    float gwv[16];
#pragma unroll
    for (int r = 0; r < 16; ++r) gwv[r] = gw[r * 256 + np];
    float o[8];
#pragma unroll
    for (int j = 0; j < 8; ++j) { const float* wr = Win + (size_t)(k0 + j) * D_IN + 2560; float s = 0.f;
#pragma unroll
        for (int r4 = 0; r4 < 4; ++r4) { const f32x4 w = *(const f32x4*)(wr + 4 * r4); s += w.x * gwv[4 * r4] + w.y * gwv[4 * r4 + 1] + w.z * gwv[4 * r4 + 2] + w.w * gwv[4 * r4 + 3]; }
        o[j] = s * g[k0 + j]; }
    *(GAS v4u*)(WT + (size_t)(2560 + np) * D + k0) = pack8(o);
}

__device__ __forceinline__ void rows_phase(LAS unsigned char* scr, const float* hin, const bf16* mm, const float* g, float* hout, bf16* y, int gw, int ngw, int lane, const float* m32 = nullptr, float* y32out = nullptr, const float* ygain = nullptr) {
    f32x4 hn[4]; v4u mn[2] = {(v4u){0u, 0u, 0u, 0u}, (v4u){0u, 0u, 0u, 0u}};
    { const float* hr = hin + (size_t)gw * D + 8 * lane; hn[0] = *(const f32x4*)hr; hn[1] = *(const f32x4*)(hr + 4); hn[2] = *(const f32x4*)(hr + 512); hn[3] = *(const f32x4*)(hr + 516);
      if (mm) { const bf16* mr = mm + (size_t)gw * D + 8 * lane; mn[0] = *(const v4u*)mr; mn[1] = *(const v4u*)(mr + 512); } }
    for (int row = gw; row < M; row += ngw) {
        float hv[16];
        hv[0] = hn[0].x; hv[1] = hn[0].y; hv[2] = hn[0].z; hv[3] = hn[0].w; hv[4] = hn[1].x; hv[5] = hn[1].y; hv[6] = hn[1].z; hv[7] = hn[1].w;
        hv[8] = hn[2].x; hv[9] = hn[2].y; hv[10] = hn[2].z; hv[11] = hn[2].w; hv[12] = hn[3].x; hv[13] = hn[3].y; hv[14] = hn[3].z; hv[15] = hn[3].w;
        const v4u mc0 = mn[0], mc1 = mn[1];
        if (row + ngw < M) { const float* hr = hin + (size_t)(row + ngw) * D + 8 * lane; hn[0] = *(const f32x4*)hr; hn[1] = *(const f32x4*)(hr + 4); hn[2] = *(const f32x4*)(hr + 512); hn[3] = *(const f32x4*)(hr + 516);
            if (mm) { const bf16* mr = mm + (size_t)(row + ngw) * D + 8 * lane; mn[0] = *(const v4u*)mr; mn[1] = *(const v4u*)(mr + 512); } }
        if (mm) {
            float mv[16];
            const int tpos = row & (SEQ - 1); const bool hp = (m32 != nullptr) && (tpos < HPR);
            if (hp) { const float* m3 = m32 + (size_t)((row >> 13) * 4 + tpos) * D + 8 * lane;
#pragma unroll
                for (int e = 0; e < 2; ++e) { const f32x4 a = *(const f32x4*)(m3 + 512 * e), b = *(const f32x4*)(m3 + 512 * e + 4);
                    mv[8 * e + 0] = a.x; mv[8 * e + 1] = a.y; mv[8 * e + 2] = a.z; mv[8 * e + 3] = a.w; mv[8 * e + 4] = b.x; mv[8 * e + 5] = b.y; mv[8 * e + 6] = b.z; mv[8 * e + 7] = b.w; }
            } else {
                float t[8]; unpack8(mc0, t);
#pragma unroll
                for (int i = 0; i < 8; ++i) mv[i] = t[i];
                unpack8(mc1, t);
#pragma unroll
                for (int i = 0; i < 8; ++i) mv[8 + i] = t[i]; }
            float ss = 0.f;
#pragma unroll
            for (int i = 0; i < 16; ++i) ss += mv[i] * mv[i];
            const float rstd = 1.0f / sqrtf(wave_sum_lds(scr, ss, lane) * (1.0f / D) + EPS);
#pragma unroll
            for (int e = 0; e < 2; ++e) { const f32x4 ga = *(const f32x4*)(g + 8 * lane + 512 * e), gb = *(const f32x4*)(g + 8 * lane + 512 * e + 4);
                const float gg[8] = {ga.x, ga.y, ga.z, ga.w, gb.x, gb.y, gb.z, gb.w};
#pragma unroll
                for (int i = 0; i < 8; ++i) hv[8 * e + i] += mv[8 * e + i] * rstd * gg[i]; }
        }
        if (hout) { float* orow = hout + (size_t)row * D + 8 * lane;
#pragma unroll
            for (int e = 0; e < 2; ++e) { *(f32x4*)(orow + 512 * e) = (f32x4){hv[8 * e], hv[8 * e + 1], hv[8 * e + 2], hv[8 * e + 3]}; *(f32x4*)(orow + 512 * e + 4) = (f32x4){hv[8 * e + 4], hv[8 * e + 5], hv[8 * e + 6], hv[8 * e + 7]}; } }
        if (y) {
            float ss = 0.f;
#pragma unroll
            for (int i = 0; i < 16; ++i) ss += hv[i] * hv[i];
            const float rstd = 1.0f / sqrtf(wave_sum_lds(scr, ss, lane) * (1.0f / D) + EPS);
            bf16* yr = y + (size_t)row * D + 8 * lane;
#pragma unroll
            for (int e = 0; e < 2; ++e) { float t[8];
#pragma unroll
                for (int i = 0; i < 8; ++i) t[i] = hv[8 * e + i] * rstd;
                *(v4u*)(yr + 512 * e) = pack8(t); }
            const int tpos2 = row & (SEQ - 1);
            if (y32out != nullptr && tpos2 < HPR) { float* y3 = y32out + (size_t)((row >> 13) * 4 + tpos2) * D + 8 * lane;
#pragma unroll
                for (int e = 0; e < 2; ++e)
#pragma unroll
                    for (int i = 0; i < 8; ++i) y3[512 * e + i] = hv[8 * e + i] * rstd * ygain[8 * lane + 512 * e + i]; }
        }
    }
}

constexpr int VT_ROW = 272, VT_HEAD = 128 * VT_ROW;
__device__ __forceinline__ void gmlp_unit(LAS unsigned char* lds, float* ab32, const bf16* z, bf16* ab, const bf16* Wm, const float* ln_g, const float* ln_b, const float* bs, const float* out_g, int unit, int tid) {
    const int lane = tid & 63, wave = __builtin_amdgcn_readfirstlane(tid >> 6), x = lane & 15, g = lane >> 4;
    const size_t row0 = (size_t)unit * 128;
    {
        float gg[8], bb[8];
        { const f32x4 a = *(const f32x4*)(ln_g + 8 * lane), b = *(const f32x4*)(ln_g + 8 * lane + 4); gg[0] = a.x; gg[1] = a.y; gg[2] = a.z; gg[3] = a.w; gg[4] = b.x; gg[5] = b.y; gg[6] = b.z; gg[7] = b.w; }
        { const f32x4 a = *(const f32x4*)(ln_b + 8 * lane), b = *(const f32x4*)(ln_b + 8 * lane + 4); bb[0] = a.x; bb[1] = a.y; bb[2] = a.z; bb[3] = a.w; bb[4] = b.x; bb[5] = b.y; bb[6] = b.z; bb[7] = b.w; }
        const int h = lane >> 4;
#pragma unroll 1
        for (int it = 0; it < 4; ++it) {
            const int j0 = 16 * wave + 4 * it;
            float val[4][8];
            LAS unsigned char* scr1 = lds + 4 * VT_HEAD + wave * 1024;
            float sm[4];
#pragma unroll
            for (int t = 0; t < 4; ++t) {
                const v4u w = *(const v4u*)(z + (row0 + j0 + t) * NZ + ZV + 8 * lane);
                unpack8(w, val[t]);
                float s = 0.f;
#pragma unroll
                for (int i = 0; i < 8; ++i) s += val[t][i];
                sm[t] = s;
            }
            wave_sum4_lds(scr1, sm, lane);
            float s2[4];
#pragma unroll
            for (int t = 0; t < 4; ++t) { const float mean = sm[t] * (1.0f / 512.0f); float q = 0.f;
#pragma unroll
                for (int i = 0; i < 8; ++i) { val[t][i] -= mean; q += val[t][i] * val[t][i]; }
                s2[t] = q; }
            wave_sum4_lds(scr1, s2, lane);
#pragma unroll
            for (int t = 0; t < 4; ++t) { const float rstd = 1.0f / sqrtf(s2[t] * (1.0f / 512.0f) + EPS);
#pragma unroll
                for (int i = 0; i < 8; ++i) val[t][i] = val[t][i] * rstd * gg[i] + bb[i]; }
#pragma unroll
            for (int i = 0; i < 8; ++i) { v2u o; o.x = pk2(val[0][i], val[1][i]); o.y = pk2(val[2][i], val[3][i]);
                *(LAS v2u*)(lds + h * VT_HEAD + (i * 16 + x) * VT_ROW + j0 * 2) = o; }
        }
    }
    __syncthreads();
    if (GMLP_DBG == 7) {
        const bf16x8 a = (bf16x8){0x3f80, 0x3f00, 0x3e80, 0x3f80, 0x3f00, 0x3e80, 0x3f80, 0x3f00};
        for (int h = 0; h < 4; ++h) {
            f32x4 acc[8];
            for (int nt = 0; nt < 8; ++nt) acc[nt] = (f32x4){0.f, 0.f, 0.f, 0.f};
            for (int ks = 0; ks < 4; ++ks) {
                bf16x8 b[8];
#pragma unroll
                for (int nt = 0; nt < 8; ++nt) b[nt] = *(const LAS bf16x8*)(lds + h * VT_HEAD + (nt * 16 + x) * VT_ROW + (ks * 32 + 8 * g) * 2);
                FRAG_WAIT();
#pragma unroll
                for (int nt = 0; nt < 8; ++nt) acc[nt] = MFMA16(a, b[nt], acc[nt]);
            }
#pragma unroll
            for (int r = 0; r < 4; ++r) { float t[8];
#pragma unroll
                for (int nt = 0; nt < 8; ++nt) t[nt] = acc[nt][r];
                *(v4u*)(ab + (row0 + 16 * wave + 4 * g + r) * D + 128 * h + 8 * x) = pack8(t); }
        }
        __syncthreads();
        return;
    }
    if (GMLP_DBG == 6) {
        for (int h = 0; h < 4; ++h) { float f[8] = {0.f, 0.f, 0.f, 0.f, 0.f, 0.f, 0.f, 0.f};
            for (int nt = 0; nt < 8; ++nt) for (int ks = 0; ks < 4; ++ks) {
                const v4u b = *(const LAS v4u*)(lds + h * VT_HEAD + (nt * 16 + x) * VT_ROW + (ks * 32 + 8 * g) * 2);
                float t[8]; unpack8(b, t);
                for (int q = 0; q < 8; ++q) f[q] += t[q] * (float)(1 + nt + 8 * ks); }
            *(v4u*)(ab + (row0 + 16 * wave + x) * D + 128 * h + 8 * g) = pack8(f); }
        __syncthreads();
        return;
    }
    const int nk = (wave < 4) ? 2 : 4;
    float ssr[4] = {0.f, 0.f, 0.f, 0.f};
#pragma unroll 1
    for (int h = 0; h < 4; ++h) {
        f32x4 acc[8];
#pragma unroll
        for (int nt = 0; nt < 8; ++nt) acc[nt] = (f32x4){0.f, 0.f, 0.f, 0.f};
        bf16x8 a4[4];
#pragma unroll
        for (int ks = 0; ks < 4; ++ks) a4[ks] = *(const bf16x8*)(Wm + h * 16384 + (16 * wave + x) * 128 + ks * 32 + 8 * g);
#pragma unroll
        for (int ks = 0; ks < 4; ++ks) {
            if (ks < nk) {
#pragma unroll
                for (int nt = 0; nt < 8; ++nt) { const bf16x8 b = *(const LAS bf16x8*)(lds + h * VT_HEAD + (nt * 16 + x) * VT_ROW + (ks * 32 + 8 * g) * 2); acc[nt] = MFMA16(a4[ks], b, acc[nt]); }
            }
        }
#pragma unroll
        for (int r = 0; r < 4; ++r) {
            const int i = 16 * wave + 4 * g + r;
            const v4u w = *(const v4u*)(z + (row0 + i) * NZ + ZU + 128 * h + 8 * x);
            float uv[8]; unpack8(w, uv);
            const float bias = bs[h * 128 + i];
            float o[8];
#pragma unroll
            for (int nt = 0; nt < 8; ++nt) o[nt] = uv[nt] * (acc[nt][r] + bias);
            const v4u pw = pack8(o);
            float ob[8]; unpack8(pw, ob);
#pragma unroll
            for (int nt = 0; nt < 8; ++nt) ssr[r] += ob[nt] * ob[nt];
            *(v4u*)(ab + (row0 + i) * D + 128 * h + 8 * x) = pw;
        }
    }
    row16_sum4_lds(lds + 4 * VT_HEAD + wave * 1024, ssr, lane);
    float rstd[4];
#pragma unroll
    for (int r = 0; r < 4; ++r) rstd[r] = 1.0f / sqrtf(ssr[r] * (1.0f / 512.0f) + EPS);
    asm volatile("s_waitcnt vmcnt(0)" ::: "memory");
#pragma unroll 1
    for (int h = 0; h < 4; ++h) {
        const f32x4 ga = *(const f32x4*)(out_g + 128 * h + 8 * x), gb = *(const f32x4*)(out_g + 128 * h + 8 * x + 4);
        const float gg[8] = {ga.x, ga.y, ga.z, ga.w, gb.x, gb.y, gb.z, gb.w};
#pragma unroll
        for (int r = 0; r < 4; ++r) {
            const int i = 16 * wave + 4 * g + r;
            bf16* p = ab + (row0 + i) * D + 128 * h + 8 * x;
            float t[8]; unpack8(*(const v4u*)p, t);
#pragma unroll
            for (int nt = 0; nt < 8; ++nt) t[nt] = t[nt] * rstd[r] * gg[nt];
            *(v4u*)p = pack8(t);

        }
    }
    __syncthreads();
}


__device__ __forceinline__ void block_sum16(LAS unsigned char* wscr, LAS float* PW, float (&v)[16], int wave, int lane) {
#pragma unroll
    for (int q = 0; q < 4; ++q) { float t[4] = {v[4 * q], v[4 * q + 1], v[4 * q + 2], v[4 * q + 3]}; wave_sum4_lds(wscr, t, lane); v[4 * q] = t[0]; v[4 * q + 1] = t[1]; v[4 * q + 2] = t[2]; v[4 * q + 3] = t[3]; asm volatile("" ::: "memory"); }
    if (lane == 0) {
#pragma unroll
        for (int i = 0; i < 16; ++i) PW[wave * 16 + i] = v[i]; }
    __syncthreads();
#pragma unroll
    for (int i = 0; i < 16; ++i) v[i] = 0.f;
#pragma unroll
    for (int w2 = 0; w2 < 8; ++w2) {
#pragma unroll
        for (int q = 0; q < 4; ++q) { const f32x4 t = *(const LAS f32x4*)(PW + w2 * 16 + 4 * q); v[4 * q] += t.x; v[4 * q + 1] += t.y; v[4 * q + 2] += t.z; v[4 * q + 3] += t.w; }
        asm volatile("" ::: "memory"); }
    __syncthreads();
}
__device__ __forceinline__ void block_sum4(LAS unsigned char* wscr, LAS float* PW, float (&v)[4], int wave, int lane) {
    wave_sum4_lds(wscr, v, lane);
    if (lane == 0) *(LAS f32x4*)(PW + wave * 4) = (f32x4){v[0], v[1], v[2], v[3]};
    __syncthreads();
    f32x4 s = (f32x4){0.f, 0.f, 0.f, 0.f};
#pragma unroll
    for (int w2 = 0; w2 < 8; ++w2) s += *(const LAS f32x4*)(PW + w2 * 4);
    v[0] = s.x; v[1] = s.y; v[2] = s.z; v[3] = s.w;
    __syncthreads();
}
__device__ __forceinline__ void gmlp_hp1(LAS unsigned char* lds, const float* hsrc, const float* Win32, const float* pre_g, float* part, float* partu, int b, int ks, int rq, int tid_in) {
    int tid = tid_in; asm volatile("" : "+v"(tid));
    const int c = tid;
    const size_t rb = (size_t)b * SEQ + 16 * rq;
    LAS float* Y = (LAS float*)(lds + 1024);
    { const int sj = tid >> 5, skk = (tid & 31) * 2;
      const float* hr = hsrc + (rb + sj) * D + 64 * ks + skk; const float* gr = pre_g + 64 * ks + skk;
      Y[(skk + 0) * 16 + sj] = hr[0] * gr[0]; Y[(skk + 1) * 16 + sj] = hr[1] * gr[1]; }
    __syncthreads();
    const float* wbase = Win32 + (size_t)(64 * ks) * D_IN + c;
    float accv[16], accu[4] = {0.f, 0.f, 0.f, 0.f};
#pragma unroll
    for (int j = 0; j < 16; ++j) accv[j] = 0.f;
#pragma unroll 1
    for (int kb = 0; kb < 64; kb += 8) {
        float wv[8], wu[8];
        const float* wk = wbase + (size_t)kb * D_IN;
#pragma unroll
        for (int e = 0; e < 8; ++e) { wv[e] = wk[(size_t)e * D_IN + ZV]; wu[e] = wk[(size_t)e * D_IN + ZU]; }
#pragma unroll
        for (int e = 0; e < 8; ++e) {
#pragma unroll
            for (int q4 = 0; q4 < 4; ++q4) { const f32x4 y = *(const LAS f32x4*)(Y + (kb + e) * 16 + 4 * q4);
                accv[4 * q4] += y.x * wv[e]; accv[4 * q4 + 1] += y.y * wv[e]; accv[4 * q4 + 2] += y.z * wv[e]; accv[4 * q4 + 3] += y.w * wv[e];
                if (q4 == 0) { accu[0] += y.x * wu[e]; accu[1] += y.y * wu[e]; accu[2] += y.z * wu[e]; accu[3] += y.w * wu[e]; } }
        }
    }
    float* pp = part + ((size_t)(b * 16 + ks) * 64 + 16 * rq) * 512 + c;
#pragma unroll
    for (int j = 0; j < 16; ++j) pp[(size_t)j * 512] = accv[j];
    if (rq == 0) {
#pragma unroll
        for (int i = 0; i < 4; ++i) partu[((size_t)(b * 16 + ks) * 4 + i) * 512 + c] = accu[i]; }
    __syncthreads();
}
__device__ __forceinline__ void gmlp_hp2a(LAS unsigned char* lds, const float* hsrc, const float* ws32, const float* ln_g, const float* ln_b, const float* part, const float* partu, float* mixp, float* zup, int b, int rg, int tid_in) {
    int tid = tid_in; asm volatile("" : "+v"(tid));
    const int lane = tid & 63, wave = __builtin_amdgcn_readfirstlane(tid >> 6), c = tid;
    const size_t rb = (size_t)b * SEQ;
    LAS float* RS = (LAS float*)(lds);
    LAS float* PW = (LAS float*)(lds + 512);
    LAS unsigned char* wscr = lds + 1024 + wave * 1024;
    if (wave < 4) {
        const float* hr = hsrc + (rb + 4 * rg + wave) * D; float s = 0.f;
#pragma unroll
        for (int e = 0; e < 16; ++e) { const float v = hr[lane + 64 * e]; s += v * v; }
        const float tot = wave_sum_lds(wscr, s, lane);
        if (lane == 0) RS[wave] = 1.0f / sqrtf(tot * (1.0f / D) + EPS);
    }
    float s4[4] = {0.f, 0.f, 0.f, 0.f};
    { const float* pb = part + ((size_t)(b * 16) * 64 + 4 * rg) * 512 + c;
#pragma unroll 8
      for (int ks = 0; ks < 16; ++ks) { const float* pk = pb + (size_t)ks * 64 * 512;
#pragma unroll
          for (int i = 0; i < 4; ++i) s4[i] += pk[i * 512]; } }
    __syncthreads();
    const float lg = ln_g[c], lb = ln_b[c];
    const int h = wave >> 1;
    float x4[4], v[4];
#pragma unroll
    for (int i = 0; i < 4; ++i) { x4[i] = pg8::gelu_tanh(s4[i] * RS[i]); v[i] = x4[i]; }
    block_sum4(wscr, PW, v, wave, lane);
#pragma unroll
    for (int i = 0; i < 4; ++i) { x4[i] -= v[i] * (1.0f / 512.0f); v[i] = x4[i] * x4[i]; }
    block_sum4(wscr, PW, v, wave, lane);
#pragma unroll
    for (int i = 0; i < 4; ++i) x4[i] = x4[i] * (1.0f / sqrtf(v[i] * (1.0f / 512.0f) + EPS)) * lg + lb;
#pragma unroll
    for (int i = 0; i < 4; ++i) { const f32x4 w = *(const f32x4*)(ws32 + (size_t)(h * 128 + i) * 128 + 4 * rg);
        mixp[((size_t)(b * 16 + rg) * 4 + i) * 512 + c] = w.x * x4[0] + w.y * x4[1] + w.z * x4[2] + w.w * x4[3]; }
    if (rg == 0) {
        float zu[4] = {0.f, 0.f, 0.f, 0.f};
#pragma unroll 8
        for (int ks = 0; ks < 16; ++ks) { const float* pk = partu + ((size_t)(b * 16 + ks) * 4) * 512 + c;
#pragma unroll
            for (int i = 0; i < 4; ++i) zu[i] += pk[i * 512]; }
#pragma unroll
        for (int i = 0; i < 4; ++i) zup[((size_t)b * 4 + i) * 512 + c] = zu[i] * RS[i];
    }
    __syncthreads();
}
__device__ __forceinline__ void gmlp_hp2b(LAS unsigned char* lds, const float* bs, const float* out_g, const float* mixp, const float* zup, float* ab32, int b, int tid_in) {
    int tid = tid_in; asm volatile("" : "+v"(tid));
    const int lane = tid & 63, wave = __builtin_amdgcn_readfirstlane(tid >> 6), c = tid;
    LAS float* PW = (LAS float*)(lds + 512);
    LAS unsigned char* wscr = lds + 1024 + wave * 1024;
    const int h = wave >> 1;
    __syncthreads();
    float mixed[4] = {0.f, 0.f, 0.f, 0.f};
#pragma unroll 8
    for (int rg = 0; rg < 16; ++rg) { const float* pk = mixp + ((size_t)(b * 16 + rg) * 4) * 512 + c;
#pragma unroll
        for (int i = 0; i < 4; ++i) mixed[i] += pk[i * 512]; }
    float o4[4], sq[4];
#pragma unroll
    for (int i = 0; i < 4; ++i) { o4[i] = pg8::gelu_tanh(zup[((size_t)b * 4 + i) * 512 + c]) * (mixed[i] + bs[h * 128 + i]); sq[i] = o4[i] * o4[i]; }
    block_sum4(wscr, PW, sq, wave, lane);
    const float og = out_g[c];
#pragma unroll
    for (int i = 0; i < 4; ++i) ab32[(size_t)(b * 4 + i) * D + c] = o4[i] * (1.0f / sqrtf(sq[i] * (1.0f / 512.0f) + EPS)) * og;
    __syncthreads();
}

constexpr int G_ROW = 144;
constexpr int G_QE = 0, G_KE = 9216, G_KDT = 18432, G_VT = 27648, G_P = 46080, G_SEG = 55296, G_SC = 57344, G_SCR = 57600, G_HROW = 65536, G_PART = 81920  , G_WSCR = 131072  , G_PSS = 139264;
constexpr int HP_R = 4;
__device__ __forceinline__ float log_sigmoid(float p) { return fminf(p, 0.f) - __logf(1.0f + __expf(-fabsf(p))); }
__device__ __forceinline__ void gla1_unit(LAS unsigned char* lds, const float* hsrc, const float* Win32, const float* pre_g, const float* gla_og, float* ab32, const bf16* z, const float* gate_b, bf16* qe_g, bf16* oi_g, float* upd_g, float* dec_g, int unit, int tid) {
    const int lane = tid & 63, wave = __builtin_amdgcn_readfirstlane(tid >> 6), x = lane & 15, g = lane >> 4;
    const int cidx = unit >> 2, h = unit & 3;
    const size_t rbase = (size_t)cidx * 64;
    const int sidx = ((cidx >> 7) * 4 + h) * 128 + (cidx & 127);
    LAS float* SEG = (LAS float*)(lds + G_SEG);
    float c[8], qv[8], kv[8];
    {
        const float gb = gate_b[h * 64 + lane];
        float run = 0.f;
#pragma unroll
        for (int tt = 0; tt < 8; ++tt) {
            const bf16* zr = z + (rbase + 8 * wave + tt) * NZ;
            const float p = bf1(zr[ZP + h * 64 + lane]) + gb;
            qv[tt] = bf1(zr[ZQ + h * 64 + lane]); kv[tt] = bf1(zr[ZK + h * 64 + lane]);
            run += log_sigmoid(p) * (1.0f / 16.0f); c[tt] = run;
        }
        SEG[wave * 64 + lane] = run;
    }
    {
#pragma unroll
        for (int e = 0; e < 2; ++e) { const int v = lane + 64 * e; float t[8];
#pragma unroll
            for (int tt = 0; tt < 8; ++tt) t[tt] = bf1(z[(rbase + 8 * wave + tt) * NZ + ZVB + h * 128 + v]);
            *(LAS v4u*)(lds + G_VT + ((v & 7) * 16 + (v >> 3)) * G_ROW + 16 * wave) = pack8(t); }
    }
    const bool hp = ((cidx & 127) == 0);
    __syncthreads();
    float vf[HP_R][2] = {{0.f, 0.f}, {0.f, 0.f}, {0.f, 0.f}, {0.f, 0.f}}, gf[HP_R][2] = {{0.f, 0.f}, {0.f, 0.f}, {0.f, 0.f}, {0.f, 0.f}};
    if (hp && wave == 0) {
#pragma unroll
        for (int tt = 0; tt < HP_R; ++tt) { const float* qr = hsrc   + (size_t)((cidx >> 7) * 4 + tt) * 1536;
            qv[tt] = qr[h * 64 + lane] * 0.125f; kv[tt] = qr[256 + h * 64 + lane];
            vf[tt][0] = qr[512 + h * 128 + lane]; vf[tt][1] = qr[512 + h * 128 + lane + 64]; gf[tt][0] = qr[1024 + h * 128 + lane]; gf[tt][1] = qr[1024 + h * 128 + lane + 64]; }
    }
    {
        float off = 0.f, tot = 0.f;
#pragma unroll
        for (int w2 = 0; w2 < 8; ++w2) { const float s = SEG[w2 * 64 + lane]; tot += s; if (w2 < wave) off += s; }
        if (wave == 0) dec_g[(size_t)sidx * 64 + lane] = __expf(tot);
        float kd[8];
#pragma unroll
        for (int tt = 0; tt < 8; ++tt) {
            const float cum = off + c[tt]; const int t = 8 * wave + tt;
            const float qe = qv[tt] * __expf(cum), ke = kv[tt] * __expf(-cum); kd[tt] = kv[tt] * __expf(tot - cum);
            const bf16 qb = (bf16)f2bf(qe);
            *(LAS bf16*)(lds + G_QE + t * G_ROW + 2 * lane) = qb;
            *(LAS bf16*)(lds + G_KE + t * G_ROW + 2 * lane) = (bf16)f2bf(ke);
            qe_g[(rbase + t) * 256 + h * 64 + lane] = qb;
        }
        *(LAS v4u*)(lds + G_KDT + lane * G_ROW + 16 * wave) = pack8(kd);
        if (hp && wave == 0) {
            float qf[HP_R], kf[HP_R];
#pragma unroll
            for (int tt = 0; tt < HP_R; ++tt) { const float cum = off + c[tt]; qf[tt] = qv[tt] * __expf(cum); kf[tt] = kv[tt] * __expf(-cum); }
            float s0[4] = {qf[0] * kf[0], qf[1] * kf[0], qf[1] * kf[1], qf[2] * kf[0]};
            float s1[4] = {qf[2] * kf[1], qf[2] * kf[2], qf[3] * kf[0], qf[3] * kf[1]};
            float s2[4] = {qf[3] * kf[2], qf[3] * kf[3], 0.f, 0.f};
            wave_sum4_lds(lds + G_SCR, s0, lane); wave_sum4_lds(lds + G_SCR, s1, lane); wave_sum4_lds(lds + G_SCR, s2, lane);
            if (lane == 0) { LAS float* SC = (LAS float*)(lds + G_SC);
                SC[0] = s0[0]; SC[1] = 0.f; SC[2] = 0.f; SC[3] = 0.f;
                SC[4] = s0[1]; SC[5] = s0[2]; SC[6] = 0.f; SC[7] = 0.f;
                SC[8] = s0[3]; SC[9] = s1[0]; SC[10] = s1[1]; SC[11] = 0.f;
                SC[12] = s1[2]; SC[13] = s1[3]; SC[14] = s2[0]; SC[15] = s2[1]; }
            float o[HP_R][2];
#pragma unroll
            for (int e = 0; e < 2; ++e) {
                o[0][e] = s0[0] * vf[0][e];
                o[1][e] = s0[1] * vf[0][e] + s0[2] * vf[1][e];
                o[2][e] = s0[3] * vf[0][e] + s1[0] * vf[1][e] + s1[1] * vf[2][e];
                o[3][e] = s1[2] * vf[0][e] + s1[3] * vf[1][e] + s2[0] * vf[2][e] + s2[1] * vf[3][e]; }
            float so[4];
#pragma unroll
            for (int i = 0; i < HP_R; ++i) so[i] = o[i][0] * o[i][0] + o[i][1] * o[i][1];
            wave_sum4_lds(lds + G_SCR, so, lane);
#pragma unroll
            for (int i = 0; i < HP_R; ++i) { const float rs = 1.0f / sqrtf(so[i] * (1.0f / 128.0f) + EPS);
#pragma unroll
                for (int e = 0; e < 2; ++e) { const float zg = gf[i][e]; const float sg = zg / (1.0f + __expf(-zg));
                    ab32[(size_t)((cidx >> 7) * 4 + i) * D + 512 + h * 128 + lane + 64 * e] = o[i][e] * rs * gla_og[h * 128 + lane + 64 * e] * sg; } }
        }
    }
    __syncthreads();
    {
        const int it = wave >> 1;
#pragma unroll
        for (int jj = 0; jj < 2; ++jj) {
            const int jt = 2 * (wave & 1) + jj;
            f32x4 s = (f32x4){0.f, 0.f, 0.f, 0.f};
            if (jt <= it) {
                bf16x8 a[2], b[2];
#pragma unroll
                for (int ks = 0; ks < 2; ++ks) {
                    a[ks] = *(const LAS bf16x8*)(lds + G_QE + (16 * it + x) * G_ROW + (ks * 32 + 8 * g) * 2);
                    b[ks] = *(const LAS bf16x8*)(lds + G_KE + (16 * jt + x) * G_ROW + (ks * 32 + 8 * g) * 2); }
                FRAG_WAIT();
                s = MFMA16(a[0], b[0], s); s = MFMA16(a[1], b[1], s);
            }
#pragma unroll
            for (int r = 0; r < 4; ++r) { const int i = 16 * it + 4 * g + r, j = 16 * jt + x;
                float sv = (j <= i) ? s[r] : 0.f;
                if (hp && i < HP_R && j < HP_R) sv = ((const LAS float*)(lds + G_SC))[i * 4 + j];
                *(LAS bf16*)(lds + G_P + i * G_ROW + 2 * j) = (bf16)f2bf(sv); }
        }
    }
    __syncthreads();
    if (wave < 4) {
        f32x4 acc[8];
#pragma unroll
        for (int vt = 0; vt < 8; ++vt) acc[vt] = (f32x4){0.f, 0.f, 0.f, 0.f};
        {
            bf16x8 a[2], b[2][8];
#pragma unroll
            for (int ks = 0; ks < 2; ++ks) {
                a[ks] = *(const LAS bf16x8*)(lds + G_P + (16 * wave + x) * G_ROW + (ks * 32 + 8 * g) * 2);
#pragma unroll
                for (int vt = 0; vt < 8; ++vt) b[ks][vt] = *(const LAS bf16x8*)(lds + G_VT + (vt * 16 + x) * G_ROW + (ks * 32 + 8 * g) * 2); }
            FRAG_WAIT();
#pragma unroll
            for (int ks = 0; ks < 2; ++ks)
#pragma unroll
                for (int vt = 0; vt < 8; ++vt) acc[vt] = MFMA16(a[ks], b[ks][vt], acc[vt]);
        }
#pragma unroll
        for (int r = 0; r < 4; ++r) { float t[8];
#pragma unroll
            for (int vt = 0; vt < 8; ++vt) t[vt] = acc[vt][r];
            *(v4u*)(oi_g + (rbase + 16 * wave + 4 * g + r) * 512 + h * 128 + 8 * x) = pack8(t); }
    } else {
        const int w2 = wave - 4;
        f32x4 acc[2][4];
#pragma unroll
        for (int a = 0; a < 2; ++a)
#pragma unroll
            for (int dt = 0; dt < 4; ++dt) acc[a][dt] = (f32x4){0.f, 0.f, 0.f, 0.f};
        {
            bf16x8 b[2][4], av[2][2];
#pragma unroll
            for (int ks = 0; ks < 2; ++ks) {
#pragma unroll
                for (int dt = 0; dt < 4; ++dt) b[ks][dt] = *(const LAS bf16x8*)(lds + G_KDT + (16 * dt + x) * G_ROW + (ks * 32 + 8 * g) * 2);
#pragma unroll
                for (int a = 0; a < 2; ++a) av[ks][a] = *(const LAS bf16x8*)(lds + G_VT + (16 * (2 * w2 + a) + x) * G_ROW + (ks * 32 + 8 * g) * 2); }
            FRAG_WAIT();
#pragma unroll
            for (int ks = 0; ks < 2; ++ks)
#pragma unroll
                for (int a = 0; a < 2; ++a)
#pragma unroll
                    for (int dt = 0; dt < 4; ++dt) acc[a][dt] = MFMA16(av[ks][a], b[ks][dt], acc[a][dt]);
        }
#pragma unroll
        for (int a = 0; a < 2; ++a)
#pragma unroll
            for (int dt = 0; dt < 4; ++dt)
#pragma unroll
                for (int r = 0; r < 4; ++r) { const int v = 8 * (4 * g + r) + (2 * w2 + a); upd_g[(size_t)sidx * 8192 + v * 64 + 16 * dt + x] = acc[a][dt][r]; }
    }
    __syncthreads();
}

__device__ __forceinline__ void gla_scan(const float* __restrict__ upd_g, const float* __restrict__ dec_g, bf16* __restrict__ sp_g, int gtid, int ngt) {
    for (int e = gtid; e < 16 * 8192; e += ngt) {
        const int bh = e >> 13, off = e & 8191, d = off & 63;
        float S = 0.f;
#pragma unroll 16
        for (int n = 0; n < 128; ++n) {
            const size_t s = (size_t)bh * 128 + n;
            const float u = upd_g[s * 8192 + off], dc = dec_g[s * 64 + d];
            sp_g[s * 8192 + off] = (bf16)f2bf(S);
            S = dc * S + u;
        }
    }
}

__device__ __forceinline__ void gla3_unit(LAS unsigned char* scr, const bf16* z, const bf16* qe_g, const bf16* oi_g, const bf16* sp_g, const float* out_g, bf16* ab, int unit, int it, int lane) {
    const int x = lane & 15, g = lane >> 4;
    const int cidx = unit >> 2, h = unit & 3;
    const size_t rbase = (size_t)cidx * 64;
    const int sidx = ((cidx >> 7) * 4 + h) * 128 + (cidx & 127);
    f32x4 acc[8];
#pragma unroll
    for (int vt = 0; vt < 8; ++vt) acc[vt] = (f32x4){0.f, 0.f, 0.f, 0.f};
    {
        bf16x8 a[2], b[2][8];
#pragma unroll
        for (int ks = 0; ks < 2; ++ks) {
            a[ks] = *(const bf16x8*)(qe_g + (rbase + 16 * it + x) * 256 + h * 64 + ks * 32 + 8 * g);
#pragma unroll
            for (int vt = 0; vt < 8; ++vt) b[ks][vt] = *(const bf16x8*)(sp_g + (size_t)sidx * 8192 + (8 * x + vt) * 64 + ks * 32 + 8 * g); }
        FRAG_WAIT();
#pragma unroll
        for (int ks = 0; ks < 2; ++ks)
#pragma unroll
            for (int vt = 0; vt < 8; ++vt) acc[vt] = MFMA16(a[ks], b[ks][vt], acc[vt]);
    }
    const f32x4 ga = *(const f32x4*)(out_g + h * 128 + 8 * x), gb = *(const f32x4*)(out_g + h * 128 + 8 * x + 4);
    const float gg[8] = {ga.x, ga.y, ga.z, ga.w, gb.x, gb.y, gb.z, gb.w};
    float ss[4];
#pragma unroll
    for (int r = 0; r < 4; ++r) {
        const size_t row = rbase + 16 * it + 4 * g + r;
        float oi[8]; unpack8(*(const v4u*)(oi_g + row * 512 + h * 128 + 8 * x), oi);
        float s = 0.f;
#pragma unroll
        for (int vt = 0; vt < 8; ++vt) { const float o = acc[vt][r] + oi[vt]; acc[vt][r] = o; s += o * o; }
        ss[r] = s;
    }
    row16_sum4_lds(scr, ss, lane);
#pragma unroll
    for (int r = 0; r < 4; ++r) {
        const size_t row = rbase + 16 * it + 4 * g + r;
        float zg[8]; unpack8(*(const v4u*)(z + row * NZ + ZG + h * 128 + 8 * x), zg);
        const float rstd = 1.0f / sqrtf(ss[r] * (1.0f / 128.0f) + EPS);
        float t[8];
#pragma unroll
        for (int vt = 0; vt < 8; ++vt) { const float sg = zg[vt] / (1.0f + __expf(-zg[vt])); t[vt] = acc[vt][r] * rstd * gg[vt] * sg; }
        *(v4u*)(ab + row * D + 512 + h * 128 + 8 * x) = pack8(t);
    }
}


#define RLX_AGENT __ATOMIC_RELAXED, __HIP_MEMORY_SCOPE_AGENT
constexpr int CW_BAR = 4096;
constexpr size_t CTL_ZERO_BYTES = 65536;
constexpr int LDS_MISC_OFF = LDS_BYTES - 64;
#define XB_TMO      128
#define XB_XCNT(j)  (256  + 64 * (j))
#define XB_XSUB(j)  (1280 + 64 * (j))
#define XB_XGEN(j)  (2304 + 64 * (j))
#define XB_TOP      3328
#define XB_TOPGEN   3392
#define XCD_BAR_WORDS 3456
#define XB_SPIN_CAP (1u << 18)

__device__ __forceinline__ unsigned xb_ld(unsigned* p)              { return __hip_atomic_load(p, __ATOMIC_RELAXED, __HIP_MEMORY_SCOPE_AGENT); }
__device__ __forceinline__ unsigned xb_add(unsigned* p, unsigned v) { return __hip_atomic_fetch_add(p, v, __ATOMIC_RELAXED, __HIP_MEMORY_SCOPE_AGENT); }
__device__ __forceinline__ unsigned xb_xcc_id() { return (unsigned)__builtin_amdgcn_s_getreg((3 << 11) | 20) & 0xFu; }
#define XB_SPIN(cond, bar) do { unsigned _sp = 0; while (cond) { __builtin_amdgcn_s_sleep(1); \
    if ((++_sp & 255u) == 0u) { if (xb_ld(&(bar)[XB_TMO])) break; if (_sp > XB_SPIN_CAP) { atomicAdd(&(bar)[XB_TMO], 1u); break; } } } } while (0)

struct XcdBarrier {
    unsigned* bar; unsigned x;
    volatile LAS unsigned* st;
};

__device__ __forceinline__ XcdBarrier xcd_barrier_post(unsigned* bar, volatile LAS unsigned* st) {
    XcdBarrier b; b.bar = bar; b.x = xb_xcc_id(); b.st = st;
    if (threadIdx.x == 0) (void)xb_add(&bar[XB_XCNT(b.x)], 1u);
    return b;
}
__device__ __forceinline__ void xcd_barrier_complete(unsigned* bar, unsigned x, unsigned& nloc, unsigned& nx) {
    const unsigned G = gridDim.x * gridDim.y * gridDim.z;
    unsigned sum, cnt, mine, sp = 0u;
    for (;;) {
        sum = 0u; cnt = 0u; mine = 0u;
#pragma unroll
        for (unsigned j = 0; j < 16; ++j) { const unsigned c = xb_ld(&bar[XB_XCNT(j)]); sum += c; cnt += (c > 0u) ? 1u : 0u; mine = (j == x) ? c : mine; }
        if (sum == G) break;
        __builtin_amdgcn_s_sleep(1);
        if ((++sp & 255u) == 0u) { if (xb_ld(&bar[XB_TMO])) break; if (sp > XB_SPIN_CAP) { atomicAdd(&bar[XB_TMO], 1u); break; } }
    }
    nloc = mine > 0u ? mine : 1u; nx = cnt > 0u ? cnt : 1u;
}

__device__ __forceinline__ void xcd_barrier(const XcdBarrier& b) {
    asm volatile("s_waitcnt vmcnt(0)" ::: "memory");
    __syncthreads();
    if (threadIdx.x == 0) {
        unsigned* bar = b.bar;
        __builtin_amdgcn_s_waitcnt(0);
        unsigned nloc = b.st[0], nx = b.st[1];
        if (nloc == 0u) { xcd_barrier_complete(bar, b.x, nloc, nx); b.st[0] = nloc; b.st[1] = nx; }
        const unsigned old = xb_add(&bar[XB_XSUB(b.x)], 1u);
        const unsigned gen = old / nloc;
        if (old + 1u == (gen + 1u) * nloc) {
            __builtin_amdgcn_fence(__ATOMIC_RELEASE, "agent");
            asm volatile("s_waitcnt vmcnt(0)" ::: "memory");
            const unsigned og = xb_add(&bar[XB_TOP], 1u);
            const unsigned tg = og / nx;
            if (og + 1u == (tg + 1u) * nx) xb_add(&bar[XB_TOPGEN], 1u);
            else XB_SPIN(xb_ld(&bar[XB_TOPGEN]) == tg, bar);
            __builtin_amdgcn_fence(__ATOMIC_ACQUIRE, "agent");
            xb_add(&bar[XB_XGEN(b.x)], 1u);
            asm volatile("s_waitcnt vmcnt(0)" ::: "memory");
        } else {
            XB_SPIN(xb_ld(&bar[XB_XGEN(b.x)]) == gen, bar);
            __builtin_amdgcn_fence(__ATOMIC_ACQUIRE, "agent");
            asm volatile("s_waitcnt vmcnt(0)" ::: "memory");
        }
    }
    __syncthreads();
}

#ifndef STOP_AT
#define STOP_AT 0
#endif
#define DUMP_BF16(src, ncol_src, coff) do { xcd_barrier(bar); for (size_t i_ = (size_t)bid * NTHR + threadIdx.x; i_ < (size_t)M * D; i_ += (size_t)G * NTHR) { const size_t r_ = i_ >> 10, c_ = i_ & 1023; out[i_] = bf1((src)[r_ * (ncol_src) + (coff) + c_]); } return; } while (0)
#ifndef GMLP_DBG
#define GMLP_DBG 0
#endif
#ifndef DUP_GEMM
#define DUP_GEMM 0
#endif
#ifndef DUP_MASK
#define DUP_MASK 0
#endif
#ifndef SEAM_REPEAT
#define SEAM_REPEAT 1
#endif
#define SEAM() xcd_barrier(bar)
struct Args { const float* in[17]; float* out; unsigned char* ws; int ph_lo, ph_hi; };
__global__ void __launch_bounds__(NTHR, 2) fwd_megakernel(Args args) {
    extern __shared__ __attribute__((aligned(16))) unsigned char lds_raw[];
    cg::grid_group grid = cg::this_grid();
    LAS unsigned char* lds = (LAS unsigned char*)lds_raw;
    const int G = gridDim.x, bid = blockIdx.x, ngw = G * NWAVES;
    volatile LAS unsigned* MISC = (volatile LAS unsigned*)(lds + LDS_MISC_OFF);
    if (threadIdx.x < 16) MISC[threadIdx.x] = 0u;
    __syncthreads();
    XcdBarrier bar = xcd_barrier_post((unsigned*)(args.ws) + CW_BAR, MISC);
    grid.sync();
#define PHASE_IDS() int tid = threadIdx.x; asm volatile("" : "+v"(tid)); const int lane = tid & 63, wave = __builtin_amdgcn_readfirstlane(tid >> 6), gw = bid * NWAVES + wave; (void)lane; (void)gw
    unsigned char* ws = args.ws;
    const float* x = args.in[0];
    float* out = args.out;
    bf16* Wm = (bf16*)(ws + WS_WM);
    float* dec_g = (float*)(ws + WS_DEC);
    bf16* zb = (bf16*)(ws + WS_Z); bf16* f1 = (bf16*)(ws + WS_F1); bf16* ab = (bf16*)(ws + WS_AB); bf16* qe_g = (bf16*)(ws + WS_QE);
    bf16* yb = (bf16*)(ws + WS_Y); bf16* sp_g = (bf16*)(ws + WS_SP); bf16* oi_g = (bf16*)(ws + WS_OI); bf16* mmb = (bf16*)(ws + WS_MM); float* upd_g = (float*)(ws + WS_UPD);

    float* M32 = (float*)(ws + WS_HP); float* Y32 = M32 + 16 * 1024; float* F1_32 = Y32 + 16 * 1024; float* F32o = F1_32 + 16 * 4096; float* AB32 = F32o + 16 * 1024; float* HPP = (float*)(ws + WS_HP + 2 * MiB); float* HPU = (float*)(ws + WS_HP + 11 * MiB); float* YH32 = (float*)(ws + WS_HP + 1 * MiB); float* QKVG32 = YH32 + 16 * 1024; float* MIXP = (float*)(ws + WS_HP + 12 * MiB); float* ZUP = (float*)(ws + WS_HP + 13 * MiB);
    {
        PHASE_IDS();
        LAS float* scr = (LAS float*)(lds + wave * 16384);
        constexpr int I_IN = 16 * 80, I_OUT = 16 * 32, I_1 = 16 * 128, I_2 = 64 * 32, I_G = 512, I_L = I_IN + I_OUT + I_1 + I_2 + I_G;
        for (int it = gw; it < DEPTH * I_L; it += ngw) {
            const int l = it / I_L; int r = it % I_L;
            bf16* WinT = (bf16*)(ws + WS_W + l * W_LAYER_B); bf16* WoutT = (bf16*)(ws + WS_W + l * W_LAYER_B + W_IN_B); bf16* W1T = (bf16*)(ws + WS_W + l * W_LAYER_B + W_IN_B + W_OUT_B); bf16* W2T = (bf16*)(ws + WS_W + l * W_LAYER_B + W_IN_B + W_OUT_B + W_1_B);
            const float* w_in = args.in[2] + (size_t)l * D * D_IN; const float* pre_g = args.in[1] + l * D;
            if (r < I_IN) { p0_transpose_item(w_in, D_IN, 2560, D, WinT, pre_g, ZQ, ZK, scr, r, lane); continue; } r -= I_IN;
            if (r < I_OUT) { p0_transpose_item(args.in[11] + (size_t)l * D * D, D, D, D, WoutT, nullptr, 0, 0, scr, r, lane); continue; } r -= I_OUT;
            if (r < I_1) { p0_transpose_item(args.in[14] + (size_t)l * D * FF, FF, FF, D, W1T, args.in[13] + l * D, 0, 0, scr, r, lane); continue; } r -= I_1;
            if (r < I_2) { p0_transpose_item(args.in[15] + (size_t)l * FF * D, D, D, FF, W2T, nullptr, 0, 0, scr, r, lane); continue; } r -= I_2;
            p0_gate_item(w_in, args.in[8] + (size_t)l * 16 * 256, pre_g, WinT, r, lane);
        }
        const float* wsrc = args.in[5];
        for (int i = bid * NTHR + tid; i < DEPTH * 4 * 128 * 128; i += G * NTHR) { const int ii = (i >> 7) & 127, jj = i & 127; Wm[i] = ((ii >> 6) >= (jj >> 6)) ? (bf16)f2bf(wsrc[i]) : (bf16)0; }
        rows_phase(lds + wave * 16384, x, nullptr, nullptr, nullptr, yb, gw, ngw, lane, nullptr, YH32, args.in[1]);
    }
    SEAM();

#pragma unroll 1
    for (int l = 0; l < DEPTH; ++l) {
        const bf16* WinT = (const bf16*)(ws + WS_W + l * W_LAYER_B); const bf16* WoutT = (const bf16*)(ws + WS_W + l * W_LAYER_B + W_IN_B);
        const bf16* W1T = (const bf16*)(ws + WS_W + l * W_LAYER_B + W_IN_B + W_OUT_B); const bf16* W2T = (const bf16*)(ws + WS_W + l * W_LAYER_B + W_IN_B + W_OUT_B + W_1_B);
        { PHASE_IDS(); pg8::Gemm gm{yb, WinT, M, NZ, D}; pg8::StaticOrder S; S.init(M, NZ, G, bid); pg8::EpiAct<1> E{zb, NZ, 4};
          pg8::gemm_phase<pg8::EpiAct<1>, pg8::StaticOrder, true, true>(lds, gm, S, E, tid);
          hp_gemv_phase<0>(lds, YH32, D, args.in[2] + (size_t)l * D * D_IN + ZQ, D_IN, 1536, QKVG32, G, bid, wave, lane, tid); }
        SEAM();
        if (STOP_AT == 1) DUMP_BF16(zb, NZ, 0);
        if (STOP_AT == 2) DUMP_BF16(zb, NZ, 1792);
        if (STOP_AT == 30) {
            const int lane_ = threadIdx.x & 63, wave_ = threadIdx.x >> 6;
            for (int u = bid; u < M / 128; u += G)
                for (int t_ = 0; t_ < 16; ++t_) { const size_t row_ = (size_t)u * 128 + 16 * wave_ + t_;
                    *(v4u*)(ab + row_ * D + 8 * lane_) = *(const v4u*)(zb + row_ * NZ + ZV + 8 * lane_); }
            xcd_barrier(bar); for (size_t i_ = (size_t)bid * NTHR + threadIdx.x; i_ < (size_t)M * D; i_ += (size_t)G * NTHR) { const size_t r_ = i_ >> 10, c_ = i_ & 511; out[i_] = bf1(ab[r_ * D + c_]); } return; }
        { PHASE_IDS();
        for (int u = bid; u < M / 128; u += G)
            gmlp_unit(lds, AB32, zb, ab, Wm + (size_t)l * 4 * 16384, args.in[3] + l * 512, args.in[4] + l * 512, args.in[6] + l * 512, args.in[7] + l * 512, u, tid);
        if (STOP_AT == 14) { xcd_barrier(bar); for (size_t i_ = (size_t)bid * NTHR + threadIdx.x; i_ < (size_t)M * D; i_ += (size_t)G * NTHR) { out[i_] = bf1(Wm[i_ & 262143]); } return; }
        if (STOP_AT >= 20 && STOP_AT < 24) { xcd_barrier(bar); for (size_t i_ = (size_t)bid * NTHR + threadIdx.x; i_ < (size_t)M * D; i_ += (size_t)G * NTHR) { const size_t r_ = i_ >> 10, c_ = i_ & 127; out[i_] = bf1(ab[r_ * D + (STOP_AT - 20) * 128 + c_]); } return; }
        if (STOP_AT == 13) { xcd_barrier(bar); for (size_t i_ = (size_t)bid * NTHR + threadIdx.x; i_ < (size_t)M * D; i_ += (size_t)G * NTHR) { const size_t r_ = i_ >> 10, c_ = i_ & 511; out[i_] = bf1(ab[r_ * D + c_]); } return; }
        }
        { PHASE_IDS();
        for (int t = bid; t < 256; t += G) gmlp_hp1(lds, l == 0 ? x : out, args.in[2] + (size_t)l * D * D_IN, args.in[1] + l * D, HPP, HPU, t >> 6, (t >> 2) & 15, t & 3, tid);
        }
        { PHASE_IDS();
        for (int ui = 0; ui * G < NCHUNK * 4; ++ui) { const int u = (G == 256) ? (256 * ui + ((bid + 4 * ui) & 255)) : (ui * G + bid); if (u >= NCHUNK * 4) break;
            gla1_unit(lds, QKVG32, args.in[2] + (size_t)l * D * D_IN, args.in[1] + l * D, args.in[10] + l * 512, AB32, zb, args.in[9] + l * 256, qe_g, oi_g, upd_g, dec_g, u, tid); } }
        SEAM();
        { PHASE_IDS(); gla_scan(upd_g, dec_g, sp_g, bid * NTHR + tid, G * NTHR); }
        { PHASE_IDS();
          for (int t = bid; t < 64; t += G) gmlp_hp2a(lds, l == 0 ? x : out, args.in[5] + (size_t)l * 4 * 16384, args.in[3] + l * 512, args.in[4] + l * 512, HPP, HPU, MIXP, ZUP, t >> 4, t & 15, tid); }
        SEAM();
        { PHASE_IDS();
        for (int pu = bid; pu < NCHUNK * 2; pu += G)
            gla3_unit(lds + wave * 1024, zb, qe_g, oi_g, sp_g, args.in[10] + l * 512, ab, 2 * pu + (wave >> 2), wave & 3, lane); }
        { PHASE_IDS();
          for (int b4 = bid; b4 < BATCH; b4 += G) gmlp_hp2b(lds, args.in[6] + l * 512, args.in[7] + l * 512, MIXP, ZUP, AB32, b4, tid); }
        SEAM();
        if (STOP_AT == 3) DUMP_BF16(ab, D, 0);
        if (STOP_AT == 8) { xcd_barrier(bar); for (size_t i_ = (size_t)bid * NTHR + threadIdx.x; i_ < (size_t)M * D; i_ += (size_t)G * NTHR) { const size_t r_ = i_ >> 10, c_ = i_ & 511; out[i_] = bf1(ab[r_ * D + c_]); } return; }
        if (STOP_AT == 9) { xcd_barrier(bar); for (size_t i_ = (size_t)bid * NTHR + threadIdx.x; i_ < (size_t)M * D; i_ += (size_t)G * NTHR) { const size_t r_ = i_ >> 10, c_ = i_ & 511; out[i_] = bf1(ab[r_ * D + 512 + c_]); } return; }
        if (STOP_AT == 10) { xcd_barrier(bar); for (size_t i_ = (size_t)bid * NTHR + threadIdx.x; i_ < (size_t)M * D; i_ += (size_t)G * NTHR) { const size_t r_ = i_ >> 10, c_ = i_ & 511; out[i_] = bf1(oi_g[r_ * 512 + c_]); } return; }
        if (STOP_AT == 11) { xcd_barrier(bar); for (size_t i_ = (size_t)bid * NTHR + threadIdx.x; i_ < (size_t)M * D; i_ += (size_t)G * NTHR) { out[i_] = bf1(sp_g[i_ & (size_t)(2048 * 8192 - 1)]); } return; }
        if (STOP_AT == 12) { xcd_barrier(bar); for (size_t i_ = (size_t)bid * NTHR + threadIdx.x; i_ < (size_t)M * D; i_ += (size_t)G * NTHR) { out[i_] = upd_g[i_ & (size_t)(2048 * 8192 - 1)]; } return; }
        { PHASE_IDS(); pg8::Gemm gm{ab, WoutT, M, D, D}; pg8::StaticOrder S; S.init(M, D, G, bid); pg8::EpiAct<0> E{mmb, D, 0};
          pg8::gemm_phase<pg8::EpiAct<0>, pg8::StaticOrder, true, true>(lds, gm, S, E, tid);
          hp_gemv_phase<0>(lds, AB32, D, args.in[11] + (size_t)l * D * D, D, D, M32, G, bid, wave, lane, tid); }
        SEAM();
        if (STOP_AT == 4) DUMP_BF16(mmb, D, 0);
        { PHASE_IDS(); rows_phase(lds + wave * 1024, l == 0 ? x : out, mmb, args.in[12] + l * D, out, yb, gw, ngw, lane, M32, Y32, args.in[13] + l * D); }
        SEAM();
        if (STOP_AT == 5) DUMP_BF16(yb, D, 0);
        { PHASE_IDS(); pg8::Gemm gm{yb, W1T, M, FF, D}; pg8::StaticOrder S; S.init(M, FF, G, bid); pg8::EpiAct<2> E{f1, FF, 0};
          pg8::gemm_phase<pg8::EpiAct<2>, pg8::StaticOrder, true, true>(lds, gm, S, E, tid);
          hp_gemv_phase<2>(lds, Y32, D, args.in[14] + (size_t)l * D * FF, FF, FF, F1_32, G, bid, wave, lane, tid); }
        SEAM();
        { PHASE_IDS(); pg8::Gemm gm{f1, W2T, M, D, FF}; pg8::StaticOrder S; S.init(M, D, G, bid); pg8::EpiAct<0> E{mmb, D, 0};
          pg8::gemm_phase<pg8::EpiAct<0>, pg8::StaticOrder, true, true>(lds, gm, S, E, tid);
          hp_gemv_phase<0>(lds, F1_32, FF, args.in[15] + (size_t)l * FF * D, D, D, F32o, G, bid, wave, lane, tid); }
        SEAM();
        if (STOP_AT == 6) DUMP_BF16(mmb, D, 0);
        if (STOP_AT == 7) DUMP_BF16(f1, FF, 0);
        { PHASE_IDS(); rows_phase(lds + wave * 1024, out, mmb, args.in[16] + l * D, out, (l + 1 < DEPTH) ? yb : nullptr, gw, ngw, lane, F32o, YH32, args.in[1] + (l + 1 < DEPTH ? l + 1 : l) * D); }
        if (l + 1 < DEPTH) SEAM();
    }
}

extern "C" void kernel_launch(void* const* d_in, const int* in_sizes, int n_in, void* d_out, int out_size, void* d_ws, size_t ws_size, hipStream_t stream) {
    static int grid = 0;
    if (grid == 0) {
        if (n_in != 17 || out_size != M * D || ws_size < WS_END) { fprintf(stderr, "kernel_launch: unexpected problem (n_in %d, out %d, ws %zu)\n", n_in, out_size, ws_size); grid = -1; return; }
        int dev = 0, cus = 0, per_cu = 0;
        hipGetDevice(&dev); hipDeviceGetAttribute(&cus, hipDeviceAttributeMultiprocessorCount, dev);
        hipFuncSetAttribute((const void*)fwd_megakernel, hipFuncAttributeMaxDynamicSharedMemorySize, LDS_BYTES);
        if (hipOccupancyMaxActiveBlocksPerMultiprocessor(&per_cu, (const void*)fwd_megakernel, NTHR, LDS_BYTES) != hipSuccess || per_cu < 1) per_cu = 1;
        (void)hipGetLastError();
        grid = cus * per_cu;
    }
    if (grid < 0) return;
    if (hipMemsetAsync(d_ws, 0, CTL_ZERO_BYTES, stream) != hipSuccess) { fprintf(stderr, "kernel_launch: memset failed\n"); return; }
    Args a{};
    for (int i = 0; i < 17; ++i) a.in[i] = (const float*)d_in[i];
    a.out = (float*)d_out; a.ws = (unsigned char*)d_ws; a.ph_lo = 0; a.ph_hi = 0;
    void* kargs[] = {&a};
    hipError_t e = hipLaunchCooperativeKernel((const void*)fwd_megakernel, dim3(grid), dim3(NTHR), kargs, LDS_BYTES, stream);
    if (e != hipSuccess) fprintf(stderr, "cooperative launch failed: %s (grid %d)\n", hipGetErrorString(e), grid);
}
```

```cpp
#include <hip/hip_runtime.h>
#include <hip/hip_cooperative_groups.h>
#include <cstdio>
#include <cstdint>
namespace cg = cooperative_groups;
namespace pg8 {
#define PG8_LAS __attribute__((address_space(3)))
typedef unsigned short bf16_t;
typedef short bf16x8 __attribute__((ext_vector_type(8)));
typedef float f32x4 __attribute__((ext_vector_type(4)));
typedef unsigned u32x4 __attribute__((ext_vector_type(4)));
constexpr int BM = 256, BK = 64, HALF = 128, HTB = HALF * BK * 2  , STAGE_BYTES = 8 * HTB, NXCD = 8, WGM = 8;

__host__ __device__ __forceinline__ int lds_byte(int r, int c) { const int st = (r >> 4) * 2 + (c >> 5), rr = r & 15, cc = c & 31, ob = rr * 64 + cc * 2; return st * 1024 + (ob ^ (((ob >> 9) & 1) << 5)); }
__host__ __device__ __forceinline__ void stage_rc(int b, int& R, int& C) { const int st = b / 1024, sb = b % 1024, swz = sb ^ (((sb >> 9) & 1) << 5); R = (st >> 1) * 16 + swz / 64; C = (st & 1) * 32 + (swz % 64) / 2; }
__host__ __device__ __forceinline__ int perm32(int rho) { const int n = rho >> 4, i = rho & 15; return 8 * (i >> 2) + 4 * n + (i & 3); }

struct Unit { int pm, pn; };
struct Gemm { const bf16_t* A; const bf16_t* Bt; int M, N, K; };

struct StaticOrder {
    int nM, nN, nwg, G, c;
    __host__ __device__ void init(int M, int N, int G_, int c_) { nM = M / BM; nN = N / BM; nwg = nM * nN; G = G_; c = c_; }
    __host__ __device__ bool next(int i, Unit& u) const {
        const long L = (long)i * G + c; if (L >= nwg) return false;
        int wgid = (int)L; { const int q = nwg / NXCD, r = nwg % NXCD, xcd = wgid % NXCD, off = wgid / NXCD; wgid = (xcd < r ? xcd * (q + 1) : r * (q + 1) + (xcd - r) * q) + off; }
        const int nig = WGM * nN, gid = wgid / nig, fm = gid * WGM, gsz = (nM - fm) < WGM ? (nM - fm) : WGM;
        u.pm = fm + ((wgid % nig) % gsz); u.pn = (wgid % nig) / gsz; return true;
    }
    __device__ __forceinline__ void a_ready(const Unit&) const {}
    __device__ __forceinline__ void done(const Unit&) const {}
};

typedef __bf16 hwbf2e __attribute__((ext_vector_type(2)));
typedef float hwf2e __attribute__((ext_vector_type(2)));
__device__ __forceinline__ unsigned cvt_pk_bf16(float lo, float hi) { const hwf2e v = {lo, hi}; return __builtin_bit_cast(unsigned, __builtin_convertvector(v, hwbf2e)); }
__device__ __forceinline__ float gelu_tanh(float x) {
    const float u = x * (0.7978845608028654f + 0.035677408136300125f * x * x);
    const float e = __builtin_amdgcn_exp2f(u * -2.885390081777927f);
    return x * __builtin_amdgcn_rcpf(1.0f + e);
}
template <int ACT> struct EpiAct {
    static constexpr bool PERM = true, AFTER_DRAIN = false;
    bf16_t* O; int ldc; int act_tiles;
    __device__ __forceinline__ void operator()(const f32x4 (&acc)[2][2][4][2], const Unit& u, int wr, int wc, int fr, int fq) const {
        const int row0 = u.pm * BM + wr * 64 + fr; const int col0 = u.pn * BM + wc * 32 + 8 * fq;
        const bool act = (ACT == 1) ? (u.pn < act_tiles) : true;
#pragma unroll
        for (int ai = 0; ai < 2; ++ai)
#pragma unroll
            for (int m = 0; m < 4; ++m) { bf16_t* rowp = O + (size_t)(row0 + ai * HALF + m * 16) * ldc + col0;
#pragma unroll
                for (int bj = 0; bj < 2; ++bj) { f32x4 v0 = acc[ai][bj][m][0], v1 = acc[ai][bj][m][1];
                    if (ACT == 1) { if (act) {
#pragma unroll
                        for (int e = 0; e < 4; ++e) { v0[e] = gelu_tanh(v0[e]); v1[e] = gelu_tanh(v1[e]); } } }
                    if (ACT == 2) {
#pragma unroll
                        for (int e = 0; e < 4; ++e) { const float a = fmaxf(v0[e], 0.f), b = fmaxf(v1[e], 0.f); v0[e] = a * a; v1[e] = b * b; } }
                    u32x4 w; w.x = cvt_pk_bf16(v0[0], v0[1]); w.y = cvt_pk_bf16(v0[2], v0[3]); w.z = cvt_pk_bf16(v1[0], v1[1]); w.w = cvt_pk_bf16(v1[2], v1[3]);
                    *(u32x4*)(rowp + bj * HALF) = w; } }
    }
};

template <class Epi, class Sched, bool ALIGN_EPI = false, bool SP2 = false>
__device__ __forceinline__ void gemm_phase(PG8_LAS unsigned char* lds, const Gemm g, const Sched& S, const Epi& E, const int tid) {
    const int wid = __builtin_amdgcn_readfirstlane(tid >> 6), lane = tid & 63, wr = wid >> 2, wc = wid & 3, fr = lane & 15, fq = lane >> 4;
    const int K = g.K, nt = K / BK;
    unsigned voffA[2], voffB[2];
#pragma unroll
    for (int i = 0; i < 2; ++i) { int R, C; stage_rc(tid * 16 + i * 8192, R, C); const int Rb = Epi::PERM ? ((R & ~31) + perm32(R & 31)) : R;
        voffA[i] = (unsigned)(R * K + C) * 2u; voffB[i] = (unsigned)(Rb * K + C) * 2u; }
    const size_t kstep = (size_t)(BK * 2);
    const size_t hstep = (size_t)HALF * K * 2;
    const size_t tstep = 2 * hstep;
    const unsigned ldsw = (unsigned)wid * 1024u;
    const int aoff = lds_byte(wr * 64 + fr, fq * 8), boff = lds_byte(wc * 32 + fr, fq * 8);
#define PG8_SA(b, h) (((b) * 2 + (h)) * HTB)
#define PG8_SB(b, h) ((4 + (b) * 2 + (h)) * HTB)
#define PG8_STAGE(bufoff, gbase, voff) do { _Pragma("unroll") for (int _i = 0; _i < 2; ++_i) \
        __builtin_amdgcn_global_load_lds((const unsigned*)((const char*)(gbase) + (voff)[_i]), (PG8_LAS unsigned*)(lds + (bufoff) + ldsw + _i * 8192), 16, 0, 0); } while (0)
#define PG8_LDA(dst, b, h) do { _Pragma("unroll") for (int m = 0; m < 4; ++m) _Pragma("unroll") for (int k = 0; k < 2; ++k) dst[m][k] = *(const PG8_LAS bf16x8*)(lds + PG8_SA(b, h) + aoff + m * 2048 + k * 1024); } while (0)
#define PG8_LDB(dst, b, h) do { _Pragma("unroll") for (int n = 0; n < 2; ++n) _Pragma("unroll") for (int k = 0; k < 2; ++k) dst[n][k] = *(const PG8_LAS bf16x8*)(lds + PG8_SB(b, h) + boff + n * 2048 + k * 1024); } while (0)
#define PG8_MMA(ai, bj, At, Bt) do { __builtin_amdgcn_s_setprio(1); _Pragma("unroll") for (int m = 0; m < 4; ++m) _Pragma("unroll") for (int n = 0; n < 2; ++n) _Pragma("unroll") for (int k = 0; k < 2; ++k) \
        acc[ai][bj][m][n] = __builtin_amdgcn_mfma_f32_16x16x32_bf16(Bt[n][k], At[m][k], acc[ai][bj][m][n], 0, 0, 0); __builtin_amdgcn_s_setprio(0); } while (0)
#define PG8_WAIT_V(n) asm volatile("s_waitcnt vmcnt(" #n ")" ::: "memory")
#define PG8_WAIT_L(n) asm volatile("s_waitcnt lgkmcnt(" #n ")" ::: "memory")
#define PG8_BAR __builtin_amdgcn_s_barrier()
#define PG8_SCHED __builtin_amdgcn_sched_barrier(0)
    Unit cur, nxt; int ui = 0;
    if (!S.next(0, cur)) return;
    f32x4 acc[2][2][4][2];
#pragma unroll
    for (int a = 0; a < 2; ++a)
#pragma unroll
        for (int b = 0; b < 2; ++b)
#pragma unroll
            for (int m = 0; m < 4; ++m)
#pragma unroll
                for (int n = 0; n < 2; ++n) acc[a][b][m][n] = (f32x4){0.f, 0.f, 0.f, 0.f};
    bf16x8 At[4][2], B0[2][2], B1[2][2];
    const char* cA = (const char*)g.A + (size_t)cur.pm * tstep; const char* cB = (const char*)g.Bt + (size_t)cur.pn * tstep;
    S.a_ready(cur);
    if constexpr (SP2) {
        PG8_STAGE(PG8_SB(0, 0), cB, voffB); PG8_STAGE(PG8_SB(0, 1), cB + hstep, voffB); PG8_STAGE(PG8_SA(0, 0), cA, voffA); PG8_STAGE(PG8_SA(0, 1), cA + hstep, voffA);
        if (wr == 1) PG8_BAR;
        PG8_WAIT_V(2); PG8_BAR;
        PG8_STAGE(PG8_SB(1, 0), cB + kstep, voffB); PG8_STAGE(PG8_SA(1, 0), cA + kstep, voffA); PG8_STAGE(PG8_SB(1, 1), cB + hstep + kstep, voffB);
        PG8_WAIT_V(6); PG8_BAR;
    } else {
        PG8_STAGE(PG8_SB(0, 0), cB, voffB); PG8_STAGE(PG8_SA(0, 0), cA, voffA); PG8_STAGE(PG8_SB(0, 1), cB + hstep, voffB); PG8_STAGE(PG8_SA(0, 1), cA + hstep, voffA);
        if (wr == 1) PG8_BAR;
        PG8_WAIT_V(4); PG8_BAR;
        PG8_STAGE(PG8_SB(1, 0), cB + kstep, voffB); PG8_STAGE(PG8_SA(1, 0), cA + kstep, voffA); PG8_STAGE(PG8_SB(1, 1), cB + hstep + kstep, voffB);
        PG8_WAIT_V(6); PG8_BAR;
    }
    for (;;) {
        const bool has_next = S.next(ui + 1, nxt);
        const char* nA = has_next ? (const char*)g.A + (size_t)nxt.pm * tstep : cA; const char* nB = has_next ? (const char*)g.Bt + (size_t)nxt.pn * tstep : cB;
        for (int t = 0; t < nt; t += 2) {
            const bool last = (t == nt - 2);
            const char* a1 = cA + (size_t)(t + 1) * kstep;
            const char* a2 = last ? nA : cA + (size_t)(t + 2) * kstep; const char* b2 = last ? nB : cB + (size_t)(t + 2) * kstep;
            const char* a3 = a2 + kstep; const char* b3 = b2 + kstep;
            if (last && has_next) S.a_ready(nxt);
            if constexpr (SP2) {
            PG8_LDB(B0, 0, 0); PG8_LDB(B1, 0, 1); PG8_SCHED; PG8_LDA(At, 0, 0); PG8_STAGE(PG8_SA(1, 1), a1 + hstep, voffA);
            PG8_WAIT_V(8); PG8_WAIT_L(0); PG8_BAR; PG8_MMA(0, 0, At, B0); PG8_MMA(0, 1, At, B1); PG8_BAR; PG8_SCHED;
            PG8_LDA(At, 0, 1); PG8_STAGE(PG8_SB(0, 0), b2, voffB); PG8_STAGE(PG8_SB(0, 1), b2 + hstep, voffB); PG8_STAGE(PG8_SA(0, 0), a2, voffA);
            PG8_WAIT_V(8); PG8_WAIT_L(0); PG8_BAR; PG8_MMA(1, 0, At, B0); PG8_MMA(1, 1, At, B1); PG8_BAR; PG8_SCHED;
            PG8_LDB(B0, 1, 0); PG8_LDB(B1, 1, 1); PG8_SCHED; PG8_LDA(At, 1, 0); PG8_STAGE(PG8_SA(0, 1), a2 + hstep, voffA);
            PG8_WAIT_V(8); PG8_WAIT_L(0); PG8_BAR; PG8_MMA(0, 0, At, B0); PG8_MMA(0, 1, At, B1); PG8_BAR; PG8_SCHED;
            PG8_LDA(At, 1, 1); PG8_STAGE(PG8_SB(1, 0), b3, voffB); PG8_STAGE(PG8_SB(1, 1), b3 + hstep, voffB); PG8_STAGE(PG8_SA(1, 0), a3, voffA);
            PG8_WAIT_V(8); PG8_WAIT_L(0); PG8_BAR; PG8_MMA(1, 0, At, B0); PG8_MMA(1, 1, At, B1); PG8_BAR; PG8_SCHED;
            } else {
            PG8_LDB(B0, 0, 0); PG8_SCHED; PG8_LDA(At, 0, 0); PG8_STAGE(PG8_SA(1, 1), a1 + hstep, voffA);
            PG8_WAIT_L(8); PG8_BAR; PG8_WAIT_L(0); PG8_MMA(0, 0, At, B0); PG8_BAR; PG8_SCHED;
            PG8_LDB(B1, 0, 1); PG8_STAGE(PG8_SB(0, 0), b2, voffB);
            PG8_BAR; PG8_WAIT_L(0); PG8_MMA(0, 1, At, B1); PG8_BAR;
            PG8_LDA(At, 0, 1); PG8_STAGE(PG8_SA(0, 0), a2, voffA);
            PG8_BAR; PG8_WAIT_L(0); PG8_MMA(1, 0, At, B0); PG8_BAR; PG8_SCHED;
            PG8_STAGE(PG8_SB(0, 1), b2 + hstep, voffB);
            PG8_WAIT_V(6); PG8_BAR; PG8_MMA(1, 1, At, B1); PG8_BAR;
            PG8_LDB(B0, 1, 0); PG8_SCHED; PG8_LDA(At, 1, 0); PG8_STAGE(PG8_SA(0, 1), a2 + hstep, voffA);
            PG8_WAIT_L(8); PG8_BAR; PG8_WAIT_L(0); PG8_MMA(0, 0, At, B0); PG8_BAR; PG8_SCHED;
            PG8_LDB(B1, 1, 1); PG8_STAGE(PG8_SB(1, 0), b3, voffB);
            PG8_BAR; PG8_WAIT_L(0); PG8_MMA(0, 1, At, B1); PG8_BAR;
            PG8_LDA(At, 1, 1); PG8_STAGE(PG8_SA(1, 0), a3, voffA);
            PG8_BAR; PG8_WAIT_L(0); PG8_MMA(1, 0, At, B0); PG8_BAR; PG8_SCHED;
            PG8_STAGE(PG8_SB(1, 1), b3 + hstep, voffB);
            PG8_WAIT_V(6); PG8_BAR; PG8_MMA(1, 1, At, B1); PG8_BAR;
            }
        }
        if constexpr (ALIGN_EPI) { if (wr == 0) PG8_BAR; }
        if constexpr (!Epi::AFTER_DRAIN) { E(acc, cur, wr, wc, fr, fq); S.done(cur); }
        if (!has_next) break;
#pragma unroll
        for (int a = 0; a < 2; ++a)
#pragma unroll
            for (int b = 0; b < 2; ++b)
#pragma unroll
                for (int m = 0; m < 4; ++m)
#pragma unroll
                    for (int n = 0; n < 2; ++n) acc[a][b][m][n] = (f32x4){0.f, 0.f, 0.f, 0.f};
        cur = nxt; cA = nA; cB = nB; ++ui;
        if constexpr (ALIGN_EPI) { if (wr == 1) PG8_BAR; }
    }
    PG8_WAIT_V(0);
    if constexpr (!ALIGN_EPI) { if (wr == 0) PG8_BAR; }
    PG8_BAR;
    if constexpr (Epi::AFTER_DRAIN) { E.fused(acc, cur, wr, wc, fr, fq, lds, wid, lane); S.done(cur); }
#undef PG8_SA
#undef PG8_SB
#undef PG8_STAGE
#undef PG8_LDA
#undef PG8_LDB
#undef PG8_MMA
#undef PG8_WAIT_V
#undef PG8_WAIT_L
#undef PG8_BAR
#undef PG8_SCHED
}
}

#ifndef GMLP_DBG
#define GMLP_DBG 0
#endif
constexpr int NWAVES = 8, NTHR = 512;
constexpr int BATCH = 4, SEQ = 8192, D = 1024, DEPTH = 4, M = BATCH * SEQ;
constexpr int D_IN = 2576, NZ = 2816;
constexpr int FF = 4096;
constexpr int ZU = 0, ZV = 512, ZQ = 1024, ZK = 1280, ZVB = 1536, ZG = 2048, ZP = 2560;
constexpr float EPS = 1e-6f;
constexpr int NCHUNK = M / 64;
constexpr size_t MiB = 1u << 20;
constexpr size_t WS_WM = 1 * MiB;
constexpr size_t WS_DEC = 1 * MiB + 512 * 1024;
constexpr size_t WS_W = 2 * MiB;
constexpr size_t W_IN_B = (size_t)NZ * D * 2, W_OUT_B = (size_t)D * D * 2, W_1_B = (size_t)FF * D * 2, W_2_B = (size_t)D * FF * 2, W_LAYER_B = W_IN_B + W_OUT_B + W_1_B + W_2_B;
constexpr size_t WS_F1 = 96 * MiB;
constexpr size_t WS_Z = 96 * MiB;
constexpr size_t WS_AB = 272 * MiB;
constexpr size_t WS_QE = 336 * MiB;
constexpr size_t WS_Y = 352 * MiB;
constexpr size_t WS_SP = 352 * MiB;
constexpr size_t WS_OI = 384 * MiB;
constexpr size_t WS_MM = 416 * MiB;
constexpr size_t WS_UPD = 416 * MiB;
constexpr size_t WS_HP = 480 * MiB;
constexpr size_t WS_END = 494 * MiB;
static_assert(WS_W + DEPTH * W_LAYER_B <= WS_F1, "weights fit");
constexpr int LDS_BYTES = 149504;

#define GAS __attribute__((address_space(1)))
#define LAS __attribute__((address_space(3)))
typedef unsigned short bf16;
typedef unsigned v4u __attribute__((ext_vector_type(4)));
typedef unsigned v2u __attribute__((ext_vector_type(2)));
typedef float f32x4 __attribute__((ext_vector_type(4)));
typedef short bf16x8 __attribute__((ext_vector_type(8)));
#define LDS_WAIT() asm volatile("s_waitcnt lgkmcnt(0)" ::: "memory")
#define MFMA_DRAIN() asm volatile("s_nop 15\n\ts_nop 15\n\ts_nop 15\n\ts_nop 15\n\ts_nop 15\n\ts_nop 15\n\ts_nop 15\n\ts_nop 15\n\ts_nop 15\n\ts_nop 15\n\ts_nop 15\n\ts_nop 15\n\ts_nop 15\n\ts_nop 15\n\ts_nop 15\n\ts_nop 15" ::: "memory")
#define FRAG_WAIT() __builtin_amdgcn_sched_barrier(0)
#define MFMA16(a, b, c) __builtin_amdgcn_mfma_f32_16x16x32_bf16((a), (b), (c), 0, 0, 0)

__device__ __forceinline__ unsigned f2bf(float f) { unsigned u = __builtin_bit_cast(unsigned, f); return (u + 0x7fffu + ((u >> 16) & 1u)) >> 16; }
typedef __bf16 hwbf2 __attribute__((ext_vector_type(2)));
typedef float hwf2 __attribute__((ext_vector_type(2)));
__device__ __forceinline__ unsigned pk2(float lo, float hi) { const hwf2 v = {lo, hi}; return __builtin_bit_cast(unsigned, __builtin_convertvector(v, hwbf2)); }
__device__ __forceinline__ float bflo(unsigned w) { return __builtin_bit_cast(float, w << 16); }
__device__ __forceinline__ float bfhi(unsigned w) { return __builtin_bit_cast(float, w & 0xffff0000u); }
__device__ __forceinline__ float bf1(bf16 h) { return __builtin_bit_cast(float, (unsigned)h << 16); }
__device__ __forceinline__ void unpack8(const v4u w, float (&o)[8]) { o[0] = bflo(w.x); o[1] = bfhi(w.x); o[2] = bflo(w.y); o[3] = bfhi(w.y); o[4] = bflo(w.z); o[5] = bfhi(w.z); o[6] = bflo(w.w); o[7] = bfhi(w.w); }
__device__ __forceinline__ v4u pack8(const float (&o)[8]) { v4u w; w.x = pk2(o[0], o[1]); w.y = pk2(o[2], o[3]); w.z = pk2(o[4], o[5]); w.w = pk2(o[6], o[7]); return w; }
__device__ __forceinline__ float wave_sum(float v) {
#pragma unroll
    for (int o = 1; o < 64; o <<= 1) v += __shfl_xor(v, o);
    return v;
}
__device__ __forceinline__ float row16_sum(float v) {
#pragma unroll
    for (int o = 1; o < 16; o <<= 1) v += __shfl_xor(v, o);
    return v;
}

__device__ __forceinline__ void row16_sum4_lds(LAS unsigned char* scr, float (&v)[4], int lane) {
    *(LAS f32x4*)(scr + lane * 16) = (f32x4){v[0], v[1], v[2], v[3]};
    asm volatile("s_waitcnt lgkmcnt(0)" ::: "memory");
    f32x4 s = (f32x4){0.f, 0.f, 0.f, 0.f};
#pragma unroll
    for (int k = 0; k < 16; ++k) s += *(const LAS f32x4*)(scr + ((lane & 48) + k) * 16);
    asm volatile("s_waitcnt lgkmcnt(0)" ::: "memory");
    v[0] = s.x; v[1] = s.y; v[2] = s.z; v[3] = s.w;
}

__device__ __forceinline__ float wave_sum_lds(LAS unsigned char* scr, float v, int lane) {
    *(LAS float*)(scr + lane * 4) = v;
    asm volatile("s_waitcnt lgkmcnt(0)" ::: "memory");
    f32x4 s = (f32x4){0.f, 0.f, 0.f, 0.f};
#pragma unroll
    for (int k = 0; k < 16; ++k) s += *(const LAS f32x4*)(scr + k * 16);
    asm volatile("s_waitcnt lgkmcnt(0)" ::: "memory");
    return (s.x + s.y) + (s.z + s.w);
}
__device__ __forceinline__ void wave_sum4_lds(LAS unsigned char* scr, float (&v)[4], int lane) {
    *(LAS f32x4*)(scr + lane * 16) = (f32x4){v[0], v[1], v[2], v[3]};
    asm volatile("s_waitcnt lgkmcnt(0)" ::: "memory");
    f32x4 s = (f32x4){0.f, 0.f, 0.f, 0.f};
#pragma unroll
    for (int k = 0; k < 16; ++k) s += *(const LAS f32x4*)(scr + ((lane & 48) + k) * 16);
    asm volatile("s_waitcnt lgkmcnt(0)" ::: "memory");
    if ((lane & 15) == 0) *(LAS f32x4*)(scr + (lane >> 4) * 16) = s;
    asm volatile("s_waitcnt lgkmcnt(0)" ::: "memory");
    const f32x4 t0 = *(const LAS f32x4*)(scr), t1 = *(const LAS f32x4*)(scr + 16), t2 = *(const LAS f32x4*)(scr + 32), t3 = *(const LAS f32x4*)(scr + 48);
    asm volatile("s_waitcnt lgkmcnt(0)" ::: "memory");
    const f32x4 t = (t0 + t1) + (t2 + t3);
    v[0] = t.x; v[1] = t.y; v[2] = t.z; v[3] = t.w;
}

constexpr int HPR = 4, HP_ROWS = 16;
__device__ __forceinline__ size_t hp_row(int r16) { return (size_t)(r16 >> 2) * SEQ + (size_t)(r16 & 3); }
template <bool IN_BF16, int ACT>
__device__ __forceinline__ void hp_gemv4(LAS unsigned char* lds, const void* in, int K, const float* W, int ldw, int c0, float* out, int ldo, int wave, int lane) {
    const int c = c0 + (wave & 3), kbeg = (wave >> 2) * (K >> 1), steps = (K >> 1) >> 6;
    float acc[16];
#pragma unroll
    for (int r = 0; r < 16; ++r) acc[r] = 0.f;
#pragma unroll 2
    for (int s = 0; s < steps; ++s) { const int k = kbeg + s * 64 + lane;
        const float w = W[(size_t)k * ldw + c];
#pragma unroll
        for (int r = 0; r < 16; ++r) { const float a = IN_BF16 ? bf1(((const bf16*)in)[hp_row(r) * D + k]) : ((const float*)in)[(size_t)r * K + k]; acc[r] += a * w; } }
    LAS unsigned char* scr = lds + wave * 1024;
#pragma unroll
    for (int q = 0; q < 4; ++q) { float v[4] = {acc[4 * q], acc[4 * q + 1], acc[4 * q + 2], acc[4 * q + 3]}; wave_sum4_lds(scr, v, lane); acc[4 * q] = v[0]; acc[4 * q + 1] = v[1]; acc[4 * q + 2] = v[2]; acc[4 * q + 3] = v[3]; }
    LAS float* X = (LAS float*)(lds + 8192);
    if (lane == 0) {
#pragma unroll
        for (int r = 0; r < 16; ++r) X[wave * 16 + r] = acc[r]; }
    __syncthreads();
    if (wave < 4 && lane < 16) { float v = X[wave * 16 + lane] + X[(wave + 4) * 16 + lane]; if (ACT == 2) { v = fmaxf(v, 0.f); v = v * v; } out[(size_t)lane * ldo + c0 + wave] = v; }
    __syncthreads();
}

template <int ACT>
__device__ __forceinline__ void hp_gemv_phase(LAS unsigned char* lds, const float* in32, int K, const float* W, int ldw, int N, float* out, int G, int bid, int wave, int lane, int tid) {
    LAS float* INS = (LAS float*)(lds + 16384);
    const int nch = K >> 10, half = wave >> 2;
    for (int cg = bid; cg < (N >> 2); cg += G) {
        float acc[16];
#pragma unroll
        for (int r = 0; r < 16; ++r) acc[r] = 0.f;
        const int c = 4 * cg + (wave & 3);
        for (int ch = 0; ch < nch; ++ch) {
            if (nch > 1 || cg == bid) {
                __syncthreads();
#pragma unroll
                for (int i = 0; i < 8; ++i) { const int idx = tid + 512 * i, r = idx >> 8, k4 = idx & 255;
                    *(LAS f32x4*)(INS + r * 1024 + 4 * k4) = *(const f32x4*)(in32 + (size_t)r * K + ch * 1024 + 4 * k4); }
                __syncthreads();
            }
            const int kb = ch * 1024 + half * 512 + lane;
            float w8[8];
#pragma unroll
            for (int s = 0; s < 8; ++s) w8[s] = W[(size_t)(kb + s * 64) * ldw + c];
#pragma unroll
            for (int s = 0; s < 8; ++s)
#pragma unroll
                for (int r = 0; r < 16; ++r) acc[r] += INS[r * 1024 + half * 512 + s * 64 + lane] * w8[s];
        }
        LAS unsigned char* scr = lds + wave * 1024;
#pragma unroll
        for (int q = 0; q < 4; ++q) { float v[4] = {acc[4 * q], acc[4 * q + 1], acc[4 * q + 2], acc[4 * q + 3]}; wave_sum4_lds(scr, v, lane); acc[4 * q] = v[0]; acc[4 * q + 1] = v[1]; acc[4 * q + 2] = v[2]; acc[4 * q + 3] = v[3]; }
        LAS float* X = (LAS float*)(lds + 8192);
        if (lane == 0) {
#pragma unroll
            for (int r = 0; r < 16; ++r) X[wave * 16 + r] = acc[r]; }
        __syncthreads();
        if (wave < 4 && lane < 16) { float v = X[wave * 16 + lane] + X[(wave + 4) * 16 + lane]; if (ACT == 2) { v = fmaxf(v, 0.f); v = v * v; } out[(size_t)lane * N + 4 * cg + wave] = v; }
        __syncthreads();
    }
}

__device__ __forceinline__ void p0_transpose_item(const float* W, int ldw, int ncols, int K, bf16* WT, const float* kscale, int qlo, int qhi, LAS float* scr, int item, int lane) {
    const int nblk = ncols / 32, kb = item / nblk, nb = item % nblk, k0 = 64 * kb, n0 = 32 * nb;
    const float cs = (n0 >= qlo && n0 < qhi) ? 0.125f : 1.0f;
    float wreg[32];
#pragma unroll
    for (int i = 0; i < 32; ++i) wreg[i] = W[(size_t)(k0 + 2 * i + (lane >> 5)) * ldw + n0 + (lane & 31)];
#pragma unroll
    for (int i = 0; i < 32; ++i) { const int kk = 2 * i + (lane >> 5); float w = wreg[i]; if (kscale) w *= kscale[k0 + kk]; scr[kk * 33 + (lane & 31)] = w * cs; }
    LDS_WAIT(); asm volatile("" ::: "memory");
    const int c = lane & 7;
#pragma unroll
    for (int j = 0; j < 4; ++j) { const int n = (lane >> 3) + 8 * j; const LAS float* s = scr + (8 * c) * 33 + n;
        v4u o; o.x = pk2(s[0 * 33], s[1 * 33]); o.y = pk2(s[2 * 33], s[3 * 33]); o.z = pk2(s[4 * 33], s[5 * 33]); o.w = pk2(s[6 * 33], s[7 * 33]);
        *(GAS v4u*)(WT + (size_t)(n0 + n) * K + k0 + 8 * c) = o; }
    LDS_WAIT(); asm volatile("" ::: "memory");
}
__device__ __forceinline__ void p0_gate_item(const float* Win, const float* gw, const float* g, bf16* WT, int item, int lane) {
    const int np = item >> 1, k0 = ((item & 1) * 64 + lane) * 8;
    float gwv[16];
#pragma unroll
    for (int r = 0; r < 16; ++r) gwv[r] = gw[r * 256 + np];
    float o[8];
#pragma unroll
    for (int j = 0; j < 8; ++j) { const float* wr = Win + (size_t)(k0 + j) * D_IN + 2560; float s = 0.f;
#pragma unroll
        for (int r4 = 0; r4 < 4; ++r4) { const f32x4 w = *(const f32x4*)(wr + 4 * r4); s += w.x * gwv[4 * r4] + w.y * gwv[4 * r4 + 1] + w.z * gwv[4 * r4 + 2] + w.w * gwv[4 * r4 + 3]; }
        o[j] = s * g[k0 + j]; }
    *(GAS v4u*)(WT + (size_t)(2560 + np) * D + k0) = pack8(o);
}

__device__ __forceinline__ void rows_phase(LAS unsigned char* scr, const float* hin, const bf16* mm, const float* g, float* hout, bf16* y, int gw, int ngw, int lane, const float* m32 = nullptr, float* y32out = nullptr, const float* ygain = nullptr) {
    f32x4 hn[4]; v4u mn[2] = {(v4u){0u, 0u, 0u, 0u}, (v4u){0u, 0u, 0u, 0u}};
#define NT_LD4F(p) __builtin_nontemporal_load((const f32x4*)(p))
#define NT_LD4U(p) __builtin_nontemporal_load((const v4u*)(p))
    { const float* hr = hin + (size_t)gw * D + 8 * lane; hn[0] = NT_LD4F(hr); hn[1] = NT_LD4F(hr + 4); hn[2] = NT_LD4F(hr + 512); hn[3] = NT_LD4F(hr + 516);
      if (mm) { const bf16* mr = mm + (size_t)gw * D + 8 * lane; mn[0] = NT_LD4U(mr); mn[1] = NT_LD4U(mr + 512); } }
    for (int row = gw; row < M; row += ngw) {
        float hv[16];
        hv[0] = hn[0].x; hv[1] = hn[0].y; hv[2] = hn[0].z; hv[3] = hn[0].w; hv[4] = hn[1].x; hv[5] = hn[1].y; hv[6] = hn[1].z; hv[7] = hn[1].w;
        hv[8] = hn[2].x; hv[9] = hn[2].y; hv[10] = hn[2].z; hv[11] = hn[2].w; hv[12] = hn[3].x; hv[13] = hn[3].y; hv[14] = hn[3].z; hv[15] = hn[3].w;
        const v4u mc0 = mn[0], mc1 = mn[1];
        if (row + ngw < M) { const float* hr = hin + (size_t)(row + ngw) * D + 8 * lane; hn[0] = NT_LD4F(hr); hn[1] = NT_LD4F(hr + 4); hn[2] = NT_LD4F(hr + 512); hn[3] = NT_LD4F(hr + 516);
            if (mm) { const bf16* mr = mm + (size_t)(row + ngw) * D + 8 * lane; mn[0] = NT_LD4U(mr); mn[1] = NT_LD4U(mr + 512); } }
        if (mm) {
            float mv[16];
            const int tpos = row & (SEQ - 1); const bool hp = (m32 != nullptr) && (tpos < HPR);
            if (hp) { const float* m3 = m32 + (size_t)((row >> 13) * 4 + tpos) * D + 8 * lane;
#pragma unroll
                for (int e = 0; e < 2; ++e) { const f32x4 a = *(const f32x4*)(m3 + 512 * e), b = *(const f32x4*)(m3 + 512 * e + 4);
                    mv[8 * e + 0] = a.x; mv[8 * e + 1] = a.y; mv[8 * e + 2] = a.z; mv[8 * e + 3] = a.w; mv[8 * e + 4] = b.x; mv[8 * e + 5] = b.y; mv[8 * e + 6] = b.z; mv[8 * e + 7] = b.w; }
            } else {
                float t[8]; unpack8(mc0, t);
#pragma unroll
                for (int i = 0; i < 8; ++i) mv[i] = t[i];
                unpack8(mc1, t);
#pragma unroll
                for (int i = 0; i < 8; ++i) mv[8 + i] = t[i]; }
            float ss = 0.f;
#pragma unroll
            for (int i = 0; i < 16; ++i) ss += mv[i] * mv[i];
            const float rstd = 1.0f / sqrtf(wave_sum_lds(scr, ss, lane) * (1.0f / D) + EPS);
#pragma unroll
            for (int e = 0; e < 2; ++e) { const f32x4 ga = *(const f32x4*)(g + 8 * lane + 512 * e), gb = *(const f32x4*)(g + 8 * lane + 512 * e + 4);
                const float gg[8] = {ga.x, ga.y, ga.z, ga.w, gb.x, gb.y, gb.z, gb.w};
#pragma unroll
                for (int i = 0; i < 8; ++i) hv[8 * e + i] += mv[8 * e + i] * rstd * gg[i]; }
        }
        if (hout) { float* orow = hout + (size_t)row * D + 8 * lane;
#pragma unroll
            for (int e = 0; e < 2; ++e) { __builtin_nontemporal_store((f32x4){hv[8 * e], hv[8 * e + 1], hv[8 * e + 2], hv[8 * e + 3]}, (f32x4*)(orow + 512 * e)); __builtin_nontemporal_store((f32x4){hv[8 * e + 4], hv[8 * e + 5], hv[8 * e + 6], hv[8 * e + 7]}, (f32x4*)(orow + 512 * e + 4)); } }
        if (y) {
            float ss = 0.f;
#pragma unroll
            for (int i = 0; i < 16; ++i) ss += hv[i] * hv[i];
            const float rstd = 1.0f / sqrtf(wave_sum_lds(scr, ss, lane) * (1.0f / D) + EPS);
            bf16* yr = y + (size_t)row * D + 8 * lane;
#pragma unroll
            for (int e = 0; e < 2; ++e) { float t[8];
#pragma unroll
                for (int i = 0; i < 8; ++i) t[i] = hv[8 * e + i] * rstd;
                *(v4u*)(yr + 512 * e) = pack8(t); }
            const int tpos2 = row & (SEQ - 1);
            if (y32out != nullptr && tpos2 < HPR) { float* y3 = y32out + (size_t)((row >> 13) * 4 + tpos2) * D + 8 * lane;
#pragma unroll
                for (int e = 0; e < 2; ++e)
#pragma unroll
                    for (int i = 0; i < 8; ++i) y3[512 * e + i] = hv[8 * e + i] * rstd * ygain[8 * lane + 512 * e + i]; }
        }
    }
}

constexpr int VT_ROW = 272, VT_HEAD = 128 * VT_ROW;
__device__ __forceinline__ void gmlp_unit(LAS unsigned char* lds, float* ab32, const bf16* z, bf16* ab, const bf16* Wm, const float* ln_g, const float* ln_b, const float* bs, const float* out_g, int unit, int tid) {
    const int lane = tid & 63, wave = __builtin_amdgcn_readfirstlane(tid >> 6), x = lane & 15, g = lane >> 4;
    const size_t row0 = (size_t)unit * 128;
    {
        float gg[8], bb[8];
        { const f32x4 a = *(const f32x4*)(ln_g + 8 * lane), b = *(const f32x4*)(ln_g + 8 * lane + 4); gg[0] = a.x; gg[1] = a.y; gg[2] = a.z; gg[3] = a.w; gg[4] = b.x; gg[5] = b.y; gg[6] = b.z; gg[7] = b.w; }
        { const f32x4 a = *(const f32x4*)(ln_b + 8 * lane), b = *(const f32x4*)(ln_b + 8 * lane + 4); bb[0] = a.x; bb[1] = a.y; bb[2] = a.z; bb[3] = a.w; bb[4] = b.x; bb[5] = b.y; bb[6] = b.z; bb[7] = b.w; }
        const int h = lane >> 4;
#pragma unroll 1
        for (int it = 0; it < 4; ++it) {
            const int j0 = 16 * wave + 4 * it;
            float val[4][8];
            LAS unsigned char* scr1 = lds + 4 * VT_HEAD + wave * 1024;
            float sm[4];
#pragma unroll
            for (int t = 0; t < 4; ++t) {
                const v4u w = *(const v4u*)(z + (row0 + j0 + t) * NZ + ZV + 8 * lane);
                unpack8(w, val[t]);
                float s = 0.f;
#pragma unroll
                for (int i = 0; i < 8; ++i) s += val[t][i];
                sm[t] = s;
            }
            wave_sum4_lds(scr1, sm, lane);
            float s2[4];
#pragma unroll
            for (int t = 0; t < 4; ++t) { const float mean = sm[t] * (1.0f / 512.0f); float q = 0.f;
#pragma unroll
                for (int i = 0; i < 8; ++i) { val[t][i] -= mean; q += val[t][i] * val[t][i]; }
                s2[t] = q; }
            wave_sum4_lds(scr1, s2, lane);
#pragma unroll
            for (int t = 0; t < 4; ++t) { const float rstd = 1.0f / sqrtf(s2[t] * (1.0f / 512.0f) + EPS);
#pragma unroll
                for (int i = 0; i < 8; ++i) val[t][i] = val[t][i] * rstd * gg[i] + bb[i]; }
#pragma unroll
            for (int i = 0; i < 8; ++i) { v2u o; o.x = pk2(val[0][i], val[1][i]); o.y = pk2(val[2][i], val[3][i]);
                *(LAS v2u*)(lds + h * VT_HEAD + (i * 16 + x) * VT_ROW + j0 * 2) = o; }
        }
    }
    __syncthreads();
    if (GMLP_DBG == 7) {
        const bf16x8 a = (bf16x8){0x3f80, 0x3f00, 0x3e80, 0x3f80, 0x3f00, 0x3e80, 0x3f80, 0x3f00};
        for (int h = 0; h < 4; ++h) {
            f32x4 acc[8];
            for (int nt = 0; nt < 8; ++nt) acc[nt] = (f32x4){0.f, 0.f, 0.f, 0.f};
            for (int ks = 0; ks < 4; ++ks) {
                bf16x8 b[8];
#pragma unroll
                for (int nt = 0; nt < 8; ++nt) b[nt] = *(const LAS bf16x8*)(lds + h * VT_HEAD + (nt * 16 + x) * VT_ROW + (ks * 32 + 8 * g) * 2);
                FRAG_WAIT();
#pragma unroll
                for (int nt = 0; nt < 8; ++nt) acc[nt] = MFMA16(a, b[nt], acc[nt]);
            }
#pragma unroll
            for (int r = 0; r < 4; ++r) { float t[8];
#pragma unroll
                for (int nt = 0; nt < 8; ++nt) t[nt] = acc[nt][r];
                *(v4u*)(ab + (row0 + 16 * wave + 4 * g + r) * D + 128 * h + 8 * x) = pack8(t); }
        }
        __syncthreads();
        return;
    }
    if (GMLP_DBG == 6) {
        for (int h = 0; h < 4; ++h) { float f[8] = {0.f, 0.f, 0.f, 0.f, 0.f, 0.f, 0.f, 0.f};
            for (int nt = 0; nt < 8; ++nt) for (int ks = 0; ks < 4; ++ks) {
                const v4u b = *(const LAS v4u*)(lds + h * VT_HEAD + (nt * 16 + x) * VT_ROW + (ks * 32 + 8 * g) * 2);
                float t[8]; unpack8(b, t);
                for (int q = 0; q < 8; ++q) f[q] += t[q] * (float)(1 + nt + 8 * ks); }
            *(v4u*)(ab + (row0 + 16 * wave + x) * D + 128 * h + 8 * g) = pack8(f); }
        __syncthreads();
        return;
    }
    const int nk = (wave < 4) ? 2 : 4;
    float ssr[4] = {0.f, 0.f, 0.f, 0.f};
#pragma unroll 1
    for (int h = 0; h < 4; ++h) {
        f32x4 acc[8];
#pragma unroll
        for (int nt = 0; nt < 8; ++nt) acc[nt] = (f32x4){0.f, 0.f, 0.f, 0.f};
        bf16x8 a4[4];
#pragma unroll
        for (int ks = 0; ks < 4; ++ks) a4[ks] = *(const bf16x8*)(Wm + h * 16384 + (16 * wave + x) * 128 + ks * 32 + 8 * g);
#pragma unroll
        for (int ks = 0; ks < 4; ++ks) {
            if (ks < nk) {
#pragma unroll
                for (int nt = 0; nt < 8; ++nt) { const bf16x8 b = *(const LAS bf16x8*)(lds + h * VT_HEAD + (nt * 16 + x) * VT_ROW + (ks * 32 + 8 * g) * 2); acc[nt] = MFMA16(a4[ks], b, acc[nt]); }
            }
        }
#pragma unroll
        for (int r = 0; r < 4; ++r) {
            const int i = 16 * wave + 4 * g + r;
            const v4u w = *(const v4u*)(z + (row0 + i) * NZ + ZU + 128 * h + 8 * x);
            float uv[8]; unpack8(w, uv);
            const float bias = bs[h * 128 + i];
            float o[8];
#pragma unroll
            for (int nt = 0; nt < 8; ++nt) o[nt] = uv[nt] * (acc[nt][r] + bias);
            const v4u pw = pack8(o);
            float ob[8]; unpack8(pw, ob);
#pragma unroll
            for (int nt = 0; nt < 8; ++nt) ssr[r] += ob[nt] * ob[nt];
            *(v4u*)(ab + (row0 + i) * D + 128 * h + 8 * x) = pw;
        }
    }
    row16_sum4_lds(lds + 4 * VT_HEAD + wave * 1024, ssr, lane);
    float rstd[4];
#pragma unroll
    for (int r = 0; r < 4; ++r) rstd[r] = 1.0f / sqrtf(ssr[r] * (1.0f / 512.0f) + EPS);
    asm volatile("s_waitcnt vmcnt(0)" ::: "memory");
#pragma unroll 1
    for (int h = 0; h < 4; ++h) {
        const f32x4 ga = *(const f32x4*)(out_g + 128 * h + 8 * x), gb = *(const f32x4*)(out_g + 128 * h + 8 * x + 4);
        const float gg[8] = {ga.x, ga.y, ga.z, ga.w, gb.x, gb.y, gb.z, gb.w};
#pragma unroll
        for (int r = 0; r < 4; ++r) {
            const int i = 16 * wave + 4 * g + r;
            bf16* p = ab + (row0 + i) * D + 128 * h + 8 * x;
            float t[8]; unpack8(*(const v4u*)p, t);
#pragma unroll
            for (int nt = 0; nt < 8; ++nt) t[nt] = t[nt] * rstd[r] * gg[nt];
            *(v4u*)p = pack8(t);

        }
    }
    __syncthreads();
}


__device__ __forceinline__ void block_sum16(LAS unsigned char* wscr, LAS float* PW, float (&v)[16], int wave, int lane) {
#pragma unroll
    for (int q = 0; q < 4; ++q) { float t[4] = {v[4 * q], v[4 * q + 1], v[4 * q + 2], v[4 * q + 3]}; wave_sum4_lds(wscr, t, lane); v[4 * q] = t[0]; v[4 * q + 1] = t[1]; v[4 * q + 2] = t[2]; v[4 * q + 3] = t[3]; asm volatile("" ::: "memory"); }
    if (lane == 0) {
#pragma unroll
        for (int i = 0; i < 16; ++i) PW[wave * 16 + i] = v[i]; }
    __syncthreads();
#pragma unroll
    for (int i = 0; i < 16; ++i) v[i] = 0.f;
#pragma unroll
    for (int w2 = 0; w2 < 8; ++w2) {
#pragma unroll
        for (int q = 0; q < 4; ++q) { const f32x4 t = *(const LAS f32x4*)(PW + w2 * 16 + 4 * q); v[4 * q] += t.x; v[4 * q + 1] += t.y; v[4 * q + 2] += t.z; v[4 * q + 3] += t.w; }
        asm volatile("" ::: "memory"); }
    __syncthreads();
}
__device__ __forceinline__ void block_sum4(LAS unsigned char* wscr, LAS float* PW, float (&v)[4], int wave, int lane) {
    wave_sum4_lds(wscr, v, lane);
    if (lane == 0) *(LAS f32x4*)(PW + wave * 4) = (f32x4){v[0], v[1], v[2], v[3]};
    __syncthreads();
    f32x4 s = (f32x4){0.f, 0.f, 0.f, 0.f};
#pragma unroll
    for (int w2 = 0; w2 < 8; ++w2) s += *(const LAS f32x4*)(PW + w2 * 4);
    v[0] = s.x; v[1] = s.y; v[2] = s.z; v[3] = s.w;
    __syncthreads();
}
__device__ __forceinline__ void gmlp_hp1(LAS unsigned char* lds, const float* hsrc, const float* Win32, const float* pre_g, float* part, float* partu, int b, int ks, int rq, int tid_in) {
    int tid = tid_in; asm volatile("" : "+v"(tid));
    const int c = tid;
    const size_t rb = (size_t)b * SEQ + 16 * rq;
    LAS float* Y = (LAS float*)(lds + 1024);
    { const int sj = tid >> 5, skk = (tid & 31) * 2;
      const float* hr = hsrc + (rb + sj) * D + 64 * ks + skk; const float* gr = pre_g + 64 * ks + skk;
      Y[(skk + 0) * 16 + sj] = hr[0] * gr[0]; Y[(skk + 1) * 16 + sj] = hr[1] * gr[1]; }
    __syncthreads();
    const float* wbase = Win32 + (size_t)(64 * ks) * D_IN + c;
    float accv[16], accu[4] = {0.f, 0.f, 0.f, 0.f};
#pragma unroll
    for (int j = 0; j < 16; ++j) accv[j] = 0.f;
#pragma unroll 1
    for (int kb = 0; kb < 64; kb += 8) {
        float wv[8], wu[8];
        const float* wk = wbase + (size_t)kb * D_IN;
#pragma unroll
        for (int e = 0; e < 8; ++e) { wv[e] = wk[(size_t)e * D_IN + ZV]; wu[e] = wk[(size_t)e * D_IN + ZU]; }
#pragma unroll
        for (int e = 0; e < 8; ++e) {
#pragma unroll
            for (int q4 = 0; q4 < 4; ++q4) { const f32x4 y = *(const LAS f32x4*)(Y + (kb + e) * 16 + 4 * q4);
                accv[4 * q4] += y.x * wv[e]; accv[4 * q4 + 1] += y.y * wv[e]; accv[4 * q4 + 2] += y.z * wv[e]; accv[4 * q4 + 3] += y.w * wv[e];
                if (q4 == 0) { accu[0] += y.x * wu[e]; accu[1] += y.y * wu[e]; accu[2] += y.z * wu[e]; accu[3] += y.w * wu[e]; } }
        }
    }
    float* pp = part + ((size_t)(b * 16 + ks) * 64 + 16 * rq) * 512 + c;
#pragma unroll
    for (int j = 0; j < 16; ++j) pp[(size_t)j * 512] = accv[j];
    if (rq == 0) {
#pragma unroll
        for (int i = 0; i < 4; ++i) partu[((size_t)(b * 16 + ks) * 4 + i) * 512 + c] = accu[i]; }
    __syncthreads();
}
__device__ __forceinline__ void gmlp_hp2a(LAS unsigned char* lds, const float* hsrc, const float* ws32, const float* ln_g, const float* ln_b, const float* part, const float* partu, float* mixp, float* zup, int b, int rg, int tid_in) {
    int tid = tid_in; asm volatile("" : "+v"(tid));
    const int lane = tid & 63, wave = __builtin_amdgcn_readfirstlane(tid >> 6), c = tid;
    const size_t rb = (size_t)b * SEQ;
    LAS float* RS = (LAS float*)(lds);
    LAS float* PW = (LAS float*)(lds + 512);
    LAS unsigned char* wscr = lds + 1024 + wave * 1024;
    if (wave < 4) {
        const float* hr = hsrc + (rb + 4 * rg + wave) * D; float s = 0.f;
#pragma unroll
        for (int e = 0; e < 16; ++e) { const float v = hr[lane + 64 * e]; s += v * v; }
        const float tot = wave_sum_lds(wscr, s, lane);
        if (lane == 0) RS[wave] = 1.0f / sqrtf(tot * (1.0f / D) + EPS);
    }
    float s4[4] = {0.f, 0.f, 0.f, 0.f};
    { const float* pb = part + ((size_t)(b * 16) * 64 + 4 * rg) * 512 + c;
#pragma unroll 8
      for (int ks = 0; ks < 16; ++ks) { const float* pk = pb + (size_t)ks * 64 * 512;
#pragma unroll
          for (int i = 0; i < 4; ++i) s4[i] += pk[i * 512]; } }
    __syncthreads();
    const float lg = ln_g[c], lb = ln_b[c];
    const int h = wave >> 1;
    float x4[4], v[4];
#pragma unroll
    for (int i = 0; i < 4; ++i) { x4[i] = pg8::gelu_tanh(s4[i] * RS[i]); v[i] = x4[i]; }
    block_sum4(wscr, PW, v, wave, lane);
#pragma unroll
    for (int i = 0; i < 4; ++i) { x4[i] -= v[i] * (1.0f / 512.0f); v[i] = x4[i] * x4[i]; }
    block_sum4(wscr, PW, v, wave, lane);
#pragma unroll
    for (int i = 0; i < 4; ++i) x4[i] = x4[i] * (1.0f / sqrtf(v[i] * (1.0f / 512.0f) + EPS)) * lg + lb;
#pragma unroll
    for (int i = 0; i < 4; ++i) { const f32x4 w = *(const f32x4*)(ws32 + (size_t)(h * 128 + i) * 128 + 4 * rg);
        mixp[((size_t)(b * 16 + rg) * 4 + i) * 512 + c] = w.x * x4[0] + w.y * x4[1] + w.z * x4[2] + w.w * x4[3]; }
    if (rg == 0) {
        float zu[4] = {0.f, 0.f, 0.f, 0.f};
#pragma unroll 8
        for (int ks = 0; ks < 16; ++ks) { const float* pk = partu + ((size_t)(b * 16 + ks) * 4) * 512 + c;
#pragma unroll
            for (int i = 0; i < 4; ++i) zu[i] += pk[i * 512]; }
#pragma unroll
        for (int i = 0; i < 4; ++i) zup[((size_t)b * 4 + i) * 512 + c] = zu[i] * RS[i];
    }
    __syncthreads();
}
__device__ __forceinline__ void gmlp_hp2b(LAS unsigned char* lds, const float* bs, const float* out_g, const float* mixp, const float* zup, float* ab32, int b, int tid_in) {
    int tid = tid_in; asm volatile("" : "+v"(tid));
    const int lane = tid & 63, wave = __builtin_amdgcn_readfirstlane(tid >> 6), c = tid;
    LAS float* PW = (LAS float*)(lds + 512);
    LAS unsigned char* wscr = lds + 1024 + wave * 1024;
    const int h = wave >> 1;
    __syncthreads();
    float mixed[4] = {0.f, 0.f, 0.f, 0.f};
#pragma unroll 8
    for (int rg = 0; rg < 16; ++rg) { const float* pk = mixp + ((size_t)(b * 16 + rg) * 4) * 512 + c;
#pragma unroll
        for (int i = 0; i < 4; ++i) mixed[i] += pk[i * 512]; }
    float o4[4], sq[4];
#pragma unroll
    for (int i = 0; i < 4; ++i) { o4[i] = pg8::gelu_tanh(zup[((size_t)b * 4 + i) * 512 + c]) * (mixed[i] + bs[h * 128 + i]); sq[i] = o4[i] * o4[i]; }
    block_sum4(wscr, PW, sq, wave, lane);
    const float og = out_g[c];
#pragma unroll
    for (int i = 0; i < 4; ++i) ab32[(size_t)(b * 4 + i) * D + c] = o4[i] * (1.0f / sqrtf(sq[i] * (1.0f / 512.0f) + EPS)) * og;
    __syncthreads();
}

constexpr int G_ROW = 144;
constexpr int G_QE = 0, G_KE = 9216, G_KDT = 18432, G_VT = 27648, G_P = 46080, G_SEG = 55296, G_SC = 57344, G_SCR = 57600, G_HROW = 65536, G_PART = 81920  , G_WSCR = 131072  , G_PSS = 139264;
constexpr int HP_R = 4;
__device__ __forceinline__ float log_sigmoid(float p) { return fminf(p, 0.f) - __logf(1.0f + __expf(-fabsf(p))); }
__device__ __forceinline__ void gla1_unit(LAS unsigned char* lds, const float* hsrc, const float* Win32, const float* pre_g, const float* gla_og, float* ab32, const bf16* z, const float* gate_b, bf16* qe_g, bf16* oi_g, float* upd_g, float* dec_g, int unit, int tid) {
    const int lane = tid & 63, wave = __builtin_amdgcn_readfirstlane(tid >> 6), x = lane & 15, g = lane >> 4;
    const int cidx = unit >> 2, h = unit & 3;
    const size_t rbase = (size_t)cidx * 64;
    const int sidx = ((cidx >> 7) * 4 + h) * 128 + (cidx & 127);
    LAS float* SEG = (LAS float*)(lds + G_SEG);
    float c[8], qv[8], kv[8];
    {
        const float gb = gate_b[h * 64 + lane];
        float run = 0.f;
#pragma unroll
        for (int tt = 0; tt < 8; ++tt) {
            const bf16* zr = z + (rbase + 8 * wave + tt) * NZ;
            const float p = bf1(zr[ZP + h * 64 + lane]) + gb;
            qv[tt] = bf1(zr[ZQ + h * 64 + lane]); kv[tt] = bf1(zr[ZK + h * 64 + lane]);
            run += log_sigmoid(p) * (1.0f / 16.0f); c[tt] = run;
        }
        SEG[wave * 64 + lane] = run;
    }
    {
#pragma unroll
        for (int e = 0; e < 2; ++e) { const int v = lane + 64 * e; float t[8];
#pragma unroll
            for (int tt = 0; tt < 8; ++tt) t[tt] = bf1(z[(rbase + 8 * wave + tt) * NZ + ZVB + h * 128 + v]);
            *(LAS v4u*)(lds + G_VT + ((v & 7) * 16 + (v >> 3)) * G_ROW + 16 * wave) = pack8(t); }
    }
    const bool hp = ((cidx & 127) == 0);
    __syncthreads();
    float vf[HP_R][2] = {{0.f, 0.f}, {0.f, 0.f}, {0.f, 0.f}, {0.f, 0.f}}, gf[HP_R][2] = {{0.f, 0.f}, {0.f, 0.f}, {0.f, 0.f}, {0.f, 0.f}};
    if (hp && wave == 0) {
#pragma unroll
        for (int tt = 0; tt < HP_R; ++tt) { const float* qr = hsrc   + (size_t)((cidx >> 7) * 4 + tt) * 1536;
            qv[tt] = qr[h * 64 + lane] * 0.125f; kv[tt] = qr[256 + h * 64 + lane];
            vf[tt][0] = qr[512 + h * 128 + lane]; vf[tt][1] = qr[512 + h * 128 + lane + 64]; gf[tt][0] = qr[1024 + h * 128 + lane]; gf[tt][1] = qr[1024 + h * 128 + lane + 64]; }
    }
    {
        float off = 0.f, tot = 0.f;
#pragma unroll
        for (int w2 = 0; w2 < 8; ++w2) { const float s = SEG[w2 * 64 + lane]; tot += s; if (w2 < wave) off += s; }
        if (wave == 0) dec_g[(size_t)sidx * 64 + lane] = __expf(tot);
        float kd[8];
#pragma unroll
        for (int tt = 0; tt < 8; ++tt) {
            const float cum = off + c[tt]; const int t = 8 * wave + tt;
            const float qe = qv[tt] * __expf(cum), ke = kv[tt] * __expf(-cum); kd[tt] = kv[tt] * __expf(tot - cum);
            const bf16 qb = (bf16)f2bf(qe);
            *(LAS bf16*)(lds + G_QE + t * G_ROW + 2 * lane) = qb;
            *(LAS bf16*)(lds + G_KE + t * G_ROW + 2 * lane) = (bf16)f2bf(ke);
            qe_g[(rbase + t) * 256 + h * 64 + lane] = qb;
        }
        *(LAS v4u*)(lds + G_KDT + lane * G_ROW + 16 * wave) = pack8(kd);
        if (hp && wave == 0) {
            float qf[HP_R], kf[HP_R];
#pragma unroll
            for (int tt = 0; tt < HP_R; ++tt) { const float cum = off + c[tt]; qf[tt] = qv[tt] * __expf(cum); kf[tt] = kv[tt] * __expf(-cum); }
            float s0[4] = {qf[0] * kf[0], qf[1] * kf[0], qf[1] * kf[1], qf[2] * kf[0]};
            float s1[4] = {qf[2] * kf[1], qf[2] * kf[2], qf[3] * kf[0], qf[3] * kf[1]};
            float s2[4] = {qf[3] * kf[2], qf[3] * kf[3], 0.f, 0.f};
            wave_sum4_lds(lds + G_SCR, s0, lane); wave_sum4_lds(lds + G_SCR, s1, lane); wave_sum4_lds(lds + G_SCR, s2, lane);
            if (lane == 0) { LAS float* SC = (LAS float*)(lds + G_SC);
                SC[0] = s0[0]; SC[1] = 0.f; SC[2] = 0.f; SC[3] = 0.f;
                SC[4] = s0[1]; SC[5] = s0[2]; SC[6] = 0.f; SC[7] = 0.f;
                SC[8] = s0[3]; SC[9] = s1[0]; SC[10] = s1[1]; SC[11] = 0.f;
                SC[12] = s1[2]; SC[13] = s1[3]; SC[14] = s2[0]; SC[15] = s2[1]; }
            float o[HP_R][2];
#pragma unroll
            for (int e = 0; e < 2; ++e) {
                o[0][e] = s0[0] * vf[0][e];
                o[1][e] = s0[1] * vf[0][e] + s0[2] * vf[1][e];
                o[2][e] = s0[3] * vf[0][e] + s1[0] * vf[1][e] + s1[1] * vf[2][e];
                o[3][e] = s1[2] * vf[0][e] + s1[3] * vf[1][e] + s2[0] * vf[2][e] + s2[1] * vf[3][e]; }
            float so[4];
#pragma unroll
            for (int i = 0; i < HP_R; ++i) so[i] = o[i][0] * o[i][0] + o[i][1] * o[i][1];
            wave_sum4_lds(lds + G_SCR, so, lane);
#pragma unroll
            for (int i = 0; i < HP_R; ++i) { const float rs = 1.0f / sqrtf(so[i] * (1.0f / 128.0f) + EPS);
#pragma unroll
                for (int e = 0; e < 2; ++e) { const float zg = gf[i][e]; const float sg = zg / (1.0f + __expf(-zg));
                    ab32[(size_t)((cidx >> 7) * 4 + i) * D + 512 + h * 128 + lane + 64 * e] = o[i][e] * rs * gla_og[h * 128 + lane + 64 * e] * sg; } }
        }
    }
    __syncthreads();
    {
        const int it = wave >> 1;
#pragma unroll
        for (int jj = 0; jj < 2; ++jj) {
            const int jt = 2 * (wave & 1) + jj;
            f32x4 s = (f32x4){0.f, 0.f, 0.f, 0.f};
            if (jt <= it) {
                bf16x8 a[2], b[2];
#pragma unroll
                for (int ks = 0; ks < 2; ++ks) {
                    a[ks] = *(const LAS bf16x8*)(lds + G_QE + (16 * it + x) * G_ROW + (ks * 32 + 8 * g) * 2);
                    b[ks] = *(const LAS bf16x8*)(lds + G_KE + (16 * jt + x) * G_ROW + (ks * 32 + 8 * g) * 2); }
                FRAG_WAIT();
                s = MFMA16(a[0], b[0], s); s = MFMA16(a[1], b[1], s);
            }
#pragma unroll
            for (int r = 0; r < 4; ++r) { const int i = 16 * it + 4 * g + r, j = 16 * jt + x;
                float sv = (j <= i) ? s[r] : 0.f;
                if (hp && i < HP_R && j < HP_R) sv = ((const LAS float*)(lds + G_SC))[i * 4 + j];
                *(LAS bf16*)(lds + G_P + i * G_ROW + 2 * j) = (bf16)f2bf(sv); }
        }
    }
    __syncthreads();
    if (wave < 4) {
        f32x4 acc[8];
#pragma unroll
        for (int vt = 0; vt < 8; ++vt) acc[vt] = (f32x4){0.f, 0.f, 0.f, 0.f};
        {
            bf16x8 a[2], b[2][8];
#pragma unroll
            for (int ks = 0; ks < 2; ++ks) {
                a[ks] = *(const LAS bf16x8*)(lds + G_P + (16 * wave + x) * G_ROW + (ks * 32 + 8 * g) * 2);
#pragma unroll
                for (int vt = 0; vt < 8; ++vt) b[ks][vt] = *(const LAS bf16x8*)(lds + G_VT + (vt * 16 + x) * G_ROW + (ks * 32 + 8 * g) * 2); }
            FRAG_WAIT();
#pragma unroll
            for (int ks = 0; ks < 2; ++ks)
#pragma unroll
                for (int vt = 0; vt < 8; ++vt) acc[vt] = MFMA16(a[ks], b[ks][vt], acc[vt]);
        }
#pragma unroll
        for (int r = 0; r < 4; ++r) { float t[8];
#pragma unroll
            for (int vt = 0; vt < 8; ++vt) t[vt] = acc[vt][r];
            *(v4u*)(oi_g + (rbase + 16 * wave + 4 * g + r) * 512 + h * 128 + 8 * x) = pack8(t); }
    } else {
        const int w2 = wave - 4;
        f32x4 acc[2][4];
#pragma unroll
        for (int a = 0; a < 2; ++a)
#pragma unroll
            for (int dt = 0; dt < 4; ++dt) acc[a][dt] = (f32x4){0.f, 0.f, 0.f, 0.f};
        {
            bf16x8 b[2][4], av[2][2];
#pragma unroll
            for (int ks = 0; ks < 2; ++ks) {
#pragma unroll
                for (int dt = 0; dt < 4; ++dt) b[ks][dt] = *(const LAS bf16x8*)(lds + G_KDT + (16 * dt + x) * G_ROW + (ks * 32 + 8 * g) * 2);
#pragma unroll
                for (int a = 0; a < 2; ++a) av[ks][a] = *(const LAS bf16x8*)(lds + G_VT + (16 * (2 * w2 + a) + x) * G_ROW + (ks * 32 + 8 * g) * 2); }
            FRAG_WAIT();
#pragma unroll
            for (int ks = 0; ks < 2; ++ks)
#pragma unroll
                for (int a = 0; a < 2; ++a)
#pragma unroll
                    for (int dt = 0; dt < 4; ++dt) acc[a][dt] = MFMA16(av[ks][a], b[ks][dt], acc[a][dt]);
        }
#pragma unroll
        for (int a = 0; a < 2; ++a)
#pragma unroll
            for (int dt = 0; dt < 4; ++dt)
#pragma unroll
                for (int r = 0; r < 4; ++r) { const int v = 8 * (4 * g + r) + (2 * w2 + a); upd_g[(size_t)sidx * 8192 + v * 64 + 16 * dt + x] = acc[a][dt][r]; }
    }
    __syncthreads();
}

__device__ __forceinline__ void gla_scan(const float* __restrict__ upd_g, const float* __restrict__ dec_g, bf16* __restrict__ sp_g, int gtid, int ngt) {
    for (int e = gtid; e < 16 * 8192; e += ngt) {
        const int bh = e >> 13, off = e & 8191, d = off & 63;
        float S = 0.f;
#pragma unroll 16
        for (int n = 0; n < 128; ++n) {
            const size_t s = (size_t)bh * 128 + n;
            const float u = upd_g[s * 8192 + off], dc = dec_g[s * 64 + d];
            sp_g[s * 8192 + off] = (bf16)f2bf(S);
            S = dc * S + u;
        }
    }
}

__device__ __forceinline__ void gla3_unit(LAS unsigned char* scr, const bf16* z, const bf16* qe_g, const bf16* oi_g, const bf16* sp_g, const float* out_g, bf16* ab, int unit, int it, int lane) {
    const int x = lane & 15, g = lane >> 4;
    const int cidx = unit >> 2, h = unit & 3;
    const size_t rbase = (size_t)cidx * 64;
    const int sidx = ((cidx >> 7) * 4 + h) * 128 + (cidx & 127);
    f32x4 acc[8];
#pragma unroll
    for (int vt = 0; vt < 8; ++vt) acc[vt] = (f32x4){0.f, 0.f, 0.f, 0.f};
    {
        bf16x8 a[2], b[2][8];
#pragma unroll
        for (int ks = 0; ks < 2; ++ks) {
            a[ks] = *(const bf16x8*)(qe_g + (rbase + 16 * it + x) * 256 + h * 64 + ks * 32 + 8 * g);
#pragma unroll
            for (int vt = 0; vt < 8; ++vt) b[ks][vt] = *(const bf16x8*)(sp_g + (size_t)sidx * 8192 + (8 * x + vt) * 64 + ks * 32 + 8 * g); }
        FRAG_WAIT();
#pragma unroll
        for (int ks = 0; ks < 2; ++ks)
#pragma unroll
            for (int vt = 0; vt < 8; ++vt) acc[vt] = MFMA16(a[ks], b[ks][vt], acc[vt]);
    }
    const f32x4 ga = *(const f32x4*)(out_g + h * 128 + 8 * x), gb = *(const f32x4*)(out_g + h * 128 + 8 * x + 4);
    const float gg[8] = {ga.x, ga.y, ga.z, ga.w, gb.x, gb.y, gb.z, gb.w};
    float ss[4];
#pragma unroll
    for (int r = 0; r < 4; ++r) {
        const size_t row = rbase + 16 * it + 4 * g + r;
        float oi[8]; unpack8(*(const v4u*)(oi_g + row * 512 + h * 128 + 8 * x), oi);
        float s = 0.f;
#pragma unroll
        for (int vt = 0; vt < 8; ++vt) { const float o = acc[vt][r] + oi[vt]; acc[vt][r] = o; s += o * o; }
        ss[r] = s;
    }
    row16_sum4_lds(scr, ss, lane);
#pragma unroll
    for (int r = 0; r < 4; ++r) {
        const size_t row = rbase + 16 * it + 4 * g + r;
        float zg[8]; unpack8(*(const v4u*)(z + row * NZ + ZG + h * 128 + 8 * x), zg);
        const float rstd = 1.0f / sqrtf(ss[r] * (1.0f / 128.0f) + EPS);
        float t[8];
#pragma unroll
        for (int vt = 0; vt < 8; ++vt) { const float sg = zg[vt] / (1.0f + __expf(-zg[vt])); t[vt] = acc[vt][r] * rstd * gg[vt] * sg; }
        *(v4u*)(ab + row * D + 512 + h * 128 + 8 * x) = pack8(t);
    }
}


#define RLX_AGENT __ATOMIC_RELAXED, __HIP_MEMORY_SCOPE_AGENT
constexpr int CW_BAR = 4096;
constexpr size_t CTL_ZERO_BYTES = 65536;
constexpr int LDS_MISC_OFF = LDS_BYTES - 64;
#define XB_TMO      128
#define XB_XCNT(j)  (256  + 64 * (j))
#define XB_XSUB(j)  (1280 + 64 * (j))
#define XB_XGEN(j)  (2304 + 64 * (j))
#define XB_TOP      3328
#define XB_TOPGEN   3392
#define XCD_BAR_WORDS 3456
#define XB_SPIN_CAP (1u << 18)

__device__ __forceinline__ unsigned xb_ld(unsigned* p)              { return __hip_atomic_load(p, __ATOMIC_RELAXED, __HIP_MEMORY_SCOPE_AGENT); }
__device__ __forceinline__ unsigned xb_add(unsigned* p, unsigned v) { return __hip_atomic_fetch_add(p, v, __ATOMIC_RELAXED, __HIP_MEMORY_SCOPE_AGENT); }
__device__ __forceinline__ unsigned xb_xcc_id() { return (unsigned)__builtin_amdgcn_s_getreg((3 << 11) | 20) & 0xFu; }
#define XB_SPIN(cond, bar) do { unsigned _sp = 0; while (cond) { __builtin_amdgcn_s_sleep(1); \
    if ((++_sp & 255u) == 0u) { if (xb_ld(&(bar)[XB_TMO])) break; if (_sp > XB_SPIN_CAP) { atomicAdd(&(bar)[XB_TMO], 1u); break; } } } } while (0)

struct XcdBarrier {
    unsigned* bar; unsigned x;
    volatile LAS unsigned* st;
};

__device__ __forceinline__ XcdBarrier xcd_barrier_post(unsigned* bar, volatile LAS unsigned* st) {
    XcdBarrier b; b.bar = bar; b.x = xb_xcc_id(); b.st = st;
    if (threadIdx.x == 0) (void)xb_add(&bar[XB_XCNT(b.x)], 1u);
    return b;
}
__device__ __forceinline__ void xcd_barrier_complete(unsigned* bar, unsigned x, unsigned& nloc, unsigned& nx) {
    const unsigned G = gridDim.x * gridDim.y * gridDim.z;
    unsigned sum, cnt, mine, sp = 0u;
    for (;;) {
        sum = 0u; cnt = 0u; mine = 0u;
#pragma unroll
        for (unsigned j = 0; j < 16; ++j) { const unsigned c = xb_ld(&bar[XB_XCNT(j)]); sum += c; cnt += (c > 0u) ? 1u : 0u; mine = (j == x) ? c : mine; }
        if (sum == G) break;
        __builtin_amdgcn_s_sleep(1);
        if ((++sp & 255u) == 0u) { if (xb_ld(&bar[XB_TMO])) break; if (sp > XB_SPIN_CAP) { atomicAdd(&bar[XB_TMO], 1u); break; } }
    }
    nloc = mine > 0u ? mine : 1u; nx = cnt > 0u ? cnt : 1u;
}

__device__ __forceinline__ void xcd_barrier(const XcdBarrier& b) {
    asm volatile("s_waitcnt vmcnt(0)" ::: "memory");
    __syncthreads();
    if (threadIdx.x == 0) {
        unsigned* bar = b.bar;
        __builtin_amdgcn_s_waitcnt(0);
        unsigned nloc = b.st[0], nx = b.st[1];
        if (nloc == 0u) { xcd_barrier_complete(bar, b.x, nloc, nx); b.st[0] = nloc; b.st[1] = nx; }
        const unsigned old = xb_add(&bar[XB_XSUB(b.x)], 1u);
        const unsigned gen = old / nloc;
        if (old + 1u == (gen + 1u) * nloc) {
            __builtin_amdgcn_fence(__ATOMIC_RELEASE, "agent");
            asm volatile("s_waitcnt vmcnt(0)" ::: "memory");
            const unsigned og = xb_add(&bar[XB_TOP], 1u);
            const unsigned tg = og / nx;
            if (og + 1u == (tg + 1u) * nx) xb_add(&bar[XB_TOPGEN], 1u);
            else XB_SPIN(xb_ld(&bar[XB_TOPGEN]) == tg, bar);
            __builtin_amdgcn_fence(__ATOMIC_ACQUIRE, "agent");
            xb_add(&bar[XB_XGEN(b.x)], 1u);
            asm volatile("s_waitcnt vmcnt(0)" ::: "memory");
        } else {
            XB_SPIN(xb_ld(&bar[XB_XGEN(b.x)]) == gen, bar);
            __builtin_amdgcn_fence(__ATOMIC_ACQUIRE, "agent");
            asm volatile("s_waitcnt vmcnt(0)" ::: "memory");
        }
    }
    __syncthreads();
}

#ifndef STOP_AT
#define STOP_AT 0
#endif
#define DUMP_BF16(src, ncol_src, coff) do { xcd_barrier(bar); for (size_t i_ = (size_t)bid * NTHR + threadIdx.x; i_ < (size_t)M * D; i_ += (size_t)G * NTHR) { const size_t r_ = i_ >> 10, c_ = i_ & 1023; out[i_] = bf1((src)[r_ * (ncol_src) + (coff) + c_]); } return; } while (0)
#ifndef GMLP_DBG
#define GMLP_DBG 0
#endif
#ifndef DUP_GEMM
#define DUP_GEMM 0
#endif
#ifndef DUP_MASK
#define DUP_MASK 0
#endif
#ifndef SEAM_REPEAT
#define SEAM_REPEAT 1
#endif
#define SEAM() xcd_barrier(bar)
struct Args { const float* in[17]; float* out; unsigned char* ws; int ph_lo, ph_hi; };
__global__ void __launch_bounds__(NTHR, 2) fwd_megakernel(Args args) {
    extern __shared__ __attribute__((aligned(16))) unsigned char lds_raw[];
    cg::grid_group grid = cg::this_grid();
    LAS unsigned char* lds = (LAS unsigned char*)lds_raw;
    const int G = gridDim.x, bid = blockIdx.x, ngw = G * NWAVES;
    volatile LAS unsigned* MISC = (volatile LAS unsigned*)(lds + LDS_MISC_OFF);
    if (threadIdx.x < 16) MISC[threadIdx.x] = 0u;
    __syncthreads();
    XcdBarrier bar = xcd_barrier_post((unsigned*)(args.ws) + CW_BAR, MISC);
    grid.sync();
#define PHASE_IDS() int tid = threadIdx.x; asm volatile("" : "+v"(tid)); const int lane = tid & 63, wave = __builtin_amdgcn_readfirstlane(tid >> 6), gw = bid * NWAVES + wave; (void)lane; (void)gw
    unsigned char* ws = args.ws;
    const float* x = args.in[0];
    float* out = args.out;
    bf16* Wm = (bf16*)(ws + WS_WM);
    float* dec_g = (float*)(ws + WS_DEC);
    bf16* zb = (bf16*)(ws + WS_Z); bf16* f1 = (bf16*)(ws + WS_F1); bf16* ab = (bf16*)(ws + WS_AB); bf16* qe_g = (bf16*)(ws + WS_QE);
    bf16* yb = (bf16*)(ws + WS_Y); bf16* sp_g = (bf16*)(ws + WS_SP); bf16* oi_g = (bf16*)(ws + WS_OI); bf16* mmb = (bf16*)(ws + WS_MM); float* upd_g = (float*)(ws + WS_UPD);

    float* M32 = (float*)(ws + WS_HP); float* Y32 = M32 + 16 * 1024; float* F1_32 = Y32 + 16 * 1024; float* F32o = F1_32 + 16 * 4096; float* AB32 = F32o + 16 * 1024; float* HPP = (float*)(ws + WS_HP + 2 * MiB); float* HPU = (float*)(ws + WS_HP + 11 * MiB); float* YH32 = (float*)(ws + WS_HP + 1 * MiB); float* QKVG32 = YH32 + 16 * 1024; float* MIXP = (float*)(ws + WS_HP + 12 * MiB); float* ZUP = (float*)(ws + WS_HP + 13 * MiB);
    {
        PHASE_IDS();
        LAS float* scr = (LAS float*)(lds + wave * 16384);
        constexpr int I_IN = 16 * 80, I_OUT = 16 * 32, I_1 = 16 * 128, I_2 = 64 * 32, I_G = 512, I_L = I_IN + I_OUT + I_1 + I_2 + I_G;
        for (int it = gw; it < DEPTH * I_L; it += ngw) {
            const int l = it / I_L; int r = it % I_L;
            bf16* WinT = (bf16*)(ws + WS_W + l * W_LAYER_B); bf16* WoutT = (bf16*)(ws + WS_W + l * W_LAYER_B + W_IN_B); bf16* W1T = (bf16*)(ws + WS_W + l * W_LAYER_B + W_IN_B + W_OUT_B); bf16* W2T = (bf16*)(ws + WS_W + l * W_LAYER_B + W_IN_B + W_OUT_B + W_1_B);
            const float* w_in = args.in[2] + (size_t)l * D * D_IN; const float* pre_g = args.in[1] + l * D;
            if (r < I_IN) { p0_transpose_item(w_in, D_IN, 2560, D, WinT, pre_g, ZQ, ZK, scr, r, lane); continue; } r -= I_IN;
            if (r < I_OUT) { p0_transpose_item(args.in[11] + (size_t)l * D * D, D, D, D, WoutT, nullptr, 0, 0, scr, r, lane); continue; } r -= I_OUT;
            if (r < I_1) { p0_transpose_item(args.in[14] + (size_t)l * D * FF, FF, FF, D, W1T, args.in[13] + l * D, 0, 0, scr, r, lane); continue; } r -= I_1;
            if (r < I_2) { p0_transpose_item(args.in[15] + (size_t)l * FF * D, D, D, FF, W2T, nullptr, 0, 0, scr, r, lane); continue; } r -= I_2;
            p0_gate_item(w_in, args.in[8] + (size_t)l * 16 * 256, pre_g, WinT, r, lane);
        }
        const float* wsrc = args.in[5];
        for (int i = bid * NTHR + tid; i < DEPTH * 4 * 128 * 128; i += G * NTHR) { const int ii = (i >> 7) & 127, jj = i & 127; Wm[i] = ((ii >> 6) >= (jj >> 6)) ? (bf16)f2bf(wsrc[i]) : (bf16)0; }
        rows_phase(lds + wave * 16384, x, nullptr, nullptr, nullptr, yb, gw, ngw, lane, nullptr, YH32, args.in[1]);
    }
    SEAM();

#pragma unroll 1
    for (int l = 0; l < DEPTH; ++l) {
        const bf16* WinT = (const bf16*)(ws + WS_W + l * W_LAYER_B); const bf16* WoutT = (const bf16*)(ws + WS_W + l * W_LAYER_B + W_IN_B);
        const bf16* W1T = (const bf16*)(ws + WS_W + l * W_LAYER_B + W_IN_B + W_OUT_B); const bf16* W2T = (const bf16*)(ws + WS_W + l * W_LAYER_B + W_IN_B + W_OUT_B + W_1_B);
        { PHASE_IDS(); pg8::Gemm gm{yb, WinT, M, NZ, D}; pg8::StaticOrder S; S.init(M, NZ, G, bid); pg8::EpiAct<1> E{zb, NZ, 4};
          pg8::gemm_phase<pg8::EpiAct<1>, pg8::StaticOrder, true, true>(lds, gm, S, E, tid);
          hp_gemv_phase<0>(lds, YH32, D, args.in[2] + (size_t)l * D * D_IN + ZQ, D_IN, 1536, QKVG32, G, bid, wave, lane, tid); }
        SEAM();
        if (STOP_AT == 1) DUMP_BF16(zb, NZ, 0);
        if (STOP_AT == 2) DUMP_BF16(zb, NZ, 1792);
        if (STOP_AT == 30) {
            const int lane_ = threadIdx.x & 63, wave_ = threadIdx.x >> 6;
            for (int u = bid; u < M / 128; u += G)
                for (int t_ = 0; t_ < 16; ++t_) { const size_t row_ = (size_t)u * 128 + 16 * wave_ + t_;
                    *(v4u*)(ab + row_ * D + 8 * lane_) = *(const v4u*)(zb + row_ * NZ + ZV + 8 * lane_); }
            xcd_barrier(bar); for (size_t i_ = (size_t)bid * NTHR + threadIdx.x; i_ < (size_t)M * D; i_ += (size_t)G * NTHR) { const size_t r_ = i_ >> 10, c_ = i_ & 511; out[i_] = bf1(ab[r_ * D + c_]); } return; }
        { PHASE_IDS();
        for (int u = bid; u < M / 128; u += G)
            gmlp_unit(lds, AB32, zb, ab, Wm + (size_t)l * 4 * 16384, args.in[3] + l * 512, args.in[4] + l * 512, args.in[6] + l * 512, args.in[7] + l * 512, u, tid);
        if (STOP_AT == 14) { xcd_barrier(bar); for (size_t i_ = (size_t)bid * NTHR + threadIdx.x; i_ < (size_t)M * D; i_ += (size_t)G * NTHR) { out[i_] = bf1(Wm[i_ & 262143]); } return; }
        if (STOP_AT >= 20 && STOP_AT < 24) { xcd_barrier(bar); for (size_t i_ = (size_t)bid * NTHR + threadIdx.x; i_ < (size_t)M * D; i_ += (size_t)G * NTHR) { const size_t r_ = i_ >> 10, c_ = i_ & 127; out[i_] = bf1(ab[r_ * D + (STOP_AT - 20) * 128 + c_]); } return; }
        if (STOP_AT == 13) { xcd_barrier(bar); for (size_t i_ = (size_t)bid * NTHR + threadIdx.x; i_ < (size_t)M * D; i_ += (size_t)G * NTHR) { const size_t r_ = i_ >> 10, c_ = i_ & 511; out[i_] = bf1(ab[r_ * D + c_]); } return; }
        }
        { PHASE_IDS();
        for (int t = bid; t < 256; t += G) gmlp_hp1(lds, l == 0 ? x : out, args.in[2] + (size_t)l * D * D_IN, args.in[1] + l * D, HPP, HPU, t >> 6, (t >> 2) & 15, t & 3, tid);
        }
        { PHASE_IDS();
        for (int ui = 0; ui * G < NCHUNK * 4; ++ui) { const int u = (G == 256) ? (256 * ui + ((bid + 4 * ui) & 255)) : (ui * G + bid); if (u >= NCHUNK * 4) break;
            gla1_unit(lds, QKVG32, args.in[2] + (size_t)l * D * D_IN, args.in[1] + l * D, args.in[10] + l * 512, AB32, zb, args.in[9] + l * 256, qe_g, oi_g, upd_g, dec_g, u, tid); } }
        SEAM();
        { PHASE_IDS(); gla_scan(upd_g, dec_g, sp_g, bid * NTHR + tid, G * NTHR); }
        { PHASE_IDS();
          for (int t = bid; t < 64; t += G) gmlp_hp2a(lds, l == 0 ? x : out, args.in[5] + (size_t)l * 4 * 16384, args.in[3] + l * 512, args.in[4] + l * 512, HPP, HPU, MIXP, ZUP, t >> 4, t & 15, tid); }
        SEAM();
        { PHASE_IDS();
        for (int pu = bid; pu < NCHUNK * 2; pu += G)
            gla3_unit(lds + wave * 1024, zb, qe_g, oi_g, sp_g, args.in[10] + l * 512, ab, 2 * pu + (wave >> 2), wave & 3, lane); }
        { PHASE_IDS();
          for (int b4 = bid; b4 < BATCH; b4 += G) gmlp_hp2b(lds, args.in[6] + l * 512, args.in[7] + l * 512, MIXP, ZUP, AB32, b4, tid); }
        SEAM();
        if (STOP_AT == 3) DUMP_BF16(ab, D, 0);
        if (STOP_AT == 8) { xcd_barrier(bar); for (size_t i_ = (size_t)bid * NTHR + threadIdx.x; i_ < (size_t)M * D; i_ += (size_t)G * NTHR) { const size_t r_ = i_ >> 10, c_ = i_ & 511; out[i_] = bf1(ab[r_ * D + c_]); } return; }
        if (STOP_AT == 9) { xcd_barrier(bar); for (size_t i_ = (size_t)bid * NTHR + threadIdx.x; i_ < (size_t)M * D; i_ += (size_t)G * NTHR) { const size_t r_ = i_ >> 10, c_ = i_ & 511; out[i_] = bf1(ab[r_ * D + 512 + c_]); } return; }
        if (STOP_AT == 10) { xcd_barrier(bar); for (size_t i_ = (size_t)bid * NTHR + threadIdx.x; i_ < (size_t)M * D; i_ += (size_t)G * NTHR) { const size_t r_ = i_ >> 10, c_ = i_ & 511; out[i_] = bf1(oi_g[r_ * 512 + c_]); } return; }
        if (STOP_AT == 11) { xcd_barrier(bar); for (size_t i_ = (size_t)bid * NTHR + threadIdx.x; i_ < (size_t)M * D; i_ += (size_t)G * NTHR) { out[i_] = bf1(sp_g[i_ & (size_t)(2048 * 8192 - 1)]); } return; }
        if (STOP_AT == 12) { xcd_barrier(bar); for (size_t i_ = (size_t)bid * NTHR + threadIdx.x; i_ < (size_t)M * D; i_ += (size_t)G * NTHR) { out[i_] = upd_g[i_ & (size_t)(2048 * 8192 - 1)]; } return; }
        { PHASE_IDS(); pg8::Gemm gm{ab, WoutT, M, D, D}; pg8::StaticOrder S; S.init(M, D, G, bid); pg8::EpiAct<0> E{mmb, D, 0};
          pg8::gemm_phase<pg8::EpiAct<0>, pg8::StaticOrder, true, true>(lds, gm, S, E, tid);
          hp_gemv_phase<0>(lds, AB32, D, args.in[11] + (size_t)l * D * D, D, D, M32, G, bid, wave, lane, tid); }
        SEAM();
        if (STOP_AT == 4) DUMP_BF16(mmb, D, 0);
        { PHASE_IDS(); rows_phase(lds + wave * 1024, l == 0 ? x : out, mmb, args.in[12] + l * D, out, yb, gw, ngw, lane, M32, Y32, args.in[13] + l * D); }
        SEAM();
        if (STOP_AT == 5) DUMP_BF16(yb, D, 0);
        { PHASE_IDS(); pg8::Gemm gm{yb, W1T, M, FF, D}; pg8::StaticOrder S; S.init(M, FF, G, bid); pg8::EpiAct<2> E{f1, FF, 0};
          pg8::gemm_phase<pg8::EpiAct<2>, pg8::StaticOrder, true, true>(lds, gm, S, E, tid);
          hp_gemv_phase<2>(lds, Y32, D, args.in[14] + (size_t)l * D * FF, FF, FF, F1_32, G, bid, wave, lane, tid); }
        SEAM();
        { PHASE_IDS(); pg8::Gemm gm{f1, W2T, M, D, FF}; pg8::StaticOrder S; S.init(M, D, G, bid); pg8::EpiAct<0> E{mmb, D, 0};
          pg8::gemm_phase<pg8::EpiAct<0>, pg8::StaticOrder, true, true>(lds, gm, S, E, tid);
          hp_gemv_phase<0>(lds, F1_32, FF, args.in[15] + (size_t)l * FF * D, D, D, F32o, G, bid, wave, lane, tid); }
        SEAM();
        if (STOP_AT == 6) DUMP_BF16(mmb, D, 0);
        if (STOP_AT == 7) DUMP_BF16(f1, FF, 0);
        { PHASE_IDS(); rows_phase(lds + wave * 1024, out, mmb, args.in[16] + l * D, out, (l + 1 < DEPTH) ? yb : nullptr, gw, ngw, lane, F32o, YH32, args.in[1] + (l + 1 < DEPTH ? l + 1 : l) * D); }
        if (l + 1 < DEPTH) SEAM();
    }
}

extern "C" void kernel_launch(void* const* d_in, const int* in_sizes, int n_in, void* d_out, int out_size, void* d_ws, size_t ws_size, hipStream_t stream) {
    static int grid = 0;
    if (grid == 0) {
        if (n_in != 17 || out_size != M * D || ws_size < WS_END) { fprintf(stderr, "kernel_launch: unexpected problem (n_in %d, out %d, ws %zu)\n", n_in, out_size, ws_size); grid = -1; return; }
        int dev = 0, cus = 0, per_cu = 0;
        hipGetDevice(&dev); hipDeviceGetAttribute(&cus, hipDeviceAttributeMultiprocessorCount, dev);
        hipFuncSetAttribute((const void*)fwd_megakernel, hipFuncAttributeMaxDynamicSharedMemorySize, LDS_BYTES);
        if (hipOccupancyMaxActiveBlocksPerMultiprocessor(&per_cu, (const void*)fwd_megakernel, NTHR, LDS_BYTES) != hipSuccess || per_cu < 1) per_cu = 1;
        (void)hipGetLastError();
        grid = cus * per_cu;
    }
    if (grid < 0) return;
    if (hipMemsetAsync(d_ws, 0, CTL_ZERO_BYTES, stream) != hipSuccess) { fprintf(stderr, "kernel_launch: memset failed\n"); return; }
    Args a{};
    for (int i = 0; i < 17; ++i) a.in[i] = (const float*)d_in[i];
    a.out = (float*)d_out; a.ws = (unsigned char*)d_ws; a.ph_lo = 0; a.ph_hi = 0;
    void* kargs[] = {&a};
    hipError_t e = hipLaunchCooperativeKernel((const void*)fwd_megakernel, dim3(grid), dim3(NTHR), kargs, LDS_BYTES, stream);
    if (e != hipSuccess) fprintf(stderr, "cooperative launch failed: %s (grid %d)\n", hipGetErrorString(e), grid);
}
```

```cpp
#include <hip/hip_runtime.h>
#include <hip/hip_cooperative_groups.h>
#include <cstdio>
#include <cstdint>
namespace cg = cooperative_groups;
namespace pg8 {
#define PG8_LAS __attribute__((address_space(3)))
typedef unsigned short bf16_t;
typedef short bf16x8 __attribute__((ext_vector_type(8)));
typedef float f32x4 __attribute__((ext_vector_type(4)));
typedef unsigned u32x4 __attribute__((ext_vector_type(4)));
constexpr int BM = 256, BK = 64, HALF = 128, HTB = HALF * BK * 2  , STAGE_BYTES = 8 * HTB, NXCD = 8, WGM = 8;

__host__ __device__ __forceinline__ int lds_byte(int r, int c) { const int st = (r >> 4) * 2 + (c >> 5), rr = r & 15, cc = c & 31, ob = rr * 64 + cc * 2; return st * 1024 + (ob ^ (((ob >> 9) & 1) << 5)); }
__host__ __device__ __forceinline__ void stage_rc(int b, int& R, int& C) { const int st = b / 1024, sb = b % 1024, swz = sb ^ (((sb >> 9) & 1) << 5); R = (st >> 1) * 16 + swz / 64; C = (st & 1) * 32 + (swz % 64) / 2; }
__host__ __device__ __forceinline__ int perm32(int rho) { const int n = rho >> 4, i = rho & 15; return 8 * (i >> 2) + 4 * n + (i & 3); }

struct Unit { int pm, pn; };
struct Gemm { const bf16_t* A; const bf16_t* Bt; int M, N, K; };

struct StaticOrder {
    int nM, nN, nwg, G, c;
    __host__ __device__ void init(int M, int N, int G_, int c_) { nM = M / BM; nN = N / BM; nwg = nM * nN; G = G_; c = c_; }
    __host__ __device__ bool next(int i, Unit& u) const {
        const long L = (long)i * G + c; if (L >= nwg) return false;
        int wgid = (int)L; { const int q = nwg / NXCD, r = nwg % NXCD, xcd = wgid % NXCD, off = wgid / NXCD; wgid = (xcd < r ? xcd * (q + 1) : r * (q + 1) + (xcd - r) * q) + off; }
        const int nig = WGM * nN, gid = wgid / nig, fm = gid * WGM, gsz = (nM - fm) < WGM ? (nM - fm) : WGM;
        u.pm = fm + ((wgid % nig) % gsz); u.pn = (wgid % nig) / gsz; return true;
    }
    __device__ __forceinline__ void a_ready(const Unit&) const {}
    __device__ __forceinline__ void done(const Unit&) const {}
};

typedef __bf16 hwbf2e __attribute__((ext_vector_type(2)));
typedef float hwf2e __attribute__((ext_vector_type(2)));
__device__ __forceinline__ unsigned cvt_pk_bf16(float lo, float hi) { const hwf2e v = {lo, hi}; return __builtin_bit_cast(unsigned, __builtin_convertvector(v, hwbf2e)); }
__device__ __forceinline__ float gelu_tanh(float x) {
    const float u = x * (0.7978845608028654f + 0.035677408136300125f * x * x);
    const float e = __builtin_amdgcn_exp2f(u * -2.885390081777927f);
    return x * __builtin_amdgcn_rcpf(1.0f + e);
}
template <int ACT> struct EpiAct {
    static constexpr bool PERM = true, AFTER_DRAIN = false;
    bf16_t* O; int ldc; int act_tiles;
    __device__ __forceinline__ void operator()(const f32x4 (&acc)[2][2][4][2], const Unit& u, int wr, int wc, int fr, int fq) const {
        const int row0 = u.pm * BM + wr * 64 + fr; const int col0 = u.pn * BM + wc * 32 + 8 * fq;
        const bool act = (ACT == 1) ? (u.pn < act_tiles) : true;
#pragma unroll
        for (int ai = 0; ai < 2; ++ai)
#pragma unroll
            for (int m = 0; m < 4; ++m) { bf16_t* rowp = O + (size_t)(row0 + ai * HALF + m * 16) * ldc + col0;
#pragma unroll
                for (int bj = 0; bj < 2; ++bj) { f32x4 v0 = acc[ai][bj][m][0], v1 = acc[ai][bj][m][1];
                    if (ACT == 1) { if (act) {
#pragma unroll
                        for (int e = 0; e < 4; ++e) { v0[e] = gelu_tanh(v0[e]); v1[e] = gelu_tanh(v1[e]); } } }
                    if (ACT == 2) {
#pragma unroll
                        for (int e = 0; e < 4; ++e) { const float a = fmaxf(v0[e], 0.f), b = fmaxf(v1[e], 0.f); v0[e] = a * a; v1[e] = b * b; } }
                    u32x4 w; w.x = cvt_pk_bf16(v0[0], v0[1]); w.y = cvt_pk_bf16(v0[2], v0[3]); w.z = cvt_pk_bf16(v1[0], v1[1]); w.w = cvt_pk_bf16(v1[2], v1[3]);
                    *(u32x4*)(rowp + bj * HALF) = w; } }
    }
};

template <class Epi, class Sched, bool ALIGN_EPI = false, bool SP2 = false>
__device__ __forceinline__ void gemm_phase(PG8_LAS unsigned char* lds, const Gemm g, const Sched& S, const Epi& E, const int tid) {
    const int wid = __builtin_amdgcn_readfirstlane(tid >> 6), lane = tid & 63, wr = wid >> 2, wc = wid & 3, fr = lane & 15, fq = lane >> 4;
    const int K = g.K, nt = K / BK;
    unsigned voffA[2], voffB[2];
#pragma unroll
    for (int i = 0; i < 2; ++i) { int R, C; stage_rc(tid * 16 + i * 8192, R, C); const int Rb = Epi::PERM ? ((R & ~31) + perm32(R & 31)) : R;
        voffA[i] = (unsigned)(R * K + C) * 2u; voffB[i] = (unsigned)(Rb * K + C) * 2u; }
    const size_t kstep = (size_t)(BK * 2);
    const size_t hstep = (size_t)HALF * K * 2;
    const size_t tstep = 2 * hstep;
    const unsigned ldsw = (unsigned)wid * 1024u;
    const int aoff = lds_byte(wr * 64 + fr, fq * 8), boff = lds_byte(wc * 32 + fr, fq * 8);
#define PG8_SA(b, h) (((b) * 2 + (h)) * HTB)
#define PG8_SB(b, h) ((4 + (b) * 2 + (h)) * HTB)
#define PG8_STAGE(bufoff, gbase, voff) do { _Pragma("unroll") for (int _i = 0; _i < 2; ++_i) \
        __builtin_amdgcn_global_load_lds((const unsigned*)((const char*)(gbase) + (voff)[_i]), (PG8_LAS unsigned*)(lds + (bufoff) + ldsw + _i * 8192), 16, 0, 0); } while (0)
#define PG8_LDA(dst, b, h) do { _Pragma("unroll") for (int m = 0; m < 4; ++m) _Pragma("unroll") for (int k = 0; k < 2; ++k) dst[m][k] = *(const PG8_LAS bf16x8*)(lds + PG8_SA(b, h) + aoff + m * 2048 + k * 1024); } while (0)
#define PG8_LDB(dst, b, h) do { _Pragma("unroll") for (int n = 0; n < 2; ++n) _Pragma("unroll") for (int k = 0; k < 2; ++k) dst[n][k] = *(const PG8_LAS bf16x8*)(lds + PG8_SB(b, h) + boff + n * 2048 + k * 1024); } while (0)
#define PG8_MMA(ai, bj, At, Bt) do { __builtin_amdgcn_s_setprio(1); _Pragma("unroll") for (int m = 0; m < 4; ++m) _Pragma("unroll") for (int n = 0; n < 2; ++n) _Pragma("unroll") for (int k = 0; k < 2; ++k) \
        acc[ai][bj][m][n] = __builtin_amdgcn_mfma_f32_16x16x32_bf16(Bt[n][k], At[m][k], acc[ai][bj][m][n], 0, 0, 0); __builtin_amdgcn_s_setprio(0); } while (0)
#define PG8_WAIT_V(n) asm volatile("s_waitcnt vmcnt(" #n ")" ::: "memory")
#define PG8_WAIT_L(n) asm volatile("s_waitcnt lgkmcnt(" #n ")" ::: "memory")
#define PG8_BAR __builtin_amdgcn_s_barrier()
#define PG8_SCHED __builtin_amdgcn_sched_barrier(0)
    Unit cur, nxt; int ui = 0;
    if (!S.next(0, cur)) return;
    f32x4 acc[2][2][4][2];
#pragma unroll
    for (int a = 0; a < 2; ++a)
#pragma unroll
        for (int b = 0; b < 2; ++b)
#pragma unroll
            for (int m = 0; m < 4; ++m)
#pragma unroll
                for (int n = 0; n < 2; ++n) acc[a][b][m][n] = (f32x4){0.f, 0.f, 0.f, 0.f};
    bf16x8 At[4][2], B0[2][2], B1[2][2];
    const char* cA = (const char*)g.A + (size_t)cur.pm * tstep; const char* cB = (const char*)g.Bt + (size_t)cur.pn * tstep;
    S.a_ready(cur);
    if constexpr (SP2) {
        PG8_STAGE(PG8_SB(0, 0), cB, voffB); PG8_STAGE(PG8_SB(0, 1), cB + hstep, voffB); PG8_STAGE(PG8_SA(0, 0), cA, voffA); PG8_STAGE(PG8_SA(0, 1), cA + hstep, voffA);
        if (wr == 1) PG8_BAR;
        PG8_WAIT_V(2); PG8_BAR;
        PG8_STAGE(PG8_SB(1, 0), cB + kstep, voffB); PG8_STAGE(PG8_SA(1, 0), cA + kstep, voffA); PG8_STAGE(PG8_SB(1, 1), cB + hstep + kstep, voffB);
        PG8_WAIT_V(6); PG8_BAR;
    } else {
        PG8_STAGE(PG8_SB(0, 0), cB, voffB); PG8_STAGE(PG8_SA(0, 0), cA, voffA); PG8_STAGE(PG8_SB(0, 1), cB + hstep, voffB); PG8_STAGE(PG8_SA(0, 1), cA + hstep, voffA);
        if (wr == 1) PG8_BAR;
        PG8_WAIT_V(4); PG8_BAR;
        PG8_STAGE(PG8_SB(1, 0), cB + kstep, voffB); PG8_STAGE(PG8_SA(1, 0), cA + kstep, voffA); PG8_STAGE(PG8_SB(1, 1), cB + hstep + kstep, voffB);
        PG8_WAIT_V(6); PG8_BAR;
    }
    for (;;) {
        const bool has_next = S.next(ui + 1, nxt);
        const char* nA = has_next ? (const char*)g.A + (size_t)nxt.pm * tstep : cA; const char* nB = has_next ? (const char*)g.Bt + (size_t)nxt.pn * tstep : cB;
        for (int t = 0; t < nt; t += 2) {
            const bool last = (t == nt - 2);
            const char* a1 = cA + (size_t)(t + 1) * kstep;
            const char* a2 = last ? nA : cA + (size_t)(t + 2) * kstep; const char* b2 = last ? nB : cB + (size_t)(t + 2) * kstep;
            const char* a3 = a2 + kstep; const char* b3 = b2 + kstep;
            if (last && has_next) S.a_ready(nxt);
            if constexpr (SP2) {
            PG8_LDB(B0, 0, 0); PG8_LDB(B1, 0, 1); PG8_SCHED; PG8_LDA(At, 0, 0); PG8_STAGE(PG8_SA(1, 1), a1 + hstep, voffA);
            PG8_WAIT_V(8); PG8_WAIT_L(0); PG8_BAR; PG8_MMA(0, 0, At, B0); PG8_MMA(0, 1, At, B1); PG8_BAR; PG8_SCHED;
            PG8_LDA(At, 0, 1); PG8_STAGE(PG8_SB(0, 0), b2, voffB); PG8_STAGE(PG8_SB(0, 1), b2 + hstep, voffB); PG8_STAGE(PG8_SA(0, 0), a2, voffA);
            PG8_WAIT_V(8); PG8_WAIT_L(0); PG8_BAR; PG8_MMA(1, 0, At, B0); PG8_MMA(1, 1, At, B1); PG8_BAR; PG8_SCHED;
            PG8_LDB(B0, 1, 0); PG8_LDB(B1, 1, 1); PG8_SCHED; PG8_LDA(At, 1, 0); PG8_STAGE(PG8_SA(0, 1), a2 + hstep, voffA);
            PG8_WAIT_V(8); PG8_WAIT_L(0); PG8_BAR; PG8_MMA(0, 0, At, B0); PG8_MMA(0, 1, At, B1); PG8_BAR; PG8_SCHED;
            PG8_LDA(At, 1, 1); PG8_STAGE(PG8_SB(1, 0), b3, voffB); PG8_STAGE(PG8_SB(1, 1), b3 + hstep, voffB); PG8_STAGE(PG8_SA(1, 0), a3, voffA);
            PG8_WAIT_V(8); PG8_WAIT_L(0); PG8_BAR; PG8_MMA(1, 0, At, B0); PG8_MMA(1, 1, At, B1); PG8_BAR; PG8_SCHED;
            } else {
            PG8_LDB(B0, 0, 0); PG8_SCHED; PG8_LDA(At, 0, 0); PG8_STAGE(PG8_SA(1, 1), a1 + hstep, voffA);
            PG8_WAIT_L(8); PG8_BAR; PG8_WAIT_L(0); PG8_MMA(0, 0, At, B0); PG8_BAR; PG8_SCHED;
            PG8_LDB(B1, 0, 1); PG8_STAGE(PG8_SB(0, 0), b2, voffB);
            PG8_BAR; PG8_WAIT_L(0); PG8_MMA(0, 1, At, B1); PG8_BAR;
            PG8_LDA(At, 0, 1); PG8_STAGE(PG8_SA(0, 0), a2, voffA);
            PG8_BAR; PG8_WAIT_L(0); PG8_MMA(1, 0, At, B0); PG8_BAR; PG8_SCHED;
            PG8_STAGE(PG8_SB(0, 1), b2 + hstep, voffB);
            PG8_WAIT_V(6); PG8_BAR; PG8_MMA(1, 1, At, B1); PG8_BAR;
            PG8_LDB(B0, 1, 0); PG8_SCHED; PG8_LDA(At, 1, 0); PG8_STAGE(PG8_SA(0, 1), a2 + hstep, voffA);
            PG8_WAIT_L(8); PG8_BAR; PG8_WAIT_L(0); PG8_MMA(0, 0, At, B0); PG8_BAR; PG8_SCHED;
            PG8_LDB(B1, 1, 1); PG8_STAGE(PG8_SB(1, 0), b3, voffB);
            PG8_BAR; PG8_WAIT_L(0); PG8_MMA(0, 1, At, B1); PG8_BAR;
            PG8_LDA(At, 1, 1); PG8_STAGE(PG8_SA(1, 0), a3, voffA);
            PG8_BAR; PG8_WAIT_L(0); PG8_MMA(1, 0, At, B0); PG8_BAR; PG8_SCHED;
            PG8_STAGE(PG8_SB(1, 1), b3 + hstep, voffB);
            PG8_WAIT_V(6); PG8_BAR; PG8_MMA(1, 1, At, B1); PG8_BAR;
            }
        }
        if constexpr (ALIGN_EPI) { if (wr == 0) PG8_BAR; }
        if constexpr (!Epi::AFTER_DRAIN) { E(acc, cur, wr, wc, fr, fq); S.done(cur); }
        if (!has_next) break;
#pragma unroll
        for (int a = 0; a < 2; ++a)
#pragma unroll
            for (int b = 0; b < 2; ++b)
#pragma unroll
                for (int m = 0; m < 4; ++m)
#pragma unroll
                    for (int n = 0; n < 2; ++n) acc[a][b][m][n] = (f32x4){0.f, 0.f, 0.f, 0.f};
        cur = nxt; cA = nA; cB = nB; ++ui;
        if constexpr (ALIGN_EPI) { if (wr == 1) PG8_BAR; }
    }
    PG8_WAIT_V(0);
    if constexpr (!ALIGN_EPI) { if (wr == 0) PG8_BAR; }
    PG8_BAR;
    if constexpr (Epi::AFTER_DRAIN) { E.fused(acc, cur, wr, wc, fr, fq, lds, wid, lane); S.done(cur); }
#undef PG8_SA
#undef PG8_SB
#undef PG8_STAGE
#undef PG8_LDA
#undef PG8_LDB
#undef PG8_MMA
#undef PG8_WAIT_V
#undef PG8_WAIT_L
#undef PG8_BAR
#undef PG8_SCHED
}
}

#ifndef GMLP_DBG
#define GMLP_DBG 0
#endif
constexpr int NWAVES = 8, NTHR = 512;
constexpr int BATCH = 4, SEQ = 8192, D = 1024, DEPTH = 4, M = BATCH * SEQ;
constexpr int D_IN = 2576, NZ = 2816;
constexpr int FF = 4096;
constexpr int ZU = 0, ZV = 512, ZQ = 1024, ZK = 1280, ZVB = 1536, ZG = 2048, ZP = 2560;
constexpr float EPS = 1e-6f;
constexpr int NCHUNK = M / 64;
constexpr size_t MiB = 1u << 20;
constexpr size_t WS_WM = 1 * MiB;
constexpr size_t WS_DEC = 1 * MiB + 512 * 1024;
constexpr size_t WS_W = 2 * MiB;
constexpr size_t W_IN_B = (size_t)NZ * D * 2, W_OUT_B = (size_t)D * D * 2, W_1_B = (size_t)FF * D * 2, W_2_B = (size_t)D * FF * 2, W_LAYER_B = W_IN_B + W_OUT_B + W_1_B + W_2_B;
constexpr size_t WS_F1 = 96 * MiB;
constexpr size_t WS_Z = 96 * MiB;
constexpr size_t WS_AB = 272 * MiB;
constexpr size_t WS_QE = 336 * MiB;
constexpr size_t WS_Y = 352 * MiB;
constexpr size_t WS_SP = 352 * MiB;
constexpr size_t WS_OI = 384 * MiB;
constexpr size_t WS_MM = 416 * MiB;
constexpr size_t WS_UPD = 416 * MiB;
constexpr size_t WS_HP = 480 * MiB;
constexpr size_t WS_END = 494 * MiB;
static_assert(WS_W + DEPTH * W_LAYER_B <= WS_F1, "weights fit");
constexpr int LDS_BYTES = 149504;

#define GAS __attribute__((address_space(1)))
#define LAS __attribute__((address_space(3)))
typedef unsigned short bf16;
typedef unsigned v4u __attribute__((ext_vector_type(4)));
typedef unsigned v2u __attribute__((ext_vector_type(2)));
typedef float f32x4 __attribute__((ext_vector_type(4)));
typedef short bf16x8 __attribute__((ext_vector_type(8)));
#define LDS_WAIT() asm volatile("s_waitcnt lgkmcnt(0)" ::: "memory")
#define MFMA_DRAIN() asm volatile("s_nop 15\n\ts_nop 15\n\ts_nop 15\n\ts_nop 15\n\ts_nop 15\n\ts_nop 15\n\ts_nop 15\n\ts_nop 15\n\ts_nop 15\n\ts_nop 15\n\ts_nop 15\n\ts_nop 15\n\ts_nop 15\n\ts_nop 15\n\ts_nop 15\n\ts_nop 15" ::: "memory")
#define FRAG_WAIT() __builtin_amdgcn_sched_barrier(0)
#define MFMA16(a, b, c) __builtin_amdgcn_mfma_f32_16x16x32_bf16((a), (b), (c), 0, 0, 0)

__device__ __forceinline__ unsigned f2bf(float f) { unsigned u = __builtin_bit_cast(unsigned, f); return (u + 0x7fffu + ((u >> 16) & 1u)) >> 16; }
typedef __bf16 hwbf2 __attribute__((ext_vector_type(2)));
typedef float hwf2 __attribute__((ext_vector_type(2)));
__device__ __forceinline__ unsigned pk2(float lo, float hi) { const hwf2 v = {lo, hi}; return __builtin_bit_cast(unsigned, __builtin_convertvector(v, hwbf2)); }
__device__ __forceinline__ float bflo(unsigned w) { return __builtin_bit_cast(float, w << 16); }
__device__ __forceinline__ float bfhi(unsigned w) { return __builtin_bit_cast(float, w & 0xffff0000u); }
__device__ __forceinline__ float bf1(bf16 h) { return __builtin_bit_cast(float, (unsigned)h << 16); }
__device__ __forceinline__ void unpack8(const v4u w, float (&o)[8]) { o[0] = bflo(w.x); o[1] = bfhi(w.x); o[2] = bflo(w.y); o[3] = bfhi(w.y); o[4] = bflo(w.z); o[5] = bfhi(w.z); o[6] = bflo(w.w); o[7] = bfhi(w.w); }
__device__ __forceinline__ v4u pack8(const float (&o)[8]) { v4u w; w.x = pk2(o[0], o[1]); w.y = pk2(o[2], o[3]); w.z = pk2(o[4], o[5]); w.w = pk2(o[6], o[7]); return w; }
__device__ __forceinline__ float wave_sum(float v) {
#pragma unroll
    for (int o = 1; o < 64; o <<= 1) v += __shfl_xor(v, o);
    return v;
}
__device__ __forceinline__ float row16_sum(float v) {
#pragma unroll
    for (int o = 1; o < 16; o <<= 1) v += __shfl_xor(v, o);
    return v;
}

__device__ __forceinline__ void row16_sum4_lds(LAS unsigned char* scr, float (&v)[4], int lane) {
    *(LAS f32x4*)(scr + lane * 16) = (f32x4){v[0], v[1], v[2], v[3]};
    asm volatile("s_waitcnt lgkmcnt(0)" ::: "memory");
    f32x4 s = (f32x4){0.f, 0.f, 0.f, 0.f};
#pragma unroll
    for (int k = 0; k < 16; ++k) s += *(const LAS f32x4*)(scr + ((lane & 48) + k) * 16);
    asm volatile("s_waitcnt lgkmcnt(0)" ::: "memory");
    v[0] = s.x; v[1] = s.y; v[2] = s.z; v[3] = s.w;
}

__device__ __forceinline__ float wave_sum_lds(LAS unsigned char* scr, float v, int lane) {
    *(LAS float*)(scr + lane * 4) = v;
    asm volatile("s_waitcnt lgkmcnt(0)" ::: "memory");
    f32x4 s = (f32x4){0.f, 0.f, 0.f, 0.f};
#pragma unroll
    for (int k = 0; k < 16; ++k) s += *(const LAS f32x4*)(scr + k * 16);
    asm volatile("s_waitcnt lgkmcnt(0)" ::: "memory");
    return (s.x + s.y) + (s.z + s.w);
}
__device__ __forceinline__ void wave_sum4_lds(LAS unsigned char* scr, float (&v)[4], int lane) {
    *(LAS f32x4*)(scr + lane * 16) = (f32x4){v[0], v[1], v[2], v[3]};
    asm volatile("s_waitcnt lgkmcnt(0)" ::: "memory");
    f32x4 s = (f32x4){0.f, 0.f, 0.f, 0.f};
#pragma unroll
    for (int k = 0; k < 16; ++k) s += *(const LAS f32x4*)(scr + ((lane & 48) + k) * 16);
    asm volatile("s_waitcnt lgkmcnt(0)" ::: "memory");
    if ((lane & 15) == 0) *(LAS f32x4*)(scr + (lane >> 4) * 16) = s;
    asm volatile("s_waitcnt lgkmcnt(0)" ::: "memory");
    const f32x4 t0 = *(const LAS f32x4*)(scr), t1 = *(const LAS f32x4*)(scr + 16), t2 = *(const LAS f32x4*)(scr + 32), t3 = *(const LAS f32x4*)(scr + 48);
    asm volatile("s_waitcnt lgkmcnt(0)" ::: "memory");
    const f32x4 t = (t0 + t1) + (t2 + t3);
    v[0] = t.x; v[1] = t.y; v[2] = t.z; v[3] = t.w;
}

constexpr int HPR = 4, HP_ROWS = 16;
__device__ __forceinline__ size_t hp_row(int r16) { return (size_t)(r16 >> 2) * SEQ + (size_t)(r16 & 3); }
template <bool IN_BF16, int ACT>
__device__ __forceinline__ void hp_gemv4(LAS unsigned char* lds, const void* in, int K, const float* W, int ldw, int c0, float* out, int ldo, int wave, int lane) {
    const int c = c0 + (wave & 3), kbeg = (wave >> 2) * (K >> 1), steps = (K >> 1) >> 6;
    float acc[16];
#pragma unroll
    for (int r = 0; r < 16; ++r) acc[r] = 0.f;
#pragma unroll 2
    for (int s = 0; s < steps; ++s) { const int k = kbeg + s * 64 + lane;
        const float w = W[(size_t)k * ldw + c];
#pragma unroll
        for (int r = 0; r < 16; ++r) { const float a = IN_BF16 ? bf1(((const bf16*)in)[hp_row(r) * D + k]) : ((const float*)in)[(size_t)r * K + k]; acc[r] += a * w; } }
    LAS unsigned char* scr = lds + wave * 1024;
#pragma unroll
    for (int q = 0; q < 4; ++q) { float v[4] = {acc[4 * q], acc[4 * q + 1], acc[4 * q + 2], acc[4 * q + 3]}; wave_sum4_lds(scr, v, lane); acc[4 * q] = v[0]; acc[4 * q + 1] = v[1]; acc[4 * q + 2] = v[2]; acc[4 * q + 3] = v[3]; }
    LAS float* X = (LAS float*)(lds + 8192);
    if (lane == 0) {
#pragma unroll
        for (int r = 0; r < 16; ++r) X[wave * 16 + r] = acc[r]; }
    __syncthreads();
    if (wave < 4 && lane < 16) { float v = X[wave * 16 + lane] + X[(wave + 4) * 16 + lane]; if (ACT == 2) { v = fmaxf(v, 0.f); v = v * v; } out[(size_t)lane * ldo + c0 + wave] = v; }
    __syncthreads();
}

template <int ACT>
__device__ __forceinline__ void hp_gemv_phase(LAS unsigned char* lds, const float* in32, int K, const float* W, int ldw, int N, float* out, int G, int bid, int wave, int lane, int tid) {
    LAS float* INS = (LAS float*)(lds + 16384);
    const int nch = K >> 10, half = wave >> 2;
    for (int cg = bid; cg < (N >> 2); cg += G) {
        float acc[16];
#pragma unroll
        for (int r = 0; r < 16; ++r) acc[r] = 0.f;
        const int c = 4 * cg + (wave & 3);
        for (int ch = 0; ch < nch; ++ch) {
            if (nch > 1 || cg == bid) {
                __syncthreads();
#pragma unroll
                for (int i = 0; i < 8; ++i) { const int idx = tid + 512 * i, r = idx >> 8, k4 = idx & 255;
                    *(LAS f32x4*)(INS + r * 1024 + 4 * k4) = *(const f32x4*)(in32 + (size_t)r * K + ch * 1024 + 4 * k4); }
                __syncthreads();
            }
            const int kb = ch * 1024 + half * 512 + lane;
            float w8[8];
#pragma unroll
            for (int s = 0; s < 8; ++s) w8[s] = W[(size_t)(kb + s * 64) * ldw + c];
#pragma unroll
            for (int s = 0; s < 8; ++s)
#pragma unroll
                for (int r = 0; r < 16; ++r) acc[r] += INS[r * 1024 + half * 512 + s * 64 + lane] * w8[s];
        }
        LAS unsigned char* scr = lds + wave * 1024;
#pragma unroll
        for (int q = 0; q < 4; ++q) { float v[4] = {acc[4 * q], acc[4 * q + 1], acc[4 * q + 2], acc[4 * q + 3]}; wave_sum4_lds(scr, v, lane); acc[4 * q] = v[0]; acc[4 * q + 1] = v[1]; acc[4 * q + 2] = v[2]; acc[4 * q + 3] = v[3]; }
        LAS float* X = (LAS float*)(lds + 8192);
        if (lane == 0) {
#pragma unroll
            for (int r = 0; r < 16; ++r) X[wave * 16 + r] = acc[r]; }
        __syncthreads();
        if (wave < 4 && lane < 16) { float v = X[wave * 16 + lane] + X[(wave + 4) * 16 + lane]; if (ACT == 2) { v = fmaxf(v, 0.f); v = v * v; } out[(size_t)lane * N + 4 * cg + wave] = v; }
        __syncthreads();
    }
}

__device__ __forceinline__ void p0_transpose_item(const float* W, int ldw, int ncols, int K, bf16* WT, const float* kscale, int qlo, int qhi, LAS float* scr, int item, int lane) {
    const int nblk = ncols / 32, kb = item / nblk, nb = item % nblk, k0 = 64 * kb, n0 = 32 * nb;
    const float cs = (n0 >= qlo && n0 < qhi) ? 0.125f : 1.0f;
    float wreg[32];
#pragma unroll
    for (int i = 0; i < 32; ++i) wreg[i] = W[(size_t)(k0 + 2 * i + (lane >> 5)) * ldw + n0 + (lane & 31)];
#pragma unroll
    for (int i = 0; i < 32; ++i) { const int kk = 2 * i + (lane >> 5); float w = wreg[i]; if (kscale) w *= kscale[k0 + kk]; scr[kk * 33 + (lane & 31)] = w * cs; }
    LDS_WAIT(); asm volatile("" ::: "memory");
    const int c = lane & 7;
#pragma unroll
    for (int j = 0; j < 4; ++j) { const int n = (lane >> 3) + 8 * j; const LAS float* s = scr + (8 * c) * 33 + n;
        v4u o; o.x = pk2(s[0 * 33], s[1 * 33]); o.y = pk2(s[2 * 33], s[3 * 33]); o.z = pk2(s[4 * 33], s[5 * 33]); o.w = pk2(s[6 * 33], s[7 * 33]);
        *(GAS v4u*)(WT + (size_t)(n0 + n) * K + k0 + 8 * c) = o; }
    LDS_WAIT(); asm volatile("" ::: "memory");
}
__device__ __forceinline__ void p0_gate_item(const float* Win, const float* gw, const float* g, bf16* WT, int item, int lane) {
    const int np = item >> 1, k0 = ((item & 1) * 64 + lane) * 8;
    float gwv[16];
#pragma unroll
    for (int r = 0; r < 16; ++r) gwv[r] = gw[r * 256 + np];
    float o[8];
#pragma unroll
    for (int j = 0; j < 8; ++j) { const float* wr = Win + (size_t)(k0 + j) * D_IN + 2560; float s = 0.f;
#pragma unroll
        for (int r4 = 0; r4 < 4; ++r4) { const f32x4 w = *(const f32x4*)(wr + 4 * r4); s += w.x * gwv[4 * r4] + w.y * gwv[4 * r4 + 1] + w.z * gwv[4 * r4 + 2] + w.w * gwv[4 * r4 + 3]; }
        o[j] = s * g[k0 + j]; }
    *(GAS v4u*)(WT + (size_t)(2560 + np) * D + k0) = pack8(o);
}

__device__ __forceinline__ void rows_add_stream(LAS unsigned char* scr, float (&hv)[16], const v4u mc0, const v4u mc1, const float* m32, const float* g, int row, int lane) {
    float mv[16];
    const int tpos = row & (SEQ - 1); const bool hp = (m32 != nullptr) && (tpos < HPR);
    if (hp) { const float* m3 = m32 + (size_t)((row >> 13) * 4 + tpos) * D + 8 * lane;
#pragma unroll
        for (int e = 0; e < 2; ++e) { const f32x4 a = *(const f32x4*)(m3 + 512 * e), b = *(const f32x4*)(m3 + 512 * e + 4);
            mv[8 * e + 0] = a.x; mv[8 * e + 1] = a.y; mv[8 * e + 2] = a.z; mv[8 * e + 3] = a.w; mv[8 * e + 4] = b.x; mv[8 * e + 5] = b.y; mv[8 * e + 6] = b.z; mv[8 * e + 7] = b.w; }
    } else {
        float t[8]; unpack8(mc0, t);
#pragma unroll
        for (int i = 0; i < 8; ++i) mv[i] = t[i];
        unpack8(mc1, t);
#pragma unroll
        for (int i = 0; i < 8; ++i) mv[8 + i] = t[i]; }
    float ss = 0.f;
#pragma unroll
    for (int i = 0; i < 16; ++i) ss += mv[i] * mv[i];
    const float rstd = 1.0f / sqrtf(wave_sum_lds(scr, ss, lane) * (1.0f / D) + EPS);
#pragma unroll
    for (int e = 0; e < 2; ++e) { const f32x4 ga = *(const f32x4*)(g + 8 * lane + 512 * e), gb = *(const f32x4*)(g + 8 * lane + 512 * e + 4);
        const float gg[8] = {ga.x, ga.y, ga.z, ga.w, gb.x, gb.y, gb.z, gb.w};
#pragma unroll
        for (int i = 0; i < 8; ++i) hv[8 * e + i] += mv[8 * e + i] * rstd * gg[i]; }
}
__device__ __forceinline__ void rows_phase(LAS unsigned char* scr, const float* hin, const bf16* mm, const float* g, float* hout, bf16* y, int gw, int ngw, int lane, const float* m32 = nullptr, float* y32out = nullptr, const float* ygain = nullptr,
                                           const bf16* mm2 = nullptr, const float* g2 = nullptr, const float* m32b = nullptr) {
    f32x4 hn[4]; v4u mn[2] = {(v4u){0u, 0u, 0u, 0u}, (v4u){0u, 0u, 0u, 0u}}, mn2[2] = {(v4u){0u, 0u, 0u, 0u}, (v4u){0u, 0u, 0u, 0u}};
#define NT_LD4F(p) __builtin_nontemporal_load((const f32x4*)(p))
#define NT_LD4U(p) __builtin_nontemporal_load((const v4u*)(p))
    { const float* hr = hin + (size_t)gw * D + 8 * lane; hn[0] = NT_LD4F(hr); hn[1] = NT_LD4F(hr + 4); hn[2] = NT_LD4F(hr + 512); hn[3] = NT_LD4F(hr + 516);
      if (mm) { const bf16* mr = mm + (size_t)gw * D + 8 * lane; mn[0] = NT_LD4U(mr); mn[1] = NT_LD4U(mr + 512); }
      if (mm2) { const bf16* mr = mm2 + (size_t)gw * D + 8 * lane; mn2[0] = NT_LD4U(mr); mn2[1] = NT_LD4U(mr + 512); } }
    for (int row = gw; row < M; row += ngw) {
        float hv[16];
        hv[0] = hn[0].x; hv[1] = hn[0].y; hv[2] = hn[0].z; hv[3] = hn[0].w; hv[4] = hn[1].x; hv[5] = hn[1].y; hv[6] = hn[1].z; hv[7] = hn[1].w;
        hv[8] = hn[2].x; hv[9] = hn[2].y; hv[10] = hn[2].z; hv[11] = hn[2].w; hv[12] = hn[3].x; hv[13] = hn[3].y; hv[14] = hn[3].z; hv[15] = hn[3].w;
        const v4u mc0 = mn[0], mc1 = mn[1], mb0 = mn2[0], mb1 = mn2[1];
        if (row + ngw < M) { const float* hr = hin + (size_t)(row + ngw) * D + 8 * lane; hn[0] = NT_LD4F(hr); hn[1] = NT_LD4F(hr + 4); hn[2] = NT_LD4F(hr + 512); hn[3] = NT_LD4F(hr + 516);
            if (mm) { const bf16* mr = mm + (size_t)(row + ngw) * D + 8 * lane; mn[0] = NT_LD4U(mr); mn[1] = NT_LD4U(mr + 512); }
            if (mm2) { const bf16* mr = mm2 + (size_t)(row + ngw) * D + 8 * lane; mn2[0] = NT_LD4U(mr); mn2[1] = NT_LD4U(mr + 512); } }
        if (mm) rows_add_stream(scr, hv, mc0, mc1, m32, g, row, lane);
        if (mm2) rows_add_stream(scr, hv, mb0, mb1, m32b, g2, row, lane);
        if (hout) { float* orow = hout + (size_t)row * D + 8 * lane;
#pragma unroll
            for (int e = 0; e < 2; ++e) { __builtin_nontemporal_store((f32x4){hv[8 * e], hv[8 * e + 1], hv[8 * e + 2], hv[8 * e + 3]}, (f32x4*)(orow + 512 * e)); __builtin_nontemporal_store((f32x4){hv[8 * e + 4], hv[8 * e + 5], hv[8 * e + 6], hv[8 * e + 7]}, (f32x4*)(orow + 512 * e + 4)); } }
        if (y) {
            float ss = 0.f;
#pragma unroll
            for (int i = 0; i < 16; ++i) ss += hv[i] * hv[i];
            const float rstd = 1.0f / sqrtf(wave_sum_lds(scr, ss, lane) * (1.0f / D) + EPS);
            bf16* yr = y + (size_t)row * D + 8 * lane;
#pragma unroll
            for (int e = 0; e < 2; ++e) { float t[8];
#pragma unroll
                for (int i = 0; i < 8; ++i) t[i] = hv[8 * e + i] * rstd;
                *(v4u*)(yr + 512 * e) = pack8(t); }
            const int tpos2 = row & (SEQ - 1);
            if (y32out != nullptr && tpos2 < HPR) { float* y3 = y32out + (size_t)((row >> 13) * 4 + tpos2) * D + 8 * lane;
#pragma unroll
                for (int e = 0; e < 2; ++e)
#pragma unroll
                    for (int i = 0; i < 8; ++i) y3[512 * e + i] = hv[8 * e + i] * rstd * ygain[8 * lane + 512 * e + i]; }
        }
    }
}

constexpr int VT_ROW = 272, VT_HEAD = 128 * VT_ROW;
__device__ __forceinline__ void gmlp_unit(LAS unsigned char* lds, float* ab32, const bf16* z, bf16* ab, const bf16* Wm, const float* ln_g, const float* ln_b, const float* bs, const float* out_g, int unit, int tid) {
    const int lane = tid & 63, wave = __builtin_amdgcn_readfirstlane(tid >> 6), x = lane & 15, g = lane >> 4;
    const size_t row0 = (size_t)unit * 128;
    {
        float gg[8], bb[8];
        { const f32x4 a = *(const f32x4*)(ln_g + 8 * lane), b = *(const f32x4*)(ln_g + 8 * lane + 4); gg[0] = a.x; gg[1] = a.y; gg[2] = a.z; gg[3] = a.w; gg[4] = b.x; gg[5] = b.y; gg[6] = b.z; gg[7] = b.w; }
        { const f32x4 a = *(const f32x4*)(ln_b + 8 * lane), b = *(const f32x4*)(ln_b + 8 * lane + 4); bb[0] = a.x; bb[1] = a.y; bb[2] = a.z; bb[3] = a.w; bb[4] = b.x; bb[5] = b.y; bb[6] = b.z; bb[7] = b.w; }
        const int h = lane >> 4;
#pragma unroll 1
        for (int it = 0; it < 4; ++it) {
            const int j0 = 16 * wave + 4 * it;
            float val[4][8];
            LAS unsigned char* scr1 = lds + 4 * VT_HEAD + wave * 1024;
            float sm[4];
#pragma unroll
            for (int t = 0; t < 4; ++t) {
                const v4u w = *(const v4u*)(z + (row0 + j0 + t) * NZ + ZV + 8 * lane);
                unpack8(w, val[t]);
                float s = 0.f;
#pragma unroll
                for (int i = 0; i < 8; ++i) s += val[t][i];
                sm[t] = s;
            }
            wave_sum4_lds(scr1, sm, lane);
            float s2[4];
#pragma unroll
            for (int t = 0; t < 4; ++t) { const float mean = sm[t] * (1.0f / 512.0f); float q = 0.f;
#pragma unroll
                for (int i = 0; i < 8; ++i) { val[t][i] -= mean; q += val[t][i] * val[t][i]; }
                s2[t] = q; }
            wave_sum4_lds(scr1, s2, lane);
#pragma unroll
            for (int t = 0; t < 4; ++t) { const float rstd = 1.0f / sqrtf(s2[t] * (1.0f / 512.0f) + EPS);
#pragma unroll
                for (int i = 0; i < 8; ++i) val[t][i] = val[t][i] * rstd * gg[i] + bb[i]; }
#pragma unroll
            for (int i = 0; i < 8; ++i) { v2u o; o.x = pk2(val[0][i], val[1][i]); o.y = pk2(val[2][i], val[3][i]);
                *(LAS v2u*)(lds + h * VT_HEAD + (i * 16 + x) * VT_ROW + j0 * 2) = o; }
        }
    }
    __syncthreads();
    if (GMLP_DBG == 7) {
        const bf16x8 a = (bf16x8){0x3f80, 0x3f00, 0x3e80, 0x3f80, 0x3f00, 0x3e80, 0x3f80, 0x3f00};
        for (int h = 0; h < 4; ++h) {
            f32x4 acc[8];
            for (int nt = 0; nt < 8; ++nt) acc[nt] = (f32x4){0.f, 0.f, 0.f, 0.f};
            for (int ks = 0; ks < 4; ++ks) {
                bf16x8 b[8];
#pragma unroll
                for (int nt = 0; nt < 8; ++nt) b[nt] = *(const LAS bf16x8*)(lds + h * VT_HEAD + (nt * 16 + x) * VT_ROW + (ks * 32 + 8 * g) * 2);
                FRAG_WAIT();
#pragma unroll
                for (int nt = 0; nt < 8; ++nt) acc[nt] = MFMA16(a, b[nt], acc[nt]);
            }
#pragma unroll
            for (int r = 0; r < 4; ++r) { float t[8];
#pragma unroll
                for (int nt = 0; nt < 8; ++nt) t[nt] = acc[nt][r];
                *(v4u*)(ab + (row0 + 16 * wave + 4 * g + r) * D + 128 * h + 8 * x) = pack8(t); }
        }
        __syncthreads();
        return;
    }
    if (GMLP_DBG == 6) {
        for (int h = 0; h < 4; ++h) { float f[8] = {0.f, 0.f, 0.f, 0.f, 0.f, 0.f, 0.f, 0.f};
            for (int nt = 0; nt < 8; ++nt) for (int ks = 0; ks < 4; ++ks) {
                const v4u b = *(const LAS v4u*)(lds + h * VT_HEAD + (nt * 16 + x) * VT_ROW + (ks * 32 + 8 * g) * 2);
                float t[8]; unpack8(b, t);
                for (int q = 0; q < 8; ++q) f[q] += t[q] * (float)(1 + nt + 8 * ks); }
            *(v4u*)(ab + (row0 + 16 * wave + x) * D + 128 * h + 8 * g) = pack8(f); }
        __syncthreads();
        return;
    }
    const int nk = (wave < 4) ? 2 : 4;
    float ssr[4] = {0.f, 0.f, 0.f, 0.f};
#pragma unroll 1
    for (int h = 0; h < 4; ++h) {
        f32x4 acc[8];
#pragma unroll
        for (int nt = 0; nt < 8; ++nt) acc[nt] = (f32x4){0.f, 0.f, 0.f, 0.f};
        bf16x8 a4[4];
#pragma unroll
        for (int ks = 0; ks < 4; ++ks) a4[ks] = *(const bf16x8*)(Wm + h * 16384 + (16 * wave + x) * 128 + ks * 32 + 8 * g);
#pragma unroll
        for (int ks = 0; ks < 4; ++ks) {
            if (ks < nk) {
#pragma unroll
                for (int nt = 0; nt < 8; ++nt) { const bf16x8 b = *(const LAS bf16x8*)(lds + h * VT_HEAD + (nt * 16 + x) * VT_ROW + (ks * 32 + 8 * g) * 2); acc[nt] = MFMA16(a4[ks], b, acc[nt]); }
            }
        }
#pragma unroll
        for (int r = 0; r < 4; ++r) {
            const int i = 16 * wave + 4 * g + r;
            const v4u w = *(const v4u*)(z + (row0 + i) * NZ + ZU + 128 * h + 8 * x);
            float uv[8]; unpack8(w, uv);
            const float bias = bs[h * 128 + i];
            float o[8];
#pragma unroll
            for (int nt = 0; nt < 8; ++nt) o[nt] = uv[nt] * (acc[nt][r] + bias);
            const v4u pw = pack8(o);
            float ob[8]; unpack8(pw, ob);
#pragma unroll
            for (int nt = 0; nt < 8; ++nt) ssr[r] += ob[nt] * ob[nt];
            *(v4u*)(ab + (row0 + i) * D + 128 * h + 8 * x) = pw;
        }
    }
    row16_sum4_lds(lds + 4 * VT_HEAD + wave * 1024, ssr, lane);
    float rstd[4];
#pragma unroll
    for (int r = 0; r < 4; ++r) rstd[r] = 1.0f / sqrtf(ssr[r] * (1.0f / 512.0f) + EPS);
    asm volatile("s_waitcnt vmcnt(0)" ::: "memory");
#pragma unroll 1
    for (int h = 0; h < 4; ++h) {
        const f32x4 ga = *(const f32x4*)(out_g + 128 * h + 8 * x), gb = *(const f32x4*)(out_g + 128 * h + 8 * x + 4);
        const float gg[8] = {ga.x, ga.y, ga.z, ga.w, gb.x, gb.y, gb.z, gb.w};
#pragma unroll
        for (int r = 0; r < 4; ++r) {
            const int i = 16 * wave + 4 * g + r;
            bf16* p = ab + (row0 + i) * D + 128 * h + 8 * x;
            float t[8]; unpack8(*(const v4u*)p, t);
#pragma unroll
            for (int nt = 0; nt < 8; ++nt) t[nt] = t[nt] * rstd[r] * gg[nt];
            *(v4u*)p = pack8(t);

        }
    }
    __syncthreads();
}


__device__ __forceinline__ void block_sum16(LAS unsigned char* wscr, LAS float* PW, float (&v)[16], int wave, int lane) {
#pragma unroll
    for (int q = 0; q < 4; ++q) { float t[4] = {v[4 * q], v[4 * q + 1], v[4 * q + 2], v[4 * q + 3]}; wave_sum4_lds(wscr, t, lane); v[4 * q] = t[0]; v[4 * q + 1] = t[1]; v[4 * q + 2] = t[2]; v[4 * q + 3] = t[3]; asm volatile("" ::: "memory"); }
    if (lane == 0) {
#pragma unroll
        for (int i = 0; i < 16; ++i) PW[wave * 16 + i] = v[i]; }
    __syncthreads();
#pragma unroll
    for (int i = 0; i < 16; ++i) v[i] = 0.f;
#pragma unroll
    for (int w2 = 0; w2 < 8; ++w2) {
#pragma unroll
        for (int q = 0; q < 4; ++q) { const f32x4 t = *(const LAS f32x4*)(PW + w2 * 16 + 4 * q); v[4 * q] += t.x; v[4 * q + 1] += t.y; v[4 * q + 2] += t.z; v[4 * q + 3] += t.w; }
        asm volatile("" ::: "memory"); }
    __syncthreads();
}
__device__ __forceinline__ void block_sum4(LAS unsigned char* wscr, LAS float* PW, float (&v)[4], int wave, int lane) {
    wave_sum4_lds(wscr, v, lane);
    if (lane == 0) *(LAS f32x4*)(PW + wave * 4) = (f32x4){v[0], v[1], v[2], v[3]};
    __syncthreads();
    f32x4 s = (f32x4){0.f, 0.f, 0.f, 0.f};
#pragma unroll
    for (int w2 = 0; w2 < 8; ++w2) s += *(const LAS f32x4*)(PW + w2 * 4);
    v[0] = s.x; v[1] = s.y; v[2] = s.z; v[3] = s.w;
    __syncthreads();
}
__device__ __forceinline__ void gmlp_hp1(LAS unsigned char* lds, const float* hsrc, const float* Win32, const float* pre_g, float* part, float* partu, int b, int ks, int rq, int tid_in) {
    int tid = tid_in; asm volatile("" : "+v"(tid));
    const int c = tid;
    const size_t rb = (size_t)b * SEQ + 16 * rq;
    LAS float* Y = (LAS float*)(lds + 1024);
    { const int sj = tid >> 5, skk = (tid & 31) * 2;
      const float* hr = hsrc + (rb + sj) * D + 64 * ks + skk; const float* gr = pre_g + 64 * ks + skk;
      Y[(skk + 0) * 16 + sj] = hr[0] * gr[0]; Y[(skk + 1) * 16 + sj] = hr[1] * gr[1]; }
    __syncthreads();
    const float* wbase = Win32 + (size_t)(64 * ks) * D_IN + c;
    float accv[16], accu[4] = {0.f, 0.f, 0.f, 0.f};
#pragma unroll
    for (int j = 0; j < 16; ++j) accv[j] = 0.f;
#pragma unroll 1
    for (int kb = 0; kb < 64; kb += 8) {
        float wv[8], wu[8];
        const float* wk = wbase + (size_t)kb * D_IN;
#pragma unroll
        for (int e = 0; e < 8; ++e) { wv[e] = wk[(size_t)e * D_IN + ZV]; wu[e] = wk[(size_t)e * D_IN + ZU]; }
#pragma unroll
        for (int e = 0; e < 8; ++e) {
#pragma unroll
            for (int q4 = 0; q4 < 4; ++q4) { const f32x4 y = *(const LAS f32x4*)(Y + (kb + e) * 16 + 4 * q4);
                accv[4 * q4] += y.x * wv[e]; accv[4 * q4 + 1] += y.y * wv[e]; accv[4 * q4 + 2] += y.z * wv[e]; accv[4 * q4 + 3] += y.w * wv[e];
                if (q4 == 0) { accu[0] += y.x * wu[e]; accu[1] += y.y * wu[e]; accu[2] += y.z * wu[e]; accu[3] += y.w * wu[e]; } }
        }
    }
    float* pp = part + ((size_t)(b * 16 + ks) * 64 + 16 * rq) * 512 + c;
#pragma unroll
    for (int j = 0; j < 16; ++j) pp[(size_t)j * 512] = accv[j];
    if (rq == 0) {
#pragma unroll
        for (int i = 0; i < 4; ++i) partu[((size_t)(b * 16 + ks) * 4 + i) * 512 + c] = accu[i]; }
    __syncthreads();
}
__device__ __forceinline__ void gmlp_hp2a(LAS unsigned char* lds, const float* hsrc, const float* ws32, const float* ln_g, const float* ln_b, const float* part, const float* partu, float* mixp, float* zup, int b, int rg, int tid_in) {
    int tid = tid_in; asm volatile("" : "+v"(tid));
    const int lane = tid & 63, wave = __builtin_amdgcn_readfirstlane(tid >> 6), c = tid;
    const size_t rb = (size_t)b * SEQ;
    LAS float* RS = (LAS float*)(lds);
    LAS float* PW = (LAS float*)(lds + 512);
    LAS unsigned char* wscr = lds + 1024 + wave * 1024;
    if (wave < 4) {
        const float* hr = hsrc + (rb + 4 * rg + wave) * D; float s = 0.f;
#pragma unroll
        for (int e = 0; e < 16; ++e) { const float v = hr[lane + 64 * e]; s += v * v; }
        const float tot = wave_sum_lds(wscr, s, lane);
        if (lane == 0) RS[wave] = 1.0f / sqrtf(tot * (1.0f / D) + EPS);
    }
    float s4[4] = {0.f, 0.f, 0.f, 0.f};
    { const float* pb = part + ((size_t)(b * 16) * 64 + 4 * rg) * 512 + c;
#pragma unroll 8
      for (int ks = 0; ks < 16; ++ks) { const float* pk = pb + (size_t)ks * 64 * 512;
#pragma unroll
          for (int i = 0; i < 4; ++i) s4[i] += pk[i * 512]; } }
    __syncthreads();
    const float lg = ln_g[c], lb = ln_b[c];
    const int h = wave >> 1;
    float x4[4], v[4];
#pragma unroll
    for (int i = 0; i < 4; ++i) { x4[i] = pg8::gelu_tanh(s4[i] * RS[i]); v[i] = x4[i]; }
    block_sum4(wscr, PW, v, wave, lane);
#pragma unroll
    for (int i = 0; i < 4; ++i) { x4[i] -= v[i] * (1.0f / 512.0f); v[i] = x4[i] * x4[i]; }
    block_sum4(wscr, PW, v, wave, lane);
#pragma unroll
    for (int i = 0; i < 4; ++i) x4[i] = x4[i] * (1.0f / sqrtf(v[i] * (1.0f / 512.0f) + EPS)) * lg + lb;
#pragma unroll
    for (int i = 0; i < 4; ++i) { const f32x4 w = *(const f32x4*)(ws32 + (size_t)(h * 128 + i) * 128 + 4 * rg);
        mixp[((size_t)(b * 16 + rg) * 4 + i) * 512 + c] = w.x * x4[0] + w.y * x4[1] + w.z * x4[2] + w.w * x4[3]; }
    if (rg == 0) {
        float zu[4] = {0.f, 0.f, 0.f, 0.f};
#pragma unroll 8
        for (int ks = 0; ks < 16; ++ks) { const float* pk = partu + ((size_t)(b * 16 + ks) * 4) * 512 + c;
#pragma unroll
            for (int i = 0; i < 4; ++i) zu[i] += pk[i * 512]; }
#pragma unroll
        for (int i = 0; i < 4; ++i) zup[((size_t)b * 4 + i) * 512 + c] = zu[i] * RS[i];
    }
    __syncthreads();
}
__device__ __forceinline__ void gmlp_hp2b(LAS unsigned char* lds, const float* bs, const float* out_g, const float* mixp, const float* zup, float* ab32, int b, int tid_in) {
    int tid = tid_in; asm volatile("" : "+v"(tid));
    const int lane = tid & 63, wave = __builtin_amdgcn_readfirstlane(tid >> 6), c = tid;
    LAS float* PW = (LAS float*)(lds + 512);
    LAS unsigned char* wscr = lds + 1024 + wave * 1024;
    const int h = wave >> 1;
    __syncthreads();
    float mixed[4] = {0.f, 0.f, 0.f, 0.f};
#pragma unroll 8
    for (int rg = 0; rg < 16; ++rg) { const float* pk = mixp + ((size_t)(b * 16 + rg) * 4) * 512 + c;
#pragma unroll
        for (int i = 0; i < 4; ++i) mixed[i] += pk[i * 512]; }
    float o4[4], sq[4];
#pragma unroll
    for (int i = 0; i < 4; ++i) { o4[i] = pg8::gelu_tanh(zup[((size_t)b * 4 + i) * 512 + c]) * (mixed[i] + bs[h * 128 + i]); sq[i] = o4[i] * o4[i]; }
    block_sum4(wscr, PW, sq, wave, lane);
    const float og = out_g[c];
#pragma unroll
    for (int i = 0; i < 4; ++i) ab32[(size_t)(b * 4 + i) * D + c] = o4[i] * (1.0f / sqrtf(sq[i] * (1.0f / 512.0f) + EPS)) * og;
    __syncthreads();
}

constexpr int G_ROW = 144;
constexpr int G_QE = 0, G_KE = 9216, G_KDT = 18432, G_VT = 27648, G_P = 46080, G_SEG = 55296, G_SC = 57344, G_SCR = 57600, G_HROW = 65536, G_PART = 81920  , G_WSCR = 131072  , G_PSS = 139264;
constexpr int HP_R = 4;
__device__ __forceinline__ float log_sigmoid(float p) { return fminf(p, 0.f) - __logf(1.0f + __expf(-fabsf(p))); }
__device__ __forceinline__ void gla1_unit(LAS unsigned char* lds, const float* hsrc, const float* Win32, const float* pre_g, const float* gla_og, float* ab32, const bf16* z, const float* gate_b, bf16* qe_g, bf16* oi_g, float* upd_g, float* dec_g, int unit, int tid) {
    const int lane = tid & 63, wave = __builtin_amdgcn_readfirstlane(tid >> 6), x = lane & 15, g = lane >> 4;
    const int cidx = unit >> 2, h = unit & 3;
    const size_t rbase = (size_t)cidx * 64;
    const int sidx = ((cidx >> 7) * 4 + h) * 128 + (cidx & 127);
    LAS float* SEG = (LAS float*)(lds + G_SEG);
    float c[8], qv[8], kv[8];
    {
        const float gb = gate_b[h * 64 + lane];
        float run = 0.f;
#pragma unroll
        for (int tt = 0; tt < 8; ++tt) {
            const bf16* zr = z + (rbase + 8 * wave + tt) * NZ;
            const float p = bf1(zr[ZP + h * 64 + lane]) + gb;
            qv[tt] = bf1(zr[ZQ + h * 64 + lane]); kv[tt] = bf1(zr[ZK + h * 64 + lane]);
            run += log_sigmoid(p) * (1.0f / 16.0f); c[tt] = run;
        }
        SEG[wave * 64 + lane] = run;
    }
    {
#pragma unroll
        for (int e = 0; e < 2; ++e) { const int v = lane + 64 * e; float t[8];
#pragma unroll
            for (int tt = 0; tt < 8; ++tt) t[tt] = bf1(z[(rbase + 8 * wave + tt) * NZ + ZVB + h * 128 + v]);
            *(LAS v4u*)(lds + G_VT + ((v & 7) * 16 + (v >> 3)) * G_ROW + 16 * wave) = pack8(t); }
    }
    const bool hp = ((cidx & 127) == 0);
    __syncthreads();
    float vf[HP_R][2] = {{0.f, 0.f}, {0.f, 0.f}, {0.f, 0.f}, {0.f, 0.f}}, gf[HP_R][2] = {{0.f, 0.f}, {0.f, 0.f}, {0.f, 0.f}, {0.f, 0.f}};
    if (hp && wave == 0) {
#pragma unroll
        for (int tt = 0; tt < HP_R; ++tt) { const float* qr = hsrc   + (size_t)((cidx >> 7) * 4 + tt) * 1536;
            qv[tt] = qr[h * 64 + lane] * 0.125f; kv[tt] = qr[256 + h * 64 + lane];
            vf[tt][0] = qr[512 + h * 128 + lane]; vf[tt][1] = qr[512 + h * 128 + lane + 64]; gf[tt][0] = qr[1024 + h * 128 + lane]; gf[tt][1] = qr[1024 + h * 128 + lane + 64]; }
    }
    {
        float off = 0.f, tot = 0.f;
#pragma unroll
        for (int w2 = 0; w2 < 8; ++w2) { const float s = SEG[w2 * 64 + lane]; tot += s; if (w2 < wave) off += s; }
        if (wave == 0) dec_g[(size_t)sidx * 64 + lane] = __expf(tot);
        float kd[8];
#pragma unroll
        for (int tt = 0; tt < 8; ++tt) {
            const float cum = off + c[tt]; const int t = 8 * wave + tt;
            const float qe = qv[tt] * __expf(cum), ke = kv[tt] * __expf(-cum); kd[tt] = kv[tt] * __expf(tot - cum);
            const bf16 qb = (bf16)f2bf(qe);
            *(LAS bf16*)(lds + G_QE + t * G_ROW + 2 * lane) = qb;
            *(LAS bf16*)(lds + G_KE + t * G_ROW + 2 * lane) = (bf16)f2bf(ke);
            qe_g[(rbase + t) * 256 + h * 64 + lane] = qb;
        }
        *(LAS v4u*)(lds + G_KDT + lane * G_ROW + 16 * wave) = pack8(kd);
        if (hp && wave == 0) {
            float qf[HP_R], kf[HP_R];
#pragma unroll
            for (int tt = 0; tt < HP_R; ++tt) { const float cum = off + c[tt]; qf[tt] = qv[tt] * __expf(cum); kf[tt] = kv[tt] * __expf(-cum); }
            float s0[4] = {qf[0] * kf[0], qf[1] * kf[0], qf[1] * kf[1], qf[2] * kf[0]};
            float s1[4] = {qf[2] * kf[1], qf[2] * kf[2], qf[3] * kf[0], qf[3] * kf[1]};
            float s2[4] = {qf[3] * kf[2], qf[3] * kf[3], 0.f, 0.f};
            wave_sum4_lds(lds + G_SCR, s0, lane); wave_sum4_lds(lds + G_SCR, s1, lane); wave_sum4_lds(lds + G_SCR, s2, lane);
            if (lane == 0) { LAS float* SC = (LAS float*)(lds + G_SC);
                SC[0] = s0[0]; SC[1] = 0.f; SC[2] = 0.f; SC[3] = 0.f;
                SC[4] = s0[1]; SC[5] = s0[2]; SC[6] = 0.f; SC[7] = 0.f;
                SC[8] = s0[3]; SC[9] = s1[0]; SC[10] = s1[1]; SC[11] = 0.f;
                SC[12] = s1[2]; SC[13] = s1[3]; SC[14] = s2[0]; SC[15] = s2[1]; }
            float o[HP_R][2];
#pragma unroll
            for (int e = 0; e < 2; ++e) {
                o[0][e] = s0[0] * vf[0][e];
                o[1][e] = s0[1] * vf[0][e] + s0[2] * vf[1][e];
                o[2][e] = s0[3] * vf[0][e] + s1[0] * vf[1][e] + s1[1] * vf[2][e];
                o[3][e] = s1[2] * vf[0][e] + s1[3] * vf[1][e] + s2[0] * vf[2][e] + s2[1] * vf[3][e]; }
            float so[4];
#pragma unroll
            for (int i = 0; i < HP_R; ++i) so[i] = o[i][0] * o[i][0] + o[i][1] * o[i][1];
            wave_sum4_lds(lds + G_SCR, so, lane);
#pragma unroll
            for (int i = 0; i < HP_R; ++i) { const float rs = 1.0f / sqrtf(so[i] * (1.0f / 128.0f) + EPS);
#pragma unroll
                for (int e = 0; e < 2; ++e) { const float zg = gf[i][e]; const float sg = zg / (1.0f + __expf(-zg));
                    ab32[(size_t)((cidx >> 7) * 4 + i) * D + 512 + h * 128 + lane + 64 * e] = o[i][e] * rs * gla_og[h * 128 + lane + 64 * e] * sg; } }
        }
    }
    __syncthreads();
    {
        const int it = wave >> 1;
#pragma unroll
        for (int jj = 0; jj < 2; ++jj) {
            const int jt = 2 * (wave & 1) + jj;
            f32x4 s = (f32x4){0.f, 0.f, 0.f, 0.f};
            if (jt <= it) {
                bf16x8 a[2], b[2];
#pragma unroll
                for (int ks = 0; ks < 2; ++ks) {
                    a[ks] = *(const LAS bf16x8*)(lds + G_QE + (16 * it + x) * G_ROW + (ks * 32 + 8 * g) * 2);
                    b[ks] = *(const LAS bf16x8*)(lds + G_KE + (16 * jt + x) * G_ROW + (ks * 32 + 8 * g) * 2); }
                FRAG_WAIT();
                s = MFMA16(a[0], b[0], s); s = MFMA16(a[1], b[1], s);
            }
#pragma unroll
            for (int r = 0; r < 4; ++r) { const int i = 16 * it + 4 * g + r, j = 16 * jt + x;
                float sv = (j <= i) ? s[r] : 0.f;
                if (hp && i < HP_R && j < HP_R) sv = ((const LAS float*)(lds + G_SC))[i * 4 + j];
                *(LAS bf16*)(lds + G_P + i * G_ROW + 2 * j) = (bf16)f2bf(sv); }
        }
    }
    __syncthreads();
    if (wave < 4) {
        f32x4 acc[8];
#pragma unroll
        for (int vt = 0; vt < 8; ++vt) acc[vt] = (f32x4){0.f, 0.f, 0.f, 0.f};
        {
            bf16x8 a[2], b[2][8];
#pragma unroll
            for (int ks = 0; ks < 2; ++ks) {
                a[ks] = *(const LAS bf16x8*)(lds + G_P + (16 * wave + x) * G_ROW + (ks * 32 + 8 * g) * 2);
#pragma unroll
                for (int vt = 0; vt < 8; ++vt) b[ks][vt] = *(const LAS bf16x8*)(lds + G_VT + (vt * 16 + x) * G_ROW + (ks * 32 + 8 * g) * 2); }
            FRAG_WAIT();
#pragma unroll
            for (int ks = 0; ks < 2; ++ks)
#pragma unroll
                for (int vt = 0; vt < 8; ++vt) acc[vt] = MFMA16(a[ks], b[ks][vt], acc[vt]);
        }
#pragma unroll
        for (int r = 0; r < 4; ++r) { float t[8];
#pragma unroll
            for (int vt = 0; vt < 8; ++vt) t[vt] = acc[vt][r];
            *(v4u*)(oi_g + (rbase + 16 * wave + 4 * g + r) * 512 + h * 128 + 8 * x) = pack8(t); }
    } else {
        const int w2 = wave - 4;
        f32x4 acc[2][4];
#pragma unroll
        for (int a = 0; a < 2; ++a)
#pragma unroll
            for (int dt = 0; dt < 4; ++dt) acc[a][dt] = (f32x4){0.f, 0.f, 0.f, 0.f};
        {
            bf16x8 b[2][4], av[2][2];
#pragma unroll
            for (int ks = 0; ks < 2; ++ks) {
#pragma unroll
                for (int dt = 0; dt < 4; ++dt) b[ks][dt] = *(const LAS bf16x8*)(lds + G_KDT + (16 * dt + x) * G_ROW + (ks * 32 + 8 * g) * 2);
#pragma unroll
                for (int a = 0; a < 2; ++a) av[ks][a] = *(const LAS bf16x8*)(lds + G_VT + (16 * (2 * w2 + a) + x) * G_ROW + (ks * 32 + 8 * g) * 2); }
            FRAG_WAIT();
#pragma unroll
            for (int ks = 0; ks < 2; ++ks)
#pragma unroll
                for (int a = 0; a < 2; ++a)
#pragma unroll
                    for (int dt = 0; dt < 4; ++dt) acc[a][dt] = MFMA16(av[ks][a], b[ks][dt], acc[a][dt]);
        }
#pragma unroll
        for (int a = 0; a < 2; ++a)
#pragma unroll
            for (int dt = 0; dt < 4; ++dt)
#pragma unroll
                for (int r = 0; r < 4; ++r) { const int v = 8 * (4 * g + r) + (2 * w2 + a); upd_g[(size_t)sidx * 8192 + v * 64 + 16 * dt + x] = acc[a][dt][r]; }
    }
    __syncthreads();
}

__device__ __forceinline__ void gla_scan(const float* __restrict__ upd_g, const float* __restrict__ dec_g, bf16* __restrict__ sp_g, int gtid, int ngt) {
    for (int e = gtid; e < 16 * 8192; e += ngt) {
        const int bh = e >> 13, off = e & 8191, d = off & 63;
        float S = 0.f;
#pragma unroll 16
        for (int n = 0; n < 128; ++n) {
            const size_t s = (size_t)bh * 128 + n;
            const float u = upd_g[s * 8192 + off], dc = dec_g[s * 64 + d];
            sp_g[s * 8192 + off] = (bf16)f2bf(S);
            S = dc * S + u;
        }
    }
}

__device__ __forceinline__ void gla3_unit(LAS unsigned char* scr, const bf16* z, const bf16* qe_g, const bf16* oi_g, const bf16* sp_g, const float* out_g, bf16* ab, int unit, int it, int lane) {
    const int x = lane & 15, g = lane >> 4;
    const int cidx = unit >> 2, h = unit & 3;
    const size_t rbase = (size_t)cidx * 64;
    const int sidx = ((cidx >> 7) * 4 + h) * 128 + (cidx & 127);
    f32x4 acc[8];
#pragma unroll
    for (int vt = 0; vt < 8; ++vt) acc[vt] = (f32x4){0.f, 0.f, 0.f, 0.f};
    {
        bf16x8 a[2], b[2][8];
#pragma unroll
        for (int ks = 0; ks < 2; ++ks) {
            a[ks] = *(const bf16x8*)(qe_g + (rbase + 16 * it + x) * 256 + h * 64 + ks * 32 + 8 * g);
#pragma unroll
            for (int vt = 0; vt < 8; ++vt) b[ks][vt] = *(const bf16x8*)(sp_g + (size_t)sidx * 8192 + (8 * x + vt) * 64 + ks * 32 + 8 * g); }
        FRAG_WAIT();
#pragma unroll
        for (int ks = 0; ks < 2; ++ks)
#pragma unroll
            for (int vt = 0; vt < 8; ++vt) acc[vt] = MFMA16(a[ks], b[ks][vt], acc[vt]);
    }
    const f32x4 ga = *(const f32x4*)(out_g + h * 128 + 8 * x), gb = *(const f32x4*)(out_g + h * 128 + 8 * x + 4);
    const float gg[8] = {ga.x, ga.y, ga.z, ga.w, gb.x, gb.y, gb.z, gb.w};
    float ss[4];
#pragma unroll
    for (int r = 0; r < 4; ++r) {
        const size_t row = rbase + 16 * it + 4 * g + r;
        float oi[8]; unpack8(*(const v4u*)(oi_g + row * 512 + h * 128 + 8 * x), oi);
        float s = 0.f;
#pragma unroll
        for (int vt = 0; vt < 8; ++vt) { const float o = acc[vt][r] + oi[vt]; acc[vt][r] = o; s += o * o; }
        ss[r] = s;
    }
    row16_sum4_lds(scr, ss, lane);
#pragma unroll
    for (int r = 0; r < 4; ++r) {
        const size_t row = rbase + 16 * it + 4 * g + r;
        float zg[8]; unpack8(*(const v4u*)(z + row * NZ + ZG + h * 128 + 8 * x), zg);
        const float rstd = 1.0f / sqrtf(ss[r] * (1.0f / 128.0f) + EPS);
        float t[8];
#pragma unroll
        for (int vt = 0; vt < 8; ++vt) { const float sg = zg[vt] / (1.0f + __expf(-zg[vt])); t[vt] = acc[vt][r] * rstd * gg[vt] * sg; }
        *(v4u*)(ab + row * D + 512 + h * 128 + 8 * x) = pack8(t);
    }
}


#define RLX_AGENT __ATOMIC_RELAXED, __HIP_MEMORY_SCOPE_AGENT
constexpr int CW_BAR = 4096;
constexpr size_t CTL_ZERO_BYTES = 65536;
constexpr int LDS_MISC_OFF = LDS_BYTES - 64;
#define XB_TMO      128
#define XB_XCNT(j)  (256  + 64 * (j))
#define XB_XSUB(j)  (1280 + 64 * (j))
#define XB_XGEN(j)  (2304 + 64 * (j))
#define XB_TOP      3328
#define XB_TOPGEN   3392
#define XCD_BAR_WORDS 3456
#define XB_SPIN_CAP (1u << 18)

__device__ __forceinline__ unsigned xb_ld(unsigned* p)              { return __hip_atomic_load(p, __ATOMIC_RELAXED, __HIP_MEMORY_SCOPE_AGENT); }
__device__ __forceinline__ unsigned xb_add(unsigned* p, unsigned v) { return __hip_atomic_fetch_add(p, v, __ATOMIC_RELAXED, __HIP_MEMORY_SCOPE_AGENT); }
__device__ __forceinline__ unsigned xb_xcc_id() { return (unsigned)__builtin_amdgcn_s_getreg((3 << 11) | 20) & 0xFu; }
#define XB_SPIN(cond, bar) do { unsigned _sp = 0; while (cond) { __builtin_amdgcn_s_sleep(1); \
    if ((++_sp & 255u) == 0u) { if (xb_ld(&(bar)[XB_TMO])) break; if (_sp > XB_SPIN_CAP) { atomicAdd(&(bar)[XB_TMO], 1u); break; } } } } while (0)

struct XcdBarrier {
    unsigned* bar; unsigned x;
    volatile LAS unsigned* st;
};

__device__ __forceinline__ XcdBarrier xcd_barrier_post(unsigned* bar, volatile LAS unsigned* st) {
    XcdBarrier b; b.bar = bar; b.x = xb_xcc_id(); b.st = st;
    if (threadIdx.x == 0) (void)xb_add(&bar[XB_XCNT(b.x)], 1u);
    return b;
}
__device__ __forceinline__ void xcd_barrier_complete(unsigned* bar, unsigned x, unsigned& nloc, unsigned& nx) {
    const unsigned G = gridDim.x * gridDim.y * gridDim.z;
    unsigned sum, cnt, mine, sp = 0u;
    for (;;) {
        sum = 0u; cnt = 0u; mine = 0u;
#pragma unroll
        for (unsigned j = 0; j < 16; ++j) { const unsigned c = xb_ld(&bar[XB_XCNT(j)]); sum += c; cnt += (c > 0u) ? 1u : 0u; mine = (j == x) ? c : mine; }
        if (sum == G) break;
        __builtin_amdgcn_s_sleep(1);
        if ((++sp & 255u) == 0u) { if (xb_ld(&bar[XB_TMO])) break; if (sp > XB_SPIN_CAP) { atomicAdd(&bar[XB_TMO], 1u); break; } }
    }
    nloc = mine > 0u ? mine : 1u; nx = cnt > 0u ? cnt : 1u;
}

__device__ __forceinline__ void xcd_barrier(const XcdBarrier& b) {
    asm volatile("s_waitcnt vmcnt(0)" ::: "memory");
    __syncthreads();
    if (threadIdx.x == 0) {
        unsigned* bar = b.bar;
        __builtin_amdgcn_s_waitcnt(0);
        unsigned nloc = b.st[0], nx = b.st[1];
        if (nloc == 0u) { xcd_barrier_complete(bar, b.x, nloc, nx); b.st[0] = nloc; b.st[1] = nx; }
        const unsigned old = xb_add(&bar[XB_XSUB(b.x)], 1u);
        const unsigned gen = old / nloc;
        if (old + 1u == (gen + 1u) * nloc) {
            __builtin_amdgcn_fence(__ATOMIC_RELEASE, "agent");
            asm volatile("s_waitcnt vmcnt(0)" ::: "memory");
            const unsigned og = xb_add(&bar[XB_TOP], 1u);
            const unsigned tg = og / nx;
            if (og + 1u == (tg + 1u) * nx) xb_add(&bar[XB_TOPGEN], 1u);
            else XB_SPIN(xb_ld(&bar[XB_TOPGEN]) == tg, bar);
            __builtin_amdgcn_fence(__ATOMIC_ACQUIRE, "agent");
            xb_add(&bar[XB_XGEN(b.x)], 1u);
            asm volatile("s_waitcnt vmcnt(0)" ::: "memory");
        } else {
            XB_SPIN(xb_ld(&bar[XB_XGEN(b.x)]) == gen, bar);
            __builtin_amdgcn_fence(__ATOMIC_ACQUIRE, "agent");
            asm volatile("s_waitcnt vmcnt(0)" ::: "memory");
        }
    }
    __syncthreads();
}

#ifndef STOP_AT
#define STOP_AT 0
#endif
#define DUMP_BF16(src, ncol_src, coff) do { xcd_barrier(bar); for (size_t i_ = (size_t)bid * NTHR + threadIdx.x; i_ < (size_t)M * D; i_ += (size_t)G * NTHR) { const size_t r_ = i_ >> 10, c_ = i_ & 1023; out[i_] = bf1((src)[r_ * (ncol_src) + (coff) + c_]); } return; } while (0)
#ifndef GMLP_DBG
#define GMLP_DBG 0
#endif
#ifndef DUP_GEMM
#define DUP_GEMM 0
#endif
#ifndef DUP_MASK
#define DUP_MASK 0
#endif
#ifndef SEAM_REPEAT
#define SEAM_REPEAT 1
#endif
#define SEAM() xcd_barrier(bar)
struct Args { const float* in[17]; float* out; unsigned char* ws; int ph_lo, ph_hi; };
__global__ void __launch_bounds__(NTHR, 2) fwd_megakernel(Args args) {
    extern __shared__ __attribute__((aligned(16))) unsigned char lds_raw[];
    cg::grid_group grid = cg::this_grid();
    LAS unsigned char* lds = (LAS unsigned char*)lds_raw;
    const int G = gridDim.x, bid = blockIdx.x, ngw = G * NWAVES;
    volatile LAS unsigned* MISC = (volatile LAS unsigned*)(lds + LDS_MISC_OFF);
    if (threadIdx.x < 16) MISC[threadIdx.x] = 0u;
    __syncthreads();
    XcdBarrier bar = xcd_barrier_post((unsigned*)(args.ws) + CW_BAR, MISC);
    grid.sync();
#define PHASE_IDS() int tid = threadIdx.x; asm volatile("" : "+v"(tid)); const int lane = tid & 63, wave = __builtin_amdgcn_readfirstlane(tid >> 6), gw = bid * NWAVES + wave; (void)lane; (void)gw
    unsigned char* ws = args.ws;
    const float* x = args.in[0];
    float* out = args.out;
    bf16* Wm = (bf16*)(ws + WS_WM);
    float* dec_g = (float*)(ws + WS_DEC);
    bf16* zb = (bf16*)(ws + WS_Z); bf16* f1 = (bf16*)(ws + WS_F1); bf16* ab = (bf16*)(ws + WS_AB); bf16* qe_g = (bf16*)(ws + WS_QE);
    bf16* yb = (bf16*)(ws + WS_Y); bf16* sp_g = (bf16*)(ws + WS_SP); bf16* oi_g = (bf16*)(ws + WS_OI); bf16* mmb = (bf16*)(ws + WS_MM); float* upd_g = (float*)(ws + WS_UPD);

    float* M32 = (float*)(ws + WS_HP); float* Y32 = M32 + 16 * 1024; float* F1_32 = Y32 + 16 * 1024; float* F32o = F1_32 + 16 * 4096; float* AB32 = F32o + 16 * 1024; float* HPP = (float*)(ws + WS_HP + 2 * MiB); float* HPU = (float*)(ws + WS_HP + 11 * MiB); float* YH32 = (float*)(ws + WS_HP + 1 * MiB); float* QKVG32 = YH32 + 16 * 1024; float* MIXP = (float*)(ws + WS_HP + 12 * MiB); float* ZUP = (float*)(ws + WS_HP + 13 * MiB);
    {
        PHASE_IDS();
        LAS float* scr = (LAS float*)(lds + wave * 16384);
        constexpr int I_IN = 16 * 80, I_OUT = 16 * 32, I_1 = 16 * 128, I_2 = 64 * 32, I_G = 512, I_L = I_IN + I_OUT + I_1 + I_2 + I_G;
        for (int it = gw; it < DEPTH * I_L; it += ngw) {
            const int l = it / I_L; int r = it % I_L;
            bf16* WinT = (bf16*)(ws + WS_W + l * W_LAYER_B); bf16* WoutT = (bf16*)(ws + WS_W + l * W_LAYER_B + W_IN_B); bf16* W1T = (bf16*)(ws + WS_W + l * W_LAYER_B + W_IN_B + W_OUT_B); bf16* W2T = (bf16*)(ws + WS_W + l * W_LAYER_B + W_IN_B + W_OUT_B + W_1_B);
            const float* w_in = args.in[2] + (size_t)l * D * D_IN; const float* pre_g = args.in[1] + l * D;
            if (r < I_IN) { p0_transpose_item(w_in, D_IN, 2560, D, WinT, pre_g, ZQ, ZK, scr, r, lane); continue; } r -= I_IN;
            if (r < I_OUT) { p0_transpose_item(args.in[11] + (size_t)l * D * D, D, D, D, WoutT, nullptr, 0, 0, scr, r, lane); continue; } r -= I_OUT;
            if (r < I_1) { p0_transpose_item(args.in[14] + (size_t)l * D * FF, FF, FF, D, W1T, args.in[13] + l * D, 0, 0, scr, r, lane); continue; } r -= I_1;
            if (r < I_2) { p0_transpose_item(args.in[15] + (size_t)l * FF * D, D, D, FF, W2T, nullptr, 0, 0, scr, r, lane); continue; } r -= I_2;
            p0_gate_item(w_in, args.in[8] + (size_t)l * 16 * 256, pre_g, WinT, r, lane);
        }
        const float* wsrc = args.in[5];
        for (int i = bid * NTHR + tid; i < DEPTH * 4 * 128 * 128; i += G * NTHR) { const int ii = (i >> 7) & 127, jj = i & 127; Wm[i] = ((ii >> 6) >= (jj >> 6)) ? (bf16)f2bf(wsrc[i]) : (bf16)0; }
        rows_phase(lds + wave * 16384, x, nullptr, nullptr, nullptr, yb, gw, ngw, lane, nullptr, YH32, args.in[1]);
    }
    SEAM();

#pragma unroll 1
    for (int l = 0; l < DEPTH; ++l) {
        const bf16* WinT = (const bf16*)(ws + WS_W + l * W_LAYER_B); const bf16* WoutT = (const bf16*)(ws + WS_W + l * W_LAYER_B + W_IN_B);
        const bf16* W1T = (const bf16*)(ws + WS_W + l * W_LAYER_B + W_IN_B + W_OUT_B); const bf16* W2T = (const bf16*)(ws + WS_W + l * W_LAYER_B + W_IN_B + W_OUT_B + W_1_B);
        { PHASE_IDS(); pg8::Gemm gm{yb, WinT, M, NZ, D}; pg8::StaticOrder S; S.init(M, NZ, G, bid); pg8::EpiAct<1> E{zb, NZ, 4};
          pg8::gemm_phase<pg8::EpiAct<1>, pg8::StaticOrder, true, true>(lds, gm, S, E, tid);
          hp_gemv_phase<0>(lds, YH32, D, args.in[2] + (size_t)l * D * D_IN + ZQ, D_IN, 1536, QKVG32, G, (G == 256) ? ((bid + 128) & 255) : bid, wave, lane, tid); }
        SEAM();
        if (STOP_AT == 1) DUMP_BF16(zb, NZ, 0);
        if (STOP_AT == 2) DUMP_BF16(zb, NZ, 1792);
        if (STOP_AT == 30) {
            const int lane_ = threadIdx.x & 63, wave_ = threadIdx.x >> 6;
            for (int u = bid; u < M / 128; u += G)
                for (int t_ = 0; t_ < 16; ++t_) { const size_t row_ = (size_t)u * 128 + 16 * wave_ + t_;
                    *(v4u*)(ab + row_ * D + 8 * lane_) = *(const v4u*)(zb + row_ * NZ + ZV + 8 * lane_); }
            xcd_barrier(bar); for (size_t i_ = (size_t)bid * NTHR + threadIdx.x; i_ < (size_t)M * D; i_ += (size_t)G * NTHR) { const size_t r_ = i_ >> 10, c_ = i_ & 511; out[i_] = bf1(ab[r_ * D + c_]); } return; }
        { PHASE_IDS();
        for (int u = bid; u < M / 128; u += G)
            gmlp_unit(lds, AB32, zb, ab, Wm + (size_t)l * 4 * 16384, args.in[3] + l * 512, args.in[4] + l * 512, args.in[6] + l * 512, args.in[7] + l * 512, u, tid);
        if (STOP_AT == 14) { xcd_barrier(bar); for (size_t i_ = (size_t)bid * NTHR + threadIdx.x; i_ < (size_t)M * D; i_ += (size_t)G * NTHR) { out[i_] = bf1(Wm[i_ & 262143]); } return; }
        if (STOP_AT >= 20 && STOP_AT < 24) { xcd_barrier(bar); for (size_t i_ = (size_t)bid * NTHR + threadIdx.x; i_ < (size_t)M * D; i_ += (size_t)G * NTHR) { const size_t r_ = i_ >> 10, c_ = i_ & 127; out[i_] = bf1(ab[r_ * D + (STOP_AT - 20) * 128 + c_]); } return; }
        if (STOP_AT == 13) { xcd_barrier(bar); for (size_t i_ = (size_t)bid * NTHR + threadIdx.x; i_ < (size_t)M * D; i_ += (size_t)G * NTHR) { const size_t r_ = i_ >> 10, c_ = i_ & 511; out[i_] = bf1(ab[r_ * D + c_]); } return; }
        }
        { PHASE_IDS();
        for (int t = bid; t < 256; t += G) gmlp_hp1(lds, l == 0 ? x : out, args.in[2] + (size_t)l * D * D_IN, args.in[1] + l * D, HPP, HPU, t >> 6, (t >> 2) & 15, t & 3, tid);
        }
        { PHASE_IDS();
        for (int ui = 0; ui * G < NCHUNK * 4; ++ui) { const int u = (G == 256) ? (256 * ui + ((bid + 4 * ui) & 255)) : (ui * G + bid); if (u >= NCHUNK * 4) break;
            gla1_unit(lds, QKVG32, args.in[2] + (size_t)l * D * D_IN, args.in[1] + l * D, args.in[10] + l * 512, AB32, zb, args.in[9] + l * 256, qe_g, oi_g, upd_g, dec_g, u, tid); } }
        SEAM();
        { PHASE_IDS(); gla_scan(upd_g, dec_g, sp_g, bid * NTHR + tid, G * NTHR); }
        { PHASE_IDS();
          for (int t = bid; t < 64; t += G) gmlp_hp2a(lds, l == 0 ? x : out, args.in[5] + (size_t)l * 4 * 16384, args.in[3] + l * 512, args.in[4] + l * 512, HPP, HPU, MIXP, ZUP, t >> 4, t & 15, tid); }
        SEAM();
        { PHASE_IDS();
        for (int pu = bid; pu < NCHUNK * 2; pu += G)
            gla3_unit(lds + wave * 1024, zb, qe_g, oi_g, sp_g, args.in[10] + l * 512, ab, 2 * pu + (wave >> 2), wave & 3, lane); }
        { PHASE_IDS();
          for (int b4 = bid; b4 < BATCH; b4 += G) gmlp_hp2b(lds, args.in[6] + l * 512, args.in[7] + l * 512, MIXP, ZUP, AB32, b4, tid); }
        SEAM();
        if (STOP_AT == 3) DUMP_BF16(ab, D, 0);
        if (STOP_AT == 8) { xcd_barrier(bar); for (size_t i_ = (size_t)bid * NTHR + threadIdx.x; i_ < (size_t)M * D; i_ += (size_t)G * NTHR) { const size_t r_ = i_ >> 10, c_ = i_ & 511; out[i_] = bf1(ab[r_ * D + c_]); } return; }
        if (STOP_AT == 9) { xcd_barrier(bar); for (size_t i_ = (size_t)bid * NTHR + threadIdx.x; i_ < (size_t)M * D; i_ += (size_t)G * NTHR) { const size_t r_ = i_ >> 10, c_ = i_ & 511; out[i_] = bf1(ab[r_ * D + 512 + c_]); } return; }
        if (STOP_AT == 10) { xcd_barrier(bar); for (size_t i_ = (size_t)bid * NTHR + threadIdx.x; i_ < (size_t)M * D; i_ += (size_t)G * NTHR) { const size_t r_ = i_ >> 10, c_ = i_ & 511; out[i_] = bf1(oi_g[r_ * 512 + c_]); } return; }
        if (STOP_AT == 11) { xcd_barrier(bar); for (size_t i_ = (size_t)bid * NTHR + threadIdx.x; i_ < (size_t)M * D; i_ += (size_t)G * NTHR) { out[i_] = bf1(sp_g[i_ & (size_t)(2048 * 8192 - 1)]); } return; }
        if (STOP_AT == 12) { xcd_barrier(bar); for (size_t i_ = (size_t)bid * NTHR + threadIdx.x; i_ < (size_t)M * D; i_ += (size_t)G * NTHR) { out[i_] = upd_g[i_ & (size_t)(2048 * 8192 - 1)]; } return; }
        { PHASE_IDS(); pg8::Gemm gm{ab, WoutT, M, D, D}; pg8::StaticOrder S; S.init(M, D, G, bid); pg8::EpiAct<0> E{mmb, D, 0};
          pg8::gemm_phase<pg8::EpiAct<0>, pg8::StaticOrder, true, true>(lds, gm, S, E, tid);
          hp_gemv_phase<0>(lds, AB32, D, args.in[11] + (size_t)l * D * D, D, D, M32, G, bid, wave, lane, tid); }
        SEAM();
        if (STOP_AT == 4) DUMP_BF16(mmb, D, 0);
        { PHASE_IDS(); rows_phase(lds + wave * 1024, l == 0 ? x : out, mmb, args.in[12] + l * D, nullptr, yb, gw, ngw, lane, M32, Y32, args.in[13] + l * D); }
        SEAM();
        if (STOP_AT == 5) DUMP_BF16(yb, D, 0);
        { PHASE_IDS(); pg8::Gemm gm{yb, W1T, M, FF, D}; pg8::StaticOrder S; S.init(M, FF, G, bid); pg8::EpiAct<2> E{f1, FF, 0};
          pg8::gemm_phase<pg8::EpiAct<2>, pg8::StaticOrder, true, true>(lds, gm, S, E, tid);
          hp_gemv_phase<2>(lds, Y32, D, args.in[14] + (size_t)l * D * FF, FF, FF, F1_32, G, bid, wave, lane, tid); }
        SEAM();
        { PHASE_IDS(); pg8::Gemm gm{f1, W2T, M, D, FF}; pg8::StaticOrder S; S.init(M, D, G, bid); pg8::EpiAct<0> E{yb, D, 0};
          pg8::gemm_phase<pg8::EpiAct<0>, pg8::StaticOrder, true, true>(lds, gm, S, E, tid);
          hp_gemv_phase<0>(lds, F1_32, FF, args.in[15] + (size_t)l * FF * D, D, D, F32o, G, bid, wave, lane, tid); }
        SEAM();
        if (STOP_AT == 6) DUMP_BF16(mmb, D, 0);
        if (STOP_AT == 7) DUMP_BF16(f1, FF, 0);
        { PHASE_IDS(); rows_phase(lds + wave * 1024, l == 0 ? x : out, mmb, args.in[12] + l * D, out, (l + 1 < DEPTH) ? yb : nullptr, gw, ngw, lane, M32, YH32, args.in[1] + (l + 1 < DEPTH ? l + 1 : l) * D, yb, args.in[16] + l * D, F32o); }
        if (l + 1 < DEPTH) SEAM();
    }
}

extern "C" void kernel_launch(void* const* d_in, const int* in_sizes, int n_in, void* d_out, int out_size, void* d_ws, size_t ws_size, hipStream_t stream) {
    static int grid = 0;
    if (grid == 0) {
        if (n_in != 17 || out_size != M * D || ws_size < WS_END) { fprintf(stderr, "kernel_launch: unexpected problem (n_in %d, out %d, ws %zu)\n", n_in, out_size, ws_size); grid = -1; return; }
        int dev = 0, cus = 0, per_cu = 0;
        hipGetDevice(&dev); hipDeviceGetAttribute(&cus, hipDeviceAttributeMultiprocessorCount, dev);
        hipFuncSetAttribute((const void*)fwd_megakernel, hipFuncAttributeMaxDynamicSharedMemorySize, LDS_BYTES);
        if (hipOccupancyMaxActiveBlocksPerMultiprocessor(&per_cu, (const void*)fwd_megakernel, NTHR, LDS_BYTES) != hipSuccess || per_cu < 1) per_cu = 1;
        (void)hipGetLastError();
        grid = cus * per_cu;
    }
    if (grid < 0) return;
    if (hipMemsetAsync(d_ws, 0, CTL_ZERO_BYTES, stream) != hipSuccess) { fprintf(stderr, "kernel_launch: memset failed\n"); return; }
    Args a{};
    for (int i = 0; i < 17; ++i) a.in[i] = (const float*)d_in[i];
    a.out = (float*)d_out; a.ws = (unsigned char*)d_ws; a.ph_lo = 0; a.ph_hi = 0;
    void* kargs[] = {&a};
    hipError_t e = hipLaunchCooperativeKernel((const void*)fwd_megakernel, dim3(grid), dim3(NTHR), kargs, LDS_BYTES, stream);
    if (e != hipSuccess) fprintf(stderr, "cooperative launch failed: %s (grid %d)\n", hipGetErrorString(e), grid);
}
```

```cpp
#include <hip/hip_runtime.h>
#include <hip/hip_cooperative_groups.h>
#include <cstdio>
#include <cstdint>
namespace cg = cooperative_groups;
namespace pg8 {
#define PG8_LAS __attribute__((address_space(3)))
typedef unsigned short bf16_t;
typedef short bf16x8 __attribute__((ext_vector_type(8)));
typedef float f32x4 __attribute__((ext_vector_type(4)));
typedef unsigned u32x4 __attribute__((ext_vector_type(4)));
constexpr int BM = 256, BK = 64, HALF = 128, HTB = HALF * BK * 2  , STAGE_BYTES = 8 * HTB, NXCD = 8, WGM = 8;

__host__ __device__ __forceinline__ int lds_byte(int r, int c) { const int st = (r >> 4) * 2 + (c >> 5), rr = r & 15, cc = c & 31, ob = rr * 64 + cc * 2; return st * 1024 + (ob ^ (((ob >> 9) & 1) << 5)); }
__host__ __device__ __forceinline__ void stage_rc(int b, int& R, int& C) { const int st = b / 1024, sb = b % 1024, swz = sb ^ (((sb >> 9) & 1) << 5); R = (st >> 1) * 16 + swz / 64; C = (st & 1) * 32 + (swz % 64) / 2; }
__host__ __device__ __forceinline__ int perm32(int rho) { const int n = rho >> 4, i = rho & 15; return 8 * (i >> 2) + 4 * n + (i & 3); }

struct Unit { int pm, pn; };
struct Gemm { const bf16_t* A; const bf16_t* Bt; int M, N, K; };

struct StaticOrder {
    int nM, nN, nwg, G, c;
    __host__ __device__ void init(int M, int N, int G_, int c_) { nM = M / BM; nN = N / BM; nwg = nM * nN; G = G_; c = c_; }
    __host__ __device__ bool next(int i, Unit& u) const {
        const long L = (long)i * G + c; if (L >= nwg) return false;
        int wgid = (int)L; { const int q = nwg / NXCD, r = nwg % NXCD, xcd = wgid % NXCD, off = wgid / NXCD; wgid = (xcd < r ? xcd * (q + 1) : r * (q + 1) + (xcd - r) * q) + off; }
        const int nig = WGM * nN, gid = wgid / nig, fm = gid * WGM, gsz = (nM - fm) < WGM ? (nM - fm) : WGM;
        u.pm = fm + ((wgid % nig) % gsz); u.pn = (wgid % nig) / gsz; return true;
    }
    __device__ __forceinline__ void a_ready(const Unit&) const {}
    __device__ __forceinline__ void done(const Unit&) const {}
};

typedef __bf16 hwbf2e __attribute__((ext_vector_type(2)));
typedef float hwf2e __attribute__((ext_vector_type(2)));
__device__ __forceinline__ unsigned cvt_pk_bf16(float lo, float hi) { const hwf2e v = {lo, hi}; return __builtin_bit_cast(unsigned, __builtin_convertvector(v, hwbf2e)); }
__device__ __forceinline__ float gelu_tanh(float x) {
    const float u = x * (0.7978845608028654f + 0.035677408136300125f * x * x);
    const float e = __builtin_amdgcn_exp2f(u * -2.885390081777927f);
    return x * __builtin_amdgcn_rcpf(1.0f + e);
}
template <int ACT> struct EpiAct {
    static constexpr bool PERM = true, AFTER_DRAIN = false;
    bf16_t* O; int ldc; int act_tiles;
    __device__ __forceinline__ void operator()(const f32x4 (&acc)[2][2][4][2], const Unit& u, int wr, int wc, int fr, int fq) const {
        const int row0 = u.pm * BM + wr * 64 + fr; const int col0 = u.pn * BM + wc * 32 + 8 * fq;
        const bool act = (ACT == 1) ? (u.pn < act_tiles) : true;
#pragma unroll
        for (int ai = 0; ai < 2; ++ai)
#pragma unroll
            for (int m = 0; m < 4; ++m) { bf16_t* rowp = O + (size_t)(row0 + ai * HALF + m * 16) * ldc + col0;
#pragma unroll
                for (int bj = 0; bj < 2; ++bj) { f32x4 v0 = acc[ai][bj][m][0], v1 = acc[ai][bj][m][1];
                    if (ACT == 1) { if (act) {
#pragma unroll
                        for (int e = 0; e < 4; ++e) { v0[e] = gelu_tanh(v0[e]); v1[e] = gelu_tanh(v1[e]); } } }
                    if (ACT == 2) {
#pragma unroll
                        for (int e = 0; e < 4; ++e) { const float a = fmaxf(v0[e], 0.f), b = fmaxf(v1[e], 0.f); v0[e] = a * a; v1[e] = b * b; } }
                    u32x4 w; w.x = cvt_pk_bf16(v0[0], v0[1]); w.y = cvt_pk_bf16(v0[2], v0[3]); w.z = cvt_pk_bf16(v1[0], v1[1]); w.w = cvt_pk_bf16(v1[2], v1[3]);
                    *(u32x4*)(rowp + bj * HALF) = w; } }
    }
};

template <class Epi, class Sched, bool ALIGN_EPI = false, bool SP2 = false>
__device__ __forceinline__ void gemm_phase(PG8_LAS unsigned char* lds, const Gemm g, const Sched& S, const Epi& E, const int tid) {
    const int wid = __builtin_amdgcn_readfirstlane(tid >> 6), lane = tid & 63, wr = wid >> 2, wc = wid & 3, fr = lane & 15, fq = lane >> 4;
    const int K = g.K, nt = K / BK;
    unsigned voffA[2], voffB[2];
#pragma unroll
    for (int i = 0; i < 2; ++i) { int R, C; stage_rc(tid * 16 + i * 8192, R, C); const int Rb = Epi::PERM ? ((R & ~31) + perm32(R & 31)) : R;
        voffA[i] = (unsigned)(R * K + C) * 2u; voffB[i] = (unsigned)(Rb * K + C) * 2u; }
    const size_t kstep = (size_t)(BK * 2);
    const size_t hstep = (size_t)HALF * K * 2;
    const size_t tstep = 2 * hstep;
    const unsigned ldsw = (unsigned)wid * 1024u;
    const int aoff = lds_byte(wr * 64 + fr, fq * 8), boff = lds_byte(wc * 32 + fr, fq * 8);
#define PG8_SA(b, h) (((b) * 2 + (h)) * HTB)
#define PG8_SB(b, h) ((4 + (b) * 2 + (h)) * HTB)
#define PG8_STAGE(bufoff, gbase, voff) do { _Pragma("unroll") for (int _i = 0; _i < 2; ++_i) \
        __builtin_amdgcn_global_load_lds((const unsigned*)((const char*)(gbase) + (voff)[_i]), (PG8_LAS unsigned*)(lds + (bufoff) + ldsw + _i * 8192), 16, 0, 0); } while (0)
#define PG8_LDA(dst, b, h) do { _Pragma("unroll") for (int m = 0; m < 4; ++m) _Pragma("unroll") for (int k = 0; k < 2; ++k) dst[m][k] = *(const PG8_LAS bf16x8*)(lds + PG8_SA(b, h) + aoff + m * 2048 + k * 1024); } while (0)
#define PG8_LDB(dst, b, h) do { _Pragma("unroll") for (int n = 0; n < 2; ++n) _Pragma("unroll") for (int k = 0; k < 2; ++k) dst[n][k] = *(const PG8_LAS bf16x8*)(lds + PG8_SB(b, h) + boff + n * 2048 + k * 1024); } while (0)
#define PG8_MMA(ai, bj, At, Bt) do { __builtin_amdgcn_s_setprio(1); _Pragma("unroll") for (int m = 0; m < 4; ++m) _Pragma("unroll") for (int n = 0; n < 2; ++n) _Pragma("unroll") for (int k = 0; k < 2; ++k) \
        acc[ai][bj][m][n] = __builtin_amdgcn_mfma_f32_16x16x32_bf16(Bt[n][k], At[m][k], acc[ai][bj][m][n], 0, 0, 0); __builtin_amdgcn_s_setprio(0); } while (0)
#define PG8_WAIT_V(n) asm volatile("s_waitcnt vmcnt(" #n ")" ::: "memory")
#define PG8_WAIT_L(n) asm volatile("s_waitcnt lgkmcnt(" #n ")" ::: "memory")
#define PG8_BAR __builtin_amdgcn_s_barrier()
#define PG8_SCHED __builtin_amdgcn_sched_barrier(0)
    Unit cur, nxt; int ui = 0;
    if (!S.next(0, cur)) return;
    f32x4 acc[2][2][4][2];
#pragma unroll
    for (int a = 0; a < 2; ++a)
#pragma unroll
        for (int b = 0; b < 2; ++b)
#pragma unroll
            for (int m = 0; m < 4; ++m)
#pragma unroll
                for (int n = 0; n < 2; ++n) acc[a][b][m][n] = (f32x4){0.f, 0.f, 0.f, 0.f};
    bf16x8 At[4][2], B0[2][2], B1[2][2];
    const char* cA = (const char*)g.A + (size_t)cur.pm * tstep; const char* cB = (const char*)g.Bt + (size_t)cur.pn * tstep;
    S.a_ready(cur);
    if constexpr (SP2) {
        PG8_STAGE(PG8_SB(0, 0), cB, voffB); PG8_STAGE(PG8_SB(0, 1), cB + hstep, voffB); PG8_STAGE(PG8_SA(0, 0), cA, voffA); PG8_STAGE(PG8_SA(0, 1), cA + hstep, voffA);
        if (wr == 1) PG8_BAR;
        PG8_WAIT_V(2); PG8_BAR;
        PG8_STAGE(PG8_SB(1, 0), cB + kstep, voffB); PG8_STAGE(PG8_SA(1, 0), cA + kstep, voffA); PG8_STAGE(PG8_SB(1, 1), cB + hstep + kstep, voffB);
        PG8_WAIT_V(6); PG8_BAR;
    } else {
        PG8_STAGE(PG8_SB(0, 0), cB, voffB); PG8_STAGE(PG8_SA(0, 0), cA, voffA); PG8_STAGE(PG8_SB(0, 1), cB + hstep, voffB); PG8_STAGE(PG8_SA(0, 1), cA + hstep, voffA);
        if (wr == 1) PG8_BAR;
        PG8_WAIT_V(4); PG8_BAR;
        PG8_STAGE(PG8_SB(1, 0), cB + kstep, voffB); PG8_STAGE(PG8_SA(1, 0), cA + kstep, voffA); PG8_STAGE(PG8_SB(1, 1), cB + hstep + kstep, voffB);
        PG8_WAIT_V(6); PG8_BAR;
    }
    for (;;) {
        const bool has_next = S.next(ui + 1, nxt);
        const char* nA = has_next ? (const char*)g.A + (size_t)nxt.pm * tstep : cA; const char* nB = has_next ? (const char*)g.Bt + (size_t)nxt.pn * tstep : cB;
        for (int t = 0; t < nt; t += 2) {
            const bool last = (t == nt - 2);
            const char* a1 = cA + (size_t)(t + 1) * kstep;
            const char* a2 = last ? nA : cA + (size_t)(t + 2) * kstep; const char* b2 = last ? nB : cB + (size_t)(t + 2) * kstep;
            const char* a3 = a2 + kstep; const char* b3 = b2 + kstep;
            if (last && has_next) S.a_ready(nxt);
            if constexpr (SP2) {
            PG8_LDB(B0, 0, 0); PG8_LDB(B1, 0, 1); PG8_SCHED; PG8_LDA(At, 0, 0); PG8_STAGE(PG8_SA(1, 1), a1 + hstep, voffA);
            PG8_WAIT_V(8); PG8_WAIT_L(0); PG8_BAR; PG8_MMA(0, 0, At, B0); PG8_MMA(0, 1, At, B1); PG8_BAR; PG8_SCHED;
            PG8_LDA(At, 0, 1); PG8_STAGE(PG8_SB(0, 0), b2, voffB); PG8_STAGE(PG8_SB(0, 1), b2 + hstep, voffB); PG8_STAGE(PG8_SA(0, 0), a2, voffA);
            PG8_WAIT_V(8); PG8_WAIT_L(0); PG8_BAR; PG8_MMA(1, 0, At, B0); PG8_MMA(1, 1, At, B1); PG8_BAR; PG8_SCHED;
            PG8_LDB(B0, 1, 0); PG8_LDB(B1, 1, 1); PG8_SCHED; PG8_LDA(At, 1, 0); PG8_STAGE(PG8_SA(0, 1), a2 + hstep, voffA);
            PG8_WAIT_V(8); PG8_WAIT_L(0); PG8_BAR; PG8_MMA(0, 0, At, B0); PG8_MMA(0, 1, At, B1); PG8_BAR; PG8_SCHED;
            PG8_LDA(At, 1, 1); PG8_STAGE(PG8_SB(1, 0), b3, voffB); PG8_STAGE(PG8_SB(1, 1), b3 + hstep, voffB); PG8_STAGE(PG8_SA(1, 0), a3, voffA);
            PG8_WAIT_V(8); PG8_WAIT_L(0); PG8_BAR; PG8_MMA(1, 0, At, B0); PG8_MMA(1, 1, At, B1); PG8_BAR; PG8_SCHED;
            } else {
            PG8_LDB(B0, 0, 0); PG8_SCHED; PG8_LDA(At, 0, 0); PG8_STAGE(PG8_SA(1, 1), a1 + hstep, voffA);
            PG8_WAIT_L(8); PG8_BAR; PG8_WAIT_L(0); PG8_MMA(0, 0, At, B0); PG8_BAR; PG8_SCHED;
            PG8_LDB(B1, 0, 1); PG8_STAGE(PG8_SB(0, 0), b2, voffB);
            PG8_BAR; PG8_WAIT_L(0); PG8_MMA(0, 1, At, B1); PG8_BAR;
            PG8_LDA(At, 0, 1); PG8_STAGE(PG8_SA(0, 0), a2, voffA);
            PG8_BAR; PG8_WAIT_L(0); PG8_MMA(1, 0, At, B0); PG8_BAR; PG8_SCHED;
            PG8_STAGE(PG8_SB(0, 1), b2 + hstep, voffB);
            PG8_WAIT_V(6); PG8_BAR; PG8_MMA(1, 1, At, B1); PG8_BAR;
            PG8_LDB(B0, 1, 0); PG8_SCHED; PG8_LDA(At, 1, 0); PG8_STAGE(PG8_SA(0, 1), a2 + hstep, voffA);
            PG8_WAIT_L(8); PG8_BAR; PG8_WAIT_L(0); PG8_MMA(0, 0, At, B0); PG8_BAR; PG8_SCHED;
            PG8_LDB(B1, 1, 1); PG8_STAGE(PG8_SB(1, 0), b3, voffB);
            PG8_BAR; PG8_WAIT_L(0); PG8_MMA(0, 1, At, B1); PG8_BAR;
            PG8_LDA(At, 1, 1); PG8_STAGE(PG8_SA(1, 0), a3, voffA);
            PG8_BAR; PG8_WAIT_L(0); PG8_MMA(1, 0, At, B0); PG8_BAR; PG8_SCHED;
            PG8_STAGE(PG8_SB(1, 1), b3 + hstep, voffB);
            PG8_WAIT_V(6); PG8_BAR; PG8_MMA(1, 1, At, B1); PG8_BAR;
            }
        }
        if constexpr (ALIGN_EPI) { if (wr == 0) PG8_BAR; }
        if constexpr (!Epi::AFTER_DRAIN) { E(acc, cur, wr, wc, fr, fq); S.done(cur); }
        if (!has_next) break;
#pragma unroll
        for (int a = 0; a < 2; ++a)
#pragma unroll
            for (int b = 0; b < 2; ++b)
#pragma unroll
                for (int m = 0; m < 4; ++m)
#pragma unroll
                    for (int n = 0; n < 2; ++n) acc[a][b][m][n] = (f32x4){0.f, 0.f, 0.f, 0.f};
        cur = nxt; cA = nA; cB = nB; ++ui;
        if constexpr (ALIGN_EPI) { if (wr == 1) PG8_BAR; }
    }
    PG8_WAIT_V(0);
    if constexpr (!ALIGN_EPI) { if (wr == 0) PG8_BAR; }
    PG8_BAR;
    if constexpr (Epi::AFTER_DRAIN) { E.fused(acc, cur, wr, wc, fr, fq, lds, wid, lane); S.done(cur); }
#undef PG8_SA
#undef PG8_SB
#undef PG8_STAGE
#undef PG8_LDA
#undef PG8_LDB
#undef PG8_MMA
#undef PG8_WAIT_V
#undef PG8_WAIT_L
#undef PG8_BAR
#undef PG8_SCHED
}
}

#ifndef GMLP_DBG
#define GMLP_DBG 0
#endif
constexpr int NWAVES = 8, NTHR = 512;
constexpr int BATCH = 4, SEQ = 8192, D = 1024, DEPTH = 4, M = BATCH * SEQ;
constexpr int D_IN = 2576, NZ = 2816;
constexpr int FF = 4096;
constexpr int ZU = 0, ZV = 512, ZQ = 1024, ZK = 1280, ZVB = 1536, ZG = 2048, ZP = 2560;
constexpr float EPS = 1e-6f;
constexpr int NCHUNK = M / 64;
constexpr size_t MiB = 1u << 20;
constexpr size_t WS_WM = 1 * MiB;
constexpr size_t WS_DEC = 1 * MiB + 512 * 1024;
constexpr size_t WS_W = 2 * MiB;
constexpr size_t W_IN_B = (size_t)NZ * D * 2, W_OUT_B = (size_t)D * D * 2, W_1_B = (size_t)FF * D * 2, W_2_B = (size_t)D * FF * 2, W_LAYER_B = W_IN_B + W_OUT_B + W_1_B + W_2_B;
constexpr size_t WS_F1 = 96 * MiB;
constexpr size_t WS_Z = 96 * MiB;
constexpr size_t WS_AB = 272 * MiB;
constexpr size_t WS_QE = 336 * MiB;
constexpr size_t WS_Y = 352 * MiB;
constexpr size_t WS_SP = 352 * MiB;
constexpr size_t WS_OI = 384 * MiB;
constexpr size_t WS_MM = 416 * MiB;
constexpr size_t WS_UPD = 416 * MiB;
constexpr size_t WS_HP = 480 * MiB;
constexpr size_t WS_END = 494 * MiB;
static_assert(WS_W + DEPTH * W_LAYER_B <= WS_F1, "weights fit");
constexpr int LDS_BYTES = 149504;

#define GAS __attribute__((address_space(1)))
#define LAS __attribute__((address_space(3)))
typedef unsigned short bf16;
typedef unsigned v4u __attribute__((ext_vector_type(4)));
typedef unsigned v2u __attribute__((ext_vector_type(2)));
typedef float f32x4 __attribute__((ext_vector_type(4)));
typedef short bf16x8 __attribute__((ext_vector_type(8)));
#define LDS_WAIT() asm volatile("s_waitcnt lgkmcnt(0)" ::: "memory")
#define MFMA_DRAIN() asm volatile("s_nop 15\n\ts_nop 15\n\ts_nop 15\n\ts_nop 15\n\ts_nop 15\n\ts_nop 15\n\ts_nop 15\n\ts_nop 15\n\ts_nop 15\n\ts_nop 15\n\ts_nop 15\n\ts_nop 15\n\ts_nop 15\n\ts_nop 15\n\ts_nop 15\n\ts_nop 15" ::: "memory")
#define FRAG_WAIT() __builtin_amdgcn_sched_barrier(0)
#define MFMA16(a, b, c) __builtin_amdgcn_mfma_f32_16x16x32_bf16((a), (b), (c), 0, 0, 0)

__device__ __forceinline__ unsigned f2bf(float f) { unsigned u = __builtin_bit_cast(unsigned, f); return (u + 0x7fffu + ((u >> 16) & 1u)) >> 16; }
typedef __bf16 hwbf2 __attribute__((ext_vector_type(2)));
typedef float hwf2 __attribute__((ext_vector_type(2)));
__device__ __forceinline__ unsigned pk2(float lo, float hi) { const hwf2 v = {lo, hi}; return __builtin_bit_cast(unsigned, __builtin_convertvector(v, hwbf2)); }
__device__ __forceinline__ float bflo(unsigned w) { return __builtin_bit_cast(float, w << 16); }
__device__ __forceinline__ float bfhi(unsigned w) { return __builtin_bit_cast(float, w & 0xffff0000u); }
__device__ __forceinline__ float bf1(bf16 h) { return __builtin_bit_cast(float, (unsigned)h << 16); }
__device__ __forceinline__ void unpack8(const v4u w, float (&o)[8]) { o[0] = bflo(w.x); o[1] = bfhi(w.x); o[2] = bflo(w.y); o[3] = bfhi(w.y); o[4] = bflo(w.z); o[5] = bfhi(w.z); o[6] = bflo(w.w); o[7] = bfhi(w.w); }
__device__ __forceinline__ v4u pack8(const float (&o)[8]) { v4u w; w.x = pk2(o[0], o[1]); w.y = pk2(o[2], o[3]); w.z = pk2(o[4], o[5]); w.w = pk2(o[6], o[7]); return w; }
__device__ __forceinline__ float wave_sum(float v) {
#pragma unroll
    for (int o = 1; o < 64; o <<= 1) v += __shfl_xor(v, o);
    return v;
}
__device__ __forceinline__ float row16_sum(float v) {
#pragma unroll
    for (int o = 1; o < 16; o <<= 1) v += __shfl_xor(v, o);
    return v;
}

__device__ __forceinline__ void row16_sum4_lds(LAS unsigned char* scr, float (&v)[4], int lane) {
    *(LAS f32x4*)(scr + lane * 16) = (f32x4){v[0], v[1], v[2], v[3]};
    asm volatile("s_waitcnt lgkmcnt(0)" ::: "memory");
    f32x4 s = (f32x4){0.f, 0.f, 0.f, 0.f};
#pragma unroll
    for (int k = 0; k < 16; ++k) s += *(const LAS f32x4*)(scr + ((lane & 48) + k) * 16);
    asm volatile("s_waitcnt lgkmcnt(0)" ::: "memory");
    v[0] = s.x; v[1] = s.y; v[2] = s.z; v[3] = s.w;
}

__device__ __forceinline__ float wave_sum_lds(LAS unsigned char* scr, float v, int lane) {
    *(LAS float*)(scr + lane * 4) = v;
    asm volatile("s_waitcnt lgkmcnt(0)" ::: "memory");
    f32x4 s = (f32x4){0.f, 0.f, 0.f, 0.f};
#pragma unroll
    for (int k = 0; k < 16; ++k) s += *(const LAS f32x4*)(scr + k * 16);
    asm volatile("s_waitcnt lgkmcnt(0)" ::: "memory");
    return (s.x + s.y) + (s.z + s.w);
}
__device__ __forceinline__ void wave_sum4_lds(LAS unsigned char* scr, float (&v)[4], int lane) {
    *(LAS f32x4*)(scr + lane * 16) = (f32x4){v[0], v[1], v[2], v[3]};
    asm volatile("s_waitcnt lgkmcnt(0)" ::: "memory");
    f32x4 s = (f32x4){0.f, 0.f, 0.f, 0.f};
#pragma unroll
    for (int k = 0; k < 16; ++k) s += *(const LAS f32x4*)(scr + ((lane & 48) + k) * 16);
    asm volatile("s_waitcnt lgkmcnt(0)" ::: "memory");
    if ((lane & 15) == 0) *(LAS f32x4*)(scr + (lane >> 4) * 16) = s;
    asm volatile("s_waitcnt lgkmcnt(0)" ::: "memory");
    const f32x4 t0 = *(const LAS f32x4*)(scr), t1 = *(const LAS f32x4*)(scr + 16), t2 = *(const LAS f32x4*)(scr + 32), t3 = *(const LAS f32x4*)(scr + 48);
    asm volatile("s_waitcnt lgkmcnt(0)" ::: "memory");
    const f32x4 t = (t0 + t1) + (t2 + t3);
    v[0] = t.x; v[1] = t.y; v[2] = t.z; v[3] = t.w;
}

constexpr int HPR = 4, HP_ROWS = 16;
__device__ __forceinline__ size_t hp_row(int r16) { return (size_t)(r16 >> 2) * SEQ + (size_t)(r16 & 3); }
template <bool IN_BF16, int ACT>
__device__ __forceinline__ void hp_gemv4(LAS unsigned char* lds, const void* in, int K, const float* W, int ldw, int c0, float* out, int ldo, int wave, int lane) {
    const int c = c0 + (wave & 3), kbeg = (wave >> 2) * (K >> 1), steps = (K >> 1) >> 6;
    float acc[16];
#pragma unroll
    for (int r = 0; r < 16; ++r) acc[r] = 0.f;
#pragma unroll 2
    for (int s = 0; s < steps; ++s) { const int k = kbeg + s * 64 + lane;
        const float w = W[(size_t)k * ldw + c];
#pragma unroll
        for (int r = 0; r < 16; ++r) { const float a = IN_BF16 ? bf1(((const bf16*)in)[hp_row(r) * D + k]) : ((const float*)in)[(size_t)r * K + k]; acc[r] += a * w; } }
    LAS unsigned char* scr = lds + wave * 1024;
#pragma unroll
    for (int q = 0; q < 4; ++q) { float v[4] = {acc[4 * q], acc[4 * q + 1], acc[4 * q + 2], acc[4 * q + 3]}; wave_sum4_lds(scr, v, lane); acc[4 * q] = v[0]; acc[4 * q + 1] = v[1]; acc[4 * q + 2] = v[2]; acc[4 * q + 3] = v[3]; }
    LAS float* X = (LAS float*)(lds + 8192);
    if (lane == 0) {
#pragma unroll
        for (int r = 0; r < 16; ++r) X[wave * 16 + r] = acc[r]; }
    __syncthreads();
    if (wave < 4 && lane < 16) { float v = X[wave * 16 + lane] + X[(wave + 4) * 16 + lane]; if (ACT == 2) { v = fmaxf(v, 0.f); v = v * v; } out[(size_t)lane * ldo + c0 + wave] = v; }
    __syncthreads();
}

template <int ACT>
__device__ __forceinline__ void hp_gemv_phase(LAS unsigned char* lds, const float* in32, int K, const float* W, int ldw, int N, float* out, int G, int bid, int wave, int lane, int tid) {
    LAS float* INS = (LAS float*)(lds + 16384);
    const int nch = K >> 10, half = wave >> 2;
    for (int cg = bid; cg < (N >> 2); cg += G) {
        float acc[16];
#pragma unroll
        for (int r = 0; r < 16; ++r) acc[r] = 0.f;
        const int c = 4 * cg + (wave & 3);
        for (int ch = 0; ch < nch; ++ch) {
            if (nch > 1 || cg == bid) {
                __syncthreads();
#pragma unroll
                for (int i = 0; i < 8; ++i) { const int idx = tid + 512 * i, r = idx >> 8, k4 = idx & 255;
                    *(LAS f32x4*)(INS + r * 1024 + 4 * k4) = *(const f32x4*)(in32 + (size_t)r * K + ch * 1024 + 4 * k4); }
                __syncthreads();
            }
            const int kb = ch * 1024 + half * 512 + lane;
            float w8[8];
#pragma unroll
            for (int s = 0; s < 8; ++s) w8[s] = W[(size_t)(kb + s * 64) * ldw + c];
#pragma unroll
            for (int s = 0; s < 8; ++s)
#pragma unroll
                for (int r = 0; r < 16; ++r) acc[r] += INS[r * 1024 + half * 512 + s * 64 + lane] * w8[s];
        }
        LAS unsigned char* scr = lds + wave * 1024;
#pragma unroll
        for (int q = 0; q < 4; ++q) { float v[4] = {acc[4 * q], acc[4 * q + 1], acc[4 * q + 2], acc[4 * q + 3]}; wave_sum4_lds(scr, v, lane); acc[4 * q] = v[0]; acc[4 * q + 1] = v[1]; acc[4 * q + 2] = v[2]; acc[4 * q + 3] = v[3]; }
        LAS float* X = (LAS float*)(lds + 8192);
        if (lane == 0) {
#pragma unroll
            for (int r = 0; r < 16; ++r) X[wave * 16 + r] = acc[r]; }
        __syncthreads();
        if (wave < 4 && lane < 16) { float v = X[wave * 16 + lane] + X[(wave + 4) * 16 + lane]; if (ACT == 2) { v = fmaxf(v, 0.f); v = v * v; } out[(size_t)lane * N + 4 * cg + wave] = v; }
        __syncthreads();
    }
}

__device__ __forceinline__ void p0_transpose_item(const float* W, int ldw, int ncols, int K, bf16* WT, const float* kscale, int qlo, int qhi, LAS float* scr, int item, int lane) {
    const int nblk = ncols / 32, kb = item / nblk, nb = item % nblk, k0 = 64 * kb, n0 = 32 * nb;
    const float cs = (n0 >= qlo && n0 < qhi) ? 0.125f : 1.0f;
    float wreg[32];
#pragma unroll
    for (int i = 0; i < 32; ++i) wreg[i] = W[(size_t)(k0 + 2 * i + (lane >> 5)) * ldw + n0 + (lane & 31)];
#pragma unroll
    for (int i = 0; i < 32; ++i) { const int kk = 2 * i + (lane >> 5); float w = wreg[i]; if (kscale) w *= kscale[k0 + kk]; scr[kk * 33 + (lane & 31)] = w * cs; }
    LDS_WAIT(); asm volatile("" ::: "memory");
    const int c = lane & 7;
#pragma unroll
    for (int j = 0; j < 4; ++j) { const int n = (lane >> 3) + 8 * j; const LAS float* s = scr + (8 * c) * 33 + n;
        v4u o; o.x = pk2(s[0 * 33], s[1 * 33]); o.y = pk2(s[2 * 33], s[3 * 33]); o.z = pk2(s[4 * 33], s[5 * 33]); o.w = pk2(s[6 * 33], s[7 * 33]);
        *(GAS v4u*)(WT + (size_t)(n0 + n) * K + k0 + 8 * c) = o; }
    LDS_WAIT(); asm volatile("" ::: "memory");
}
__device__ __forceinline__ void p0_gate_item(const float* Win, const float* gw, const float* g, bf16* WT, int item, int lane) {
    const int np = item >> 1, k0 = ((item & 1) * 64 + lane) * 8;
    float gwv[16];
#pragma unroll
    for (int r = 0; r < 16; ++r) gwv[r] = gw[r * 256 + np];
    float o[8];
#pragma unroll
    for (int j = 0; j < 8; ++j) { const float* wr = Win + (size_t)(k0 + j) * D_IN + 2560; float s = 0.f;
#pragma unroll
        for (int r4 = 0; r4 < 4; ++r4) { const f32x4 w = *(const f32x4*)(wr + 4 * r4); s += w.x * gwv[4 * r4] + w.y * gwv[4 * r4 + 1] + w.z * gwv[4 * r4 + 2] + w.w * gwv[4 * r4 + 3]; }
        o[j] = s * g[k0 + j]; }
    *(GAS v4u*)(WT + (size_t)(2560 + np) * D + k0) = pack8(o);
}

__device__ __forceinline__ void rows_add_stream(LAS unsigned char* scr, float (&hv)[16], const v4u mc0, const v4u mc1, const float* m32, const float* g, int row, int lane) {
    float mv[16];
    const int tpos = row & (SEQ - 1); const bool hp = (m32 != nullptr) && (tpos < HPR);
    if (hp) { const float* m3 = m32 + (size_t)((row >> 13) * 4 + tpos) * D + 8 * lane;
#pragma unroll
        for (int e = 0; e < 2; ++e) { const f32x4 a = *(const f32x4*)(m3 + 512 * e), b = *(const f32x4*)(m3 + 512 * e + 4);
            mv[8 * e + 0] = a.x; mv[8 * e + 1] = a.y; mv[8 * e + 2] = a.z; mv[8 * e + 3] = a.w; mv[8 * e + 4] = b.x; mv[8 * e + 5] = b.y; mv[8 * e + 6] = b.z; mv[8 * e + 7] = b.w; }
    } else {
        float t[8]; unpack8(mc0, t);
#pragma unroll
        for (int i = 0; i < 8; ++i) mv[i] = t[i];
        unpack8(mc1, t);
#pragma unroll
        for (int i = 0; i < 8; ++i) mv[8 + i] = t[i]; }
    float ss = 0.f;
#pragma unroll
    for (int i = 0; i < 16; ++i) ss += mv[i] * mv[i];
    const float rstd = 1.0f / sqrtf(wave_sum_lds(scr, ss, lane) * (1.0f / D) + EPS);
#pragma unroll
    for (int e = 0; e < 2; ++e) { const f32x4 ga = *(const f32x4*)(g + 8 * lane + 512 * e), gb = *(const f32x4*)(g + 8 * lane + 512 * e + 4);
        const float gg[8] = {ga.x, ga.y, ga.z, ga.w, gb.x, gb.y, gb.z, gb.w};
#pragma unroll
        for (int i = 0; i < 8; ++i) hv[8 * e + i] += mv[8 * e + i] * rstd * gg[i]; }
}
__device__ __forceinline__ void rows_phase(LAS unsigned char* scr, const float* hin, const bf16* mm, const float* g, float* hout, bf16* y, int gw, int ngw, int lane, const float* m32 = nullptr, float* y32out = nullptr, const float* ygain = nullptr,
                                           const bf16* mm2 = nullptr, const float* g2 = nullptr, const float* m32b = nullptr) {
    f32x4 hn[4]; v4u mn[2] = {(v4u){0u, 0u, 0u, 0u}, (v4u){0u, 0u, 0u, 0u}}, mn2[2] = {(v4u){0u, 0u, 0u, 0u}, (v4u){0u, 0u, 0u, 0u}};
#define NT_LD4F(p) __builtin_nontemporal_load((const f32x4*)(p))
#define NT_LD4U(p) __builtin_nontemporal_load((const v4u*)(p))
    { const float* hr = hin + (size_t)gw * D + 8 * lane; hn[0] = NT_LD4F(hr); hn[1] = NT_LD4F(hr + 4); hn[2] = NT_LD4F(hr + 512); hn[3] = NT_LD4F(hr + 516);
      if (mm) { const bf16* mr = mm + (size_t)gw * D + 8 * lane; mn[0] = NT_LD4U(mr); mn[1] = NT_LD4U(mr + 512); }
      if (mm2) { const bf16* mr = mm2 + (size_t)gw * D + 8 * lane; mn2[0] = NT_LD4U(mr); mn2[1] = NT_LD4U(mr + 512); } }
    for (int row = gw; row < M; row += ngw) {
        float hv[16];
        hv[0] = hn[0].x; hv[1] = hn[0].y; hv[2] = hn[0].z; hv[3] = hn[0].w; hv[4] = hn[1].x; hv[5] = hn[1].y; hv[6] = hn[1].z; hv[7] = hn[1].w;
        hv[8] = hn[2].x; hv[9] = hn[2].y; hv[10] = hn[2].z; hv[11] = hn[2].w; hv[12] = hn[3].x; hv[13] = hn[3].y; hv[14] = hn[3].z; hv[15] = hn[3].w;
        const v4u mc0 = mn[0], mc1 = mn[1], mb0 = mn2[0], mb1 = mn2[1];
        if (row + ngw < M) { const float* hr = hin + (size_t)(row + ngw) * D + 8 * lane; hn[0] = NT_LD4F(hr); hn[1] = NT_LD4F(hr + 4); hn[2] = NT_LD4F(hr + 512); hn[3] = NT_LD4F(hr + 516);
            if (mm) { const bf16* mr = mm + (size_t)(row + ngw) * D + 8 * lane; mn[0] = NT_LD4U(mr); mn[1] = NT_LD4U(mr + 512); }
            if (mm2) { const bf16* mr = mm2 + (size_t)(row + ngw) * D + 8 * lane; mn2[0] = NT_LD4U(mr); mn2[1] = NT_LD4U(mr + 512); } }
        if (mm) rows_add_stream(scr, hv, mc0, mc1, m32, g, row, lane);
        if (mm2) rows_add_stream(scr, hv, mb0, mb1, m32b, g2, row, lane);
        if (hout) { float* orow = hout + (size_t)row * D + 8 * lane;
#pragma unroll
            for (int e = 0; e < 2; ++e) { __builtin_nontemporal_store((f32x4){hv[8 * e], hv[8 * e + 1], hv[8 * e + 2], hv[8 * e + 3]}, (f32x4*)(orow + 512 * e)); __builtin_nontemporal_store((f32x4){hv[8 * e + 4], hv[8 * e + 5], hv[8 * e + 6], hv[8 * e + 7]}, (f32x4*)(orow + 512 * e + 4)); } }
        if (y) {
            float ss = 0.f;
#pragma unroll
            for (int i = 0; i < 16; ++i) ss += hv[i] * hv[i];
            const float rstd = 1.0f / sqrtf(wave_sum_lds(scr, ss, lane) * (1.0f / D) + EPS);
            bf16* yr = y + (size_t)row * D + 8 * lane;
#pragma unroll
            for (int e = 0; e < 2; ++e) { float t[8];
#pragma unroll
                for (int i = 0; i < 8; ++i) t[i] = hv[8 * e + i] * rstd;
                *(v4u*)(yr + 512 * e) = pack8(t); }
            const int tpos2 = row & (SEQ - 1);
            if (y32out != nullptr && tpos2 < HPR) { float* y3 = y32out + (size_t)((row >> 13) * 4 + tpos2) * D + 8 * lane;
#pragma unroll
                for (int e = 0; e < 2; ++e)
#pragma unroll
                    for (int i = 0; i < 8; ++i) y3[512 * e + i] = hv[8 * e + i] * rstd * ygain[8 * lane + 512 * e + i]; }
        }
    }
}

constexpr int VT_ROW = 272, VT_HEAD = 128 * VT_ROW;
__device__ __forceinline__ void gmlp_unit(LAS unsigned char* lds, float* ab32, const bf16* z, bf16* ab, const bf16* Wm, const float* ln_g, const float* ln_b, const float* bs, const float* out_g, int unit, int tid) {
    const int lane = tid & 63, wave = __builtin_amdgcn_readfirstlane(tid >> 6), x = lane & 15, g = lane >> 4;
    const size_t row0 = (size_t)unit * 128;
    {
        float gg[8], bb[8];
        { const f32x4 a = *(const f32x4*)(ln_g + 8 * lane), b = *(const f32x4*)(ln_g + 8 * lane + 4); gg[0] = a.x; gg[1] = a.y; gg[2] = a.z; gg[3] = a.w; gg[4] = b.x; gg[5] = b.y; gg[6] = b.z; gg[7] = b.w; }
        { const f32x4 a = *(const f32x4*)(ln_b + 8 * lane), b = *(const f32x4*)(ln_b + 8 * lane + 4); bb[0] = a.x; bb[1] = a.y; bb[2] = a.z; bb[3] = a.w; bb[4] = b.x; bb[5] = b.y; bb[6] = b.z; bb[7] = b.w; }
        const int h = lane >> 4;
#pragma unroll 1
        for (int it = 0; it < 4; ++it) {
            const int j0 = 16 * wave + 4 * it;
            float val[4][8];
            LAS unsigned char* scr1 = lds + 4 * VT_HEAD + wave * 1024;
            float sm[4];
#pragma unroll
            for (int t = 0; t < 4; ++t) {
                const v4u w = *(const v4u*)(z + (row0 + j0 + t) * NZ + ZV + 8 * lane);
                unpack8(w, val[t]);
                float s = 0.f;
#pragma unroll
                for (int i = 0; i < 8; ++i) s += val[t][i];
                sm[t] = s;
            }
            wave_sum4_lds(scr1, sm, lane);
            float s2[4];
#pragma unroll
            for (int t = 0; t < 4; ++t) { const float mean = sm[t] * (1.0f / 512.0f); float q = 0.f;
#pragma unroll
                for (int i = 0; i < 8; ++i) { val[t][i] -= mean; q += val[t][i] * val[t][i]; }
                s2[t] = q; }
            wave_sum4_lds(scr1, s2, lane);
#pragma unroll
            for (int t = 0; t < 4; ++t) { const float rstd = 1.0f / sqrtf(s2[t] * (1.0f / 512.0f) + EPS);
#pragma unroll
                for (int i = 0; i < 8; ++i) val[t][i] = val[t][i] * rstd * gg[i] + bb[i]; }
#pragma unroll
            for (int i = 0; i < 8; ++i) { v2u o; o.x = pk2(val[0][i], val[1][i]); o.y = pk2(val[2][i], val[3][i]);
                *(LAS v2u*)(lds + h * VT_HEAD + (i * 16 + x) * VT_ROW + j0 * 2) = o; }
        }
    }
    __syncthreads();
    if (GMLP_DBG == 7) {
        const bf16x8 a = (bf16x8){0x3f80, 0x3f00, 0x3e80, 0x3f80, 0x3f00, 0x3e80, 0x3f80, 0x3f00};
        for (int h = 0; h < 4; ++h) {
            f32x4 acc[8];
            for (int nt = 0; nt < 8; ++nt) acc[nt] = (f32x4){0.f, 0.f, 0.f, 0.f};
            for (int ks = 0; ks < 4; ++ks) {
                bf16x8 b[8];
#pragma unroll
                for (int nt = 0; nt < 8; ++nt) b[nt] = *(const LAS bf16x8*)(lds + h * VT_HEAD + (nt * 16 + x) * VT_ROW + (ks * 32 + 8 * g) * 2);
                FRAG_WAIT();
#pragma unroll
                for (int nt = 0; nt < 8; ++nt) acc[nt] = MFMA16(a, b[nt], acc[nt]);
            }
#pragma unroll
            for (int r = 0; r < 4; ++r) { float t[8];
#pragma unroll
                for (int nt = 0; nt < 8; ++nt) t[nt] = acc[nt][r];
                *(v4u*)(ab + (row0 + 16 * wave + 4 * g + r) * D + 128 * h + 8 * x) = pack8(t); }
        }
        __syncthreads();
        return;
    }
    if (GMLP_DBG == 6) {
        for (int h = 0; h < 4; ++h) { float f[8] = {0.f, 0.f, 0.f, 0.f, 0.f, 0.f, 0.f, 0.f};
            for (int nt = 0; nt < 8; ++nt) for (int ks = 0; ks < 4; ++ks) {
                const v4u b = *(const LAS v4u*)(lds + h * VT_HEAD + (nt * 16 + x) * VT_ROW + (ks * 32 + 8 * g) * 2);
                float t[8]; unpack8(b, t);
                for (int q = 0; q < 8; ++q) f[q] += t[q] * (float)(1 + nt + 8 * ks); }
            *(v4u*)(ab + (row0 + 16 * wave + x) * D + 128 * h + 8 * g) = pack8(f); }
        __syncthreads();
        return;
    }
    const int nk = (wave < 4) ? 2 : 4;
    float ssr[4] = {0.f, 0.f, 0.f, 0.f};
#pragma unroll 1
    for (int h = 0; h < 4; ++h) {
        f32x4 acc[8];
#pragma unroll
        for (int nt = 0; nt < 8; ++nt) acc[nt] = (f32x4){0.f, 0.f, 0.f, 0.f};
        bf16x8 a4[4]; v4u uw[4];
#pragma unroll
        for (int ks = 0; ks < 4; ++ks) a4[ks] = *(const bf16x8*)(Wm + h * 16384 + (16 * wave + x) * 128 + ks * 32 + 8 * g);
#pragma unroll
        for (int r = 0; r < 4; ++r) uw[r] = *(const v4u*)(z + (row0 + 16 * wave + 4 * g + r) * NZ + ZU + 128 * h + 8 * x);
#pragma unroll
        for (int ks = 0; ks < 4; ++ks) {
            if (ks < nk) {
#pragma unroll
                for (int nt = 0; nt < 8; ++nt) { const bf16x8 b = *(const LAS bf16x8*)(lds + h * VT_HEAD + (nt * 16 + x) * VT_ROW + (ks * 32 + 8 * g) * 2); acc[nt] = MFMA16(a4[ks], b, acc[nt]); }
            }
        }
        __syncthreads();
#pragma unroll
        for (int r = 0; r < 4; ++r) {
            const int i = 16 * wave + 4 * g + r;
            float uv[8]; unpack8(uw[r], uv);
            const float bias = bs[h * 128 + i];
            float o[8];
#pragma unroll
            for (int nt = 0; nt < 8; ++nt) o[nt] = uv[nt] * (acc[nt][r] + bias);
            const v4u pw = pack8(o);
            float ob[8]; unpack8(pw, ob);
#pragma unroll
            for (int nt = 0; nt < 8; ++nt) ssr[r] += ob[nt] * ob[nt];
            *(LAS v4u*)(lds + h * VT_HEAD + wave * 4096 + r * 1024 + lane * 16) = pw;
        }
    }
    row16_sum4_lds(lds + 4 * VT_HEAD + wave * 1024, ssr, lane);
    float rstd[4];
#pragma unroll
    for (int r = 0; r < 4; ++r) rstd[r] = 1.0f / sqrtf(ssr[r] * (1.0f / 512.0f) + EPS);
#pragma unroll 1
    for (int h = 0; h < 4; ++h) {
        const f32x4 ga = *(const f32x4*)(out_g + 128 * h + 8 * x), gb = *(const f32x4*)(out_g + 128 * h + 8 * x + 4);
        const float gg[8] = {ga.x, ga.y, ga.z, ga.w, gb.x, gb.y, gb.z, gb.w};
#pragma unroll
        for (int r = 0; r < 4; ++r) {
            const int i = 16 * wave + 4 * g + r;
            float t[8]; unpack8(*(const LAS v4u*)(lds + h * VT_HEAD + wave * 4096 + r * 1024 + lane * 16), t);
#pragma unroll
            for (int nt = 0; nt < 8; ++nt) t[nt] = t[nt] * rstd[r] * gg[nt];
            *(v4u*)(ab + (row0 + i) * D + 128 * h + 8 * x) = pack8(t);
        }
    }
    __syncthreads();
}


__device__ __forceinline__ void block_sum16(LAS unsigned char* wscr, LAS float* PW, float (&v)[16], int wave, int lane) {
#pragma unroll
    for (int q = 0; q < 4; ++q) { float t[4] = {v[4 * q], v[4 * q + 1], v[4 * q + 2], v[4 * q + 3]}; wave_sum4_lds(wscr, t, lane); v[4 * q] = t[0]; v[4 * q + 1] = t[1]; v[4 * q + 2] = t[2]; v[4 * q + 3] = t[3]; asm volatile("" ::: "memory"); }
    if (lane == 0) {
#pragma unroll
        for (int i = 0; i < 16; ++i) PW[wave * 16 + i] = v[i]; }
    __syncthreads();
#pragma unroll
    for (int i = 0; i < 16; ++i) v[i] = 0.f;
#pragma unroll
    for (int w2 = 0; w2 < 8; ++w2) {
#pragma unroll
        for (int q = 0; q < 4; ++q) { const f32x4 t = *(const LAS f32x4*)(PW + w2 * 16 + 4 * q); v[4 * q] += t.x; v[4 * q + 1] += t.y; v[4 * q + 2] += t.z; v[4 * q + 3] += t.w; }
        asm volatile("" ::: "memory"); }
    __syncthreads();
}
__device__ __forceinline__ void block_sum4(LAS unsigned char* wscr, LAS float* PW, float (&v)[4], int wave, int lane) {
    wave_sum4_lds(wscr, v, lane);
    if (lane == 0) *(LAS f32x4*)(PW + wave * 4) = (f32x4){v[0], v[1], v[2], v[3]};
    __syncthreads();
    f32x4 s = (f32x4){0.f, 0.f, 0.f, 0.f};
#pragma unroll
    for (int w2 = 0; w2 < 8; ++w2) s += *(const LAS f32x4*)(PW + w2 * 4);
    v[0] = s.x; v[1] = s.y; v[2] = s.z; v[3] = s.w;
    __syncthreads();
}
__device__ __forceinline__ void gmlp_hp1(LAS unsigned char* lds, const float* hsrc, const float* Win32, const float* pre_g, float* part, float* partu, int b, int ks, int rq, int tid_in) {
    int tid = tid_in; asm volatile("" : "+v"(tid));
    const int c = tid;
    const size_t rb = (size_t)b * SEQ + 16 * rq;
    LAS float* Y = (LAS float*)(lds + 1024);
    { const int sj = tid >> 5, skk = (tid & 31) * 2;
      const float* hr = hsrc + (rb + sj) * D + 64 * ks + skk; const float* gr = pre_g + 64 * ks + skk;
      Y[(skk + 0) * 16 + sj] = hr[0] * gr[0]; Y[(skk + 1) * 16 + sj] = hr[1] * gr[1]; }
    __syncthreads();
    const float* wbase = Win32 + (size_t)(64 * ks) * D_IN + c;
    float accv[16], accu[4] = {0.f, 0.f, 0.f, 0.f};
#pragma unroll
    for (int j = 0; j < 16; ++j) accv[j] = 0.f;
#pragma unroll 1
    for (int kb = 0; kb < 64; kb += 8) {
        float wv[8], wu[8];
        const float* wk = wbase + (size_t)kb * D_IN;
#pragma unroll
        for (int e = 0; e < 8; ++e) { wv[e] = wk[(size_t)e * D_IN + ZV]; wu[e] = wk[(size_t)e * D_IN + ZU]; }
#pragma unroll
        for (int e = 0; e < 8; ++e) {
#pragma unroll
            for (int q4 = 0; q4 < 4; ++q4) { const f32x4 y = *(const LAS f32x4*)(Y + (kb + e) * 16 + 4 * q4);
                accv[4 * q4] += y.x * wv[e]; accv[4 * q4 + 1] += y.y * wv[e]; accv[4 * q4 + 2] += y.z * wv[e]; accv[4 * q4 + 3] += y.w * wv[e];
                if (q4 == 0) { accu[0] += y.x * wu[e]; accu[1] += y.y * wu[e]; accu[2] += y.z * wu[e]; accu[3] += y.w * wu[e]; } }
        }
    }
    float* pp = part + ((size_t)(b * 16 + ks) * 64 + 16 * rq) * 512 + c;
#pragma unroll
    for (int j = 0; j < 16; ++j) pp[(size_t)j * 512] = accv[j];
    if (rq == 0) {
#pragma unroll
        for (int i = 0; i < 4; ++i) partu[((size_t)(b * 16 + ks) * 4 + i) * 512 + c] = accu[i]; }
    __syncthreads();
}
__device__ __forceinline__ void gmlp_hp2a(LAS unsigned char* lds, const float* hsrc, const float* ws32, const float* ln_g, const float* ln_b, const float* part, const float* partu, float* mixp, float* zup, int b, int rg, int tid_in) {
    int tid = tid_in; asm volatile("" : "+v"(tid));
    const int lane = tid & 63, wave = __builtin_amdgcn_readfirstlane(tid >> 6), c = tid;
    const size_t rb = (size_t)b * SEQ;
    LAS float* RS = (LAS float*)(lds);
    LAS float* PW = (LAS float*)(lds + 512);
    LAS unsigned char* wscr = lds + 1024 + wave * 1024;
    if (wave < 4) {
        const float* hr = hsrc + (rb + 4 * rg + wave) * D; float s = 0.f;
#pragma unroll
        for (int e = 0; e < 16; ++e) { const float v = hr[lane + 64 * e]; s += v * v; }
        const float tot = wave_sum_lds(wscr, s, lane);
        if (lane == 0) RS[wave] = 1.0f / sqrtf(tot * (1.0f / D) + EPS);
    }
    float s4[4] = {0.f, 0.f, 0.f, 0.f};
    { const float* pb = part + ((size_t)(b * 16) * 64 + 4 * rg) * 512 + c;
#pragma unroll 8
      for (int ks = 0; ks < 16; ++ks) { const float* pk = pb + (size_t)ks * 64 * 512;
#pragma unroll
          for (int i = 0; i < 4; ++i) s4[i] += pk[i * 512]; } }
    __syncthreads();
    const float lg = ln_g[c], lb = ln_b[c];
    const int h = wave >> 1;
    float x4[4], v[4];
#pragma unroll
    for (int i = 0; i < 4; ++i) { x4[i] = pg8::gelu_tanh(s4[i] * RS[i]); v[i] = x4[i]; }
    block_sum4(wscr, PW, v, wave, lane);
#pragma unroll
    for (int i = 0; i < 4; ++i) { x4[i] -= v[i] * (1.0f / 512.0f); v[i] = x4[i] * x4[i]; }
    block_sum4(wscr, PW, v, wave, lane);
#pragma unroll
    for (int i = 0; i < 4; ++i) x4[i] = x4[i] * (1.0f / sqrtf(v[i] * (1.0f / 512.0f) + EPS)) * lg + lb;
#pragma unroll
    for (int i = 0; i < 4; ++i) { const f32x4 w = *(const f32x4*)(ws32 + (size_t)(h * 128 + i) * 128 + 4 * rg);
        mixp[((size_t)(b * 16 + rg) * 4 + i) * 512 + c] = w.x * x4[0] + w.y * x4[1] + w.z * x4[2] + w.w * x4[3]; }
    if (rg == 0) {
        float zu[4] = {0.f, 0.f, 0.f, 0.f};
#pragma unroll 8
        for (int ks = 0; ks < 16; ++ks) { const float* pk = partu + ((size_t)(b * 16 + ks) * 4) * 512 + c;
#pragma unroll
            for (int i = 0; i < 4; ++i) zu[i] += pk[i * 512]; }
#pragma unroll
        for (int i = 0; i < 4; ++i) zup[((size_t)b * 4 + i) * 512 + c] = zu[i] * RS[i];
    }
    __syncthreads();
}
__device__ __forceinline__ void gmlp_hp2b(LAS unsigned char* lds, const float* bs, const float* out_g, const float* mixp, const float* zup, float* ab32, int b, int tid_in) {
    int tid = tid_in; asm volatile("" : "+v"(tid));
    const int lane = tid & 63, wave = __builtin_amdgcn_readfirstlane(tid >> 6), c = tid;
    LAS float* PW = (LAS float*)(lds + 512);
    LAS unsigned char* wscr = lds + 1024 + wave * 1024;
    const int h = wave >> 1;
    __syncthreads();
    float mixed[4] = {0.f, 0.f, 0.f, 0.f};
#pragma unroll 8
    for (int rg = 0; rg < 16; ++rg) { const float* pk = mixp + ((size_t)(b * 16 + rg) * 4) * 512 + c;
#pragma unroll
        for (int i = 0; i < 4; ++i) mixed[i] += pk[i * 512]; }
    float o4[4], sq[4];
#pragma unroll
    for (int i = 0; i < 4; ++i) { o4[i] = pg8::gelu_tanh(zup[((size_t)b * 4 + i) * 512 + c]) * (mixed[i] + bs[h * 128 + i]); sq[i] = o4[i] * o4[i]; }
    block_sum4(wscr, PW, sq, wave, lane);
    const float og = out_g[c];
#pragma unroll
    for (int i = 0; i < 4; ++i) ab32[(size_t)(b * 4 + i) * D + c] = o4[i] * (1.0f / sqrtf(sq[i] * (1.0f / 512.0f) + EPS)) * og;
    __syncthreads();
}

constexpr int G_ROW = 144;
constexpr int G_QE = 0, G_KE = 9216, G_KDT = 18432, G_VT = 27648, G_P = 46080, G_SEG = 55296, G_SC = 57344, G_SCR = 57600, G_HROW = 65536, G_PART = 81920  , G_WSCR = 131072  , G_PSS = 139264;
constexpr int HP_R = 4;
__device__ __forceinline__ float log_sigmoid(float p) { return fminf(p, 0.f) - __logf(1.0f + __expf(-fabsf(p))); }
__device__ __forceinline__ void gla1_unit(LAS unsigned char* lds, const float* hsrc, const float* Win32, const float* pre_g, const float* gla_og, float* ab32, const bf16* z, const float* gate_b, bf16* qe_g, bf16* oi_g, float* upd_g, float* dec_g, int unit, int tid) {
    const int lane = tid & 63, wave = __builtin_amdgcn_readfirstlane(tid >> 6), x = lane & 15, g = lane >> 4;
    const int cidx = unit >> 2, h = unit & 3;
    const size_t rbase = (size_t)cidx * 64;
    const int sidx = ((cidx >> 7) * 4 + h) * 128 + (cidx & 127);
    LAS float* SEG = (LAS float*)(lds + G_SEG);
    float c[8], qv[8], kv[8];
    {
        const float gb = gate_b[h * 64 + lane];
        float run = 0.f;
#pragma unroll
        for (int tt = 0; tt < 8; ++tt) {
            const bf16* zr = z + (rbase + 8 * wave + tt) * NZ;
            const float p = bf1(zr[ZP + h * 64 + lane]) + gb;
            qv[tt] = bf1(zr[ZQ + h * 64 + lane]); kv[tt] = bf1(zr[ZK + h * 64 + lane]);
            run += log_sigmoid(p) * (1.0f / 16.0f); c[tt] = run;
        }
        SEG[wave * 64 + lane] = run;
    }
    {
#pragma unroll
        for (int e = 0; e < 2; ++e) { const int v = lane + 64 * e; float t[8];
#pragma unroll
            for (int tt = 0; tt < 8; ++tt) t[tt] = bf1(z[(rbase + 8 * wave + tt) * NZ + ZVB + h * 128 + v]);
            *(LAS v4u*)(lds + G_VT + ((v & 7) * 16 + (v >> 3)) * G_ROW + 16 * wave) = pack8(t); }
    }
    const bool hp = ((cidx & 127) == 0);
    __syncthreads();
    float vf[HP_R][2] = {{0.f, 0.f}, {0.f, 0.f}, {0.f, 0.f}, {0.f, 0.f}}, gf[HP_R][2] = {{0.f, 0.f}, {0.f, 0.f}, {0.f, 0.f}, {0.f, 0.f}};
    if (hp && wave == 0) {
#pragma unroll
        for (int tt = 0; tt < HP_R; ++tt) { const float* qr = hsrc   + (size_t)((cidx >> 7) * 4 + tt) * 1536;
            qv[tt] = qr[h * 64 + lane] * 0.125f; kv[tt] = qr[256 + h * 64 + lane];
            vf[tt][0] = qr[512 + h * 128 + lane]; vf[tt][1] = qr[512 + h * 128 + lane + 64]; gf[tt][0] = qr[1024 + h * 128 + lane]; gf[tt][1] = qr[1024 + h * 128 + lane + 64]; }
    }
    {
        float off = 0.f, tot = 0.f;
#pragma unroll
        for (int w2 = 0; w2 < 8; ++w2) { const float s = SEG[w2 * 64 + lane]; tot += s; if (w2 < wave) off += s; }
        if (wave == 0) dec_g[(size_t)sidx * 64 + lane] = __expf(tot);
        float kd[8];
#pragma unroll
        for (int tt = 0; tt < 8; ++tt) {
            const float cum = off + c[tt]; const int t = 8 * wave + tt;
            const float qe = qv[tt] * __expf(cum), ke = kv[tt] * __expf(-cum); kd[tt] = kv[tt] * __expf(tot - cum);
            const bf16 qb = (bf16)f2bf(qe);
            *(LAS bf16*)(lds + G_QE + t * G_ROW + 2 * lane) = qb;
            *(LAS bf16*)(lds + G_KE + t * G_ROW + 2 * lane) = (bf16)f2bf(ke);
            qe_g[(rbase + t) * 256 + h * 64 + lane] = qb;
        }
        *(LAS v4u*)(lds + G_KDT + lane * G_ROW + 16 * wave) = pack8(kd);
        if (hp && wave == 0) {
            float qf[HP_R], kf[HP_R];
#pragma unroll
            for (int tt = 0; tt < HP_R; ++tt) { const float cum = off + c[tt]; qf[tt] = qv[tt] * __expf(cum); kf[tt] = kv[tt] * __expf(-cum); }
            float s0[4] = {qf[0] * kf[0], qf[1] * kf[0], qf[1] * kf[1], qf[2] * kf[0]};
            float s1[4] = {qf[2] * kf[1], qf[2] * kf[2], qf[3] * kf[0], qf[3] * kf[1]};
            float s2[4] = {qf[3] * kf[2], qf[3] * kf[3], 0.f, 0.f};
            wave_sum4_lds(lds + G_SCR, s0, lane); wave_sum4_lds(lds + G_SCR, s1, lane); wave_sum4_lds(lds + G_SCR, s2, lane);
            if (lane == 0) { LAS float* SC = (LAS float*)(lds + G_SC);
                SC[0] = s0[0]; SC[1] = 0.f; SC[2] = 0.f; SC[3] = 0.f;
                SC[4] = s0[1]; SC[5] = s0[2]; SC[6] = 0.f; SC[7] = 0.f;
                SC[8] = s0[3]; SC[9] = s1[0]; SC[10] = s1[1]; SC[11] = 0.f;
                SC[12] = s1[2]; SC[13] = s1[3]; SC[14] = s2[0]; SC[15] = s2[1]; }
            float o[HP_R][2];
#pragma unroll
            for (int e = 0; e < 2; ++e) {
                o[0][e] = s0[0] * vf[0][e];
                o[1][e] = s0[1] * vf[0][e] + s0[2] * vf[1][e];
                o[2][e] = s0[3] * vf[0][e] + s1[0] * vf[1][e] + s1[1] * vf[2][e];
                o[3][e] = s1[2] * vf[0][e] + s1[3] * vf[1][e] + s2[0] * vf[2][e] + s2[1] * vf[3][e]; }
            float so[4];
#pragma unroll
            for (int i = 0; i < HP_R; ++i) so[i] = o[i][0] * o[i][0] + o[i][1] * o[i][1];
            wave_sum4_lds(lds + G_SCR, so, lane);
#pragma unroll
            for (int i = 0; i < HP_R; ++i) { const float rs = 1.0f / sqrtf(so[i] * (1.0f / 128.0f) + EPS);
#pragma unroll
                for (int e = 0; e < 2; ++e) { const float zg = gf[i][e]; const float sg = zg / (1.0f + __expf(-zg));
                    ab32[(size_t)((cidx >> 7) * 4 + i) * D + 512 + h * 128 + lane + 64 * e] = o[i][e] * rs * gla_og[h * 128 + lane + 64 * e] * sg; } }
        }
    }
    __syncthreads();
    {
        const int it = wave >> 1;
#pragma unroll
        for (int jj = 0; jj < 2; ++jj) {
            const int jt = 2 * (wave & 1) + jj;
            f32x4 s = (f32x4){0.f, 0.f, 0.f, 0.f};
            if (jt <= it) {
                bf16x8 a[2], b[2];
#pragma unroll
                for (int ks = 0; ks < 2; ++ks) {
                    a[ks] = *(const LAS bf16x8*)(lds + G_QE + (16 * it + x) * G_ROW + (ks * 32 + 8 * g) * 2);
                    b[ks] = *(const LAS bf16x8*)(lds + G_KE + (16 * jt + x) * G_ROW + (ks * 32 + 8 * g) * 2); }
                FRAG_WAIT();
                s = MFMA16(a[0], b[0], s); s = MFMA16(a[1], b[1], s);
            }
#pragma unroll
            for (int r = 0; r < 4; ++r) { const int i = 16 * it + 4 * g + r, j = 16 * jt + x;
                float sv = (j <= i) ? s[r] : 0.f;
                if (hp && i < HP_R && j < HP_R) sv = ((const LAS float*)(lds + G_SC))[i * 4 + j];
                *(LAS bf16*)(lds + G_P + i * G_ROW + 2 * j) = (bf16)f2bf(sv); }
        }
    }
    __syncthreads();
    if (wave < 4) {
        f32x4 acc[8];
#pragma unroll
        for (int vt = 0; vt < 8; ++vt) acc[vt] = (f32x4){0.f, 0.f, 0.f, 0.f};
        {
            bf16x8 a[2], b[2][8];
#pragma unroll
            for (int ks = 0; ks < 2; ++ks) {
                a[ks] = *(const LAS bf16x8*)(lds + G_P + (16 * wave + x) * G_ROW + (ks * 32 + 8 * g) * 2);
#pragma unroll
                for (int vt = 0; vt < 8; ++vt) b[ks][vt] = *(const LAS bf16x8*)(lds + G_VT + (vt * 16 + x) * G_ROW + (ks * 32 + 8 * g) * 2); }
            FRAG_WAIT();
#pragma unroll
            for (int ks = 0; ks < 2; ++ks)
#pragma unroll
                for (int vt = 0; vt < 8; ++vt) acc[vt] = MFMA16(a[ks], b[ks][vt], acc[vt]);
        }
#pragma unroll
        for (int r = 0; r < 4; ++r) { float t[8];
#pragma unroll
            for (int vt = 0; vt < 8; ++vt) t[vt] = acc[vt][r];
            *(v4u*)(oi_g + (rbase + 16 * wave + 4 * g + r) * 512 + h * 128 + 8 * x) = pack8(t); }
    } else {
        const int w2 = wave - 4;
        f32x4 acc[2][4];
#pragma unroll
        for (int a = 0; a < 2; ++a)
#pragma unroll
            for (int dt = 0; dt < 4; ++dt) acc[a][dt] = (f32x4){0.f, 0.f, 0.f, 0.f};
        {
            bf16x8 b[2][4], av[2][2];
#pragma unroll
            for (int ks = 0; ks < 2; ++ks) {
#pragma unroll
                for (int dt = 0; dt < 4; ++dt) b[ks][dt] = *(const LAS bf16x8*)(lds + G_KDT + (16 * dt + x) * G_ROW + (ks * 32 + 8 * g) * 2);
#pragma unroll
                for (int a = 0; a < 2; ++a) av[ks][a] = *(const LAS bf16x8*)(lds + G_VT + (16 * (2 * w2 + a) + x) * G_ROW + (ks * 32 + 8 * g) * 2); }
            FRAG_WAIT();
#pragma unroll
            for (int ks = 0; ks < 2; ++ks)
#pragma unroll
                for (int a = 0; a < 2; ++a)
#pragma unroll
                    for (int dt = 0; dt < 4; ++dt) acc[a][dt] = MFMA16(av[ks][a], b[ks][dt], acc[a][dt]);
        }
#pragma unroll
        for (int a = 0; a < 2; ++a)
#pragma unroll
            for (int dt = 0; dt < 4; ++dt)
#pragma unroll
                for (int r = 0; r < 4; ++r) { const int v = 8 * (4 * g + r) + (2 * w2 + a); upd_g[(size_t)sidx * 8192 + v * 64 + 16 * dt + x] = acc[a][dt][r]; }
    }
    __syncthreads();
}

__device__ __forceinline__ void gla_scan(const float* __restrict__ upd_g, const float* __restrict__ dec_g, bf16* __restrict__ sp_g, int gtid, int ngt) {
    for (int e = gtid; e < 16 * 8192; e += ngt) {
        const int bh = e >> 13, off = e & 8191, d = off & 63;
        float S = 0.f;
#pragma unroll 16
        for (int n = 0; n < 128; ++n) {
            const size_t s = (size_t)bh * 128 + n;
            const float u = upd_g[s * 8192 + off], dc = dec_g[s * 64 + d];
            sp_g[s * 8192 + off] = (bf16)f2bf(S);
            S = dc * S + u;
        }
    }
}

__device__ __forceinline__ void gla3_unit(LAS unsigned char* scr, const bf16* z, const bf16* qe_g, const bf16* oi_g, const bf16* sp_g, const float* out_g, bf16* ab, int unit, int it, int lane) {
    const int x = lane & 15, g = lane >> 4;
    const int cidx = unit >> 2, h = unit & 3;
    const size_t rbase = (size_t)cidx * 64;
    const int sidx = ((cidx >> 7) * 4 + h) * 128 + (cidx & 127);
    f32x4 acc[8];
#pragma unroll
    for (int vt = 0; vt < 8; ++vt) acc[vt] = (f32x4){0.f, 0.f, 0.f, 0.f};
    {
        bf16x8 a[2], b[2][8];
#pragma unroll
        for (int ks = 0; ks < 2; ++ks) {
            a[ks] = *(const bf16x8*)(qe_g + (rbase + 16 * it + x) * 256 + h * 64 + ks * 32 + 8 * g);
#pragma unroll
            for (int vt = 0; vt < 8; ++vt) b[ks][vt] = *(const bf16x8*)(sp_g + (size_t)sidx * 8192 + (8 * x + vt) * 64 + ks * 32 + 8 * g); }
        FRAG_WAIT();
#pragma unroll
        for (int ks = 0; ks < 2; ++ks)
#pragma unroll
            for (int vt = 0; vt < 8; ++vt) acc[vt] = MFMA16(a[ks], b[ks][vt], acc[vt]);
    }
    const f32x4 ga = *(const f32x4*)(out_g + h * 128 + 8 * x), gb = *(const f32x4*)(out_g + h * 128 + 8 * x + 4);
    const float gg[8] = {ga.x, ga.y, ga.z, ga.w, gb.x, gb.y, gb.z, gb.w};
    float ss[4];
#pragma unroll
    for (int r = 0; r < 4; ++r) {
        const size_t row = rbase + 16 * it + 4 * g + r;
        float oi[8]; unpack8(*(const v4u*)(oi_g + row * 512 + h * 128 + 8 * x), oi);
        float s = 0.f;
#pragma unroll
        for (int vt = 0; vt < 8; ++vt) { const float o = acc[vt][r] + oi[vt]; acc[vt][r] = o; s += o * o; }
        ss[r] = s;
    }
    row16_sum4_lds(scr, ss, lane);
#pragma unroll
    for (int r = 0; r < 4; ++r) {
        const size_t row = rbase + 16 * it + 4 * g + r;
        float zg[8]; unpack8(*(const v4u*)(z + row * NZ + ZG + h * 128 + 8 * x), zg);
        const float rstd = 1.0f / sqrtf(ss[r] * (1.0f / 128.0f) + EPS);
        float t[8];
#pragma unroll
        for (int vt = 0; vt < 8; ++vt) { const float sg = zg[vt] / (1.0f + __expf(-zg[vt])); t[vt] = acc[vt][r] * rstd * gg[vt] * sg; }
        *(v4u*)(ab + row * D + 512 + h * 128 + 8 * x) = pack8(t);
    }
}


#define RLX_AGENT __ATOMIC_RELAXED, __HIP_MEMORY_SCOPE_AGENT
constexpr int CW_BAR = 4096;
constexpr size_t CTL_ZERO_BYTES = 65536;
constexpr int LDS_MISC_OFF = LDS_BYTES - 64;
#define XB_TMO      128
#define XB_XCNT(j)  (256  + 64 * (j))
#define XB_XSUB(j)  (1280 + 64 * (j))
#define XB_XGEN(j)  (2304 + 64 * (j))
#define XB_TOP      3328
#define XB_TOPGEN   3392
#define XCD_BAR_WORDS 3456
#define XB_SPIN_CAP (1u << 18)

__device__ __forceinline__ unsigned xb_ld(unsigned* p)              { return __hip_atomic_load(p, __ATOMIC_RELAXED, __HIP_MEMORY_SCOPE_AGENT); }
__device__ __forceinline__ unsigned xb_add(unsigned* p, unsigned v) { return __hip_atomic_fetch_add(p, v, __ATOMIC_RELAXED, __HIP_MEMORY_SCOPE_AGENT); }
__device__ __forceinline__ unsigned xb_xcc_id() { return (unsigned)__builtin_amdgcn_s_getreg((3 << 11) | 20) & 0xFu; }
#define XB_SPIN(cond, bar) do { unsigned _sp = 0; while (cond) { __builtin_amdgcn_s_sleep(1); \
    if ((++_sp & 255u) == 0u) { if (xb_ld(&(bar)[XB_TMO])) break; if (_sp > XB_SPIN_CAP) { atomicAdd(&(bar)[XB_TMO], 1u); break; } } } } while (0)

struct XcdBarrier {
    unsigned* bar; unsigned x;
    volatile LAS unsigned* st;
};

__device__ __forceinline__ XcdBarrier xcd_barrier_post(unsigned* bar, volatile LAS unsigned* st) {
    XcdBarrier b; b.bar = bar; b.x = xb_xcc_id(); b.st = st;
    if (threadIdx.x == 0) (void)xb_add(&bar[XB_XCNT(b.x)], 1u);
    return b;
}
__device__ __forceinline__ void xcd_barrier_complete(unsigned* bar, unsigned x, unsigned& nloc, unsigned& nx) {
    const unsigned G = gridDim.x * gridDim.y * gridDim.z;
    unsigned sum, cnt, mine, sp = 0u;
    for (;;) {
        sum = 0u; cnt = 0u; mine = 0u;
#pragma unroll
        for (unsigned j = 0; j < 16; ++j) { const unsigned c = xb_ld(&bar[XB_XCNT(j)]); sum += c; cnt += (c > 0u) ? 1u : 0u; mine = (j == x) ? c : mine; }
        if (sum == G) break;
        __builtin_amdgcn_s_sleep(1);
        if ((++sp & 255u) == 0u) { if (xb_ld(&bar[XB_TMO])) break; if (sp > XB_SPIN_CAP) { atomicAdd(&bar[XB_TMO], 1u); break; } }
    }
    nloc = mine > 0u ? mine : 1u; nx = cnt > 0u ? cnt : 1u;
}

__device__ __forceinline__ void xcd_barrier(const XcdBarrier& b) {
    asm volatile("s_waitcnt vmcnt(0)" ::: "memory");
    __syncthreads();
    if (threadIdx.x == 0) {
        unsigned* bar = b.bar;
        __builtin_amdgcn_s_waitcnt(0);
        unsigned nloc = b.st[0], nx = b.st[1];
        if (nloc == 0u) { xcd_barrier_complete(bar, b.x, nloc, nx); b.st[0] = nloc; b.st[1] = nx; }
        const unsigned old = xb_add(&bar[XB_XSUB(b.x)], 1u);
        const unsigned gen = old / nloc;
        if (old + 1u == (gen + 1u) * nloc) {
            __builtin_amdgcn_fence(__ATOMIC_RELEASE, "agent");
            asm volatile("s_waitcnt vmcnt(0)" ::: "memory");
            const unsigned og = xb_add(&bar[XB_TOP], 1u);
            const unsigned tg = og / nx;
            if (og + 1u == (tg + 1u) * nx) xb_add(&bar[XB_TOPGEN], 1u);
            else XB_SPIN(xb_ld(&bar[XB_TOPGEN]) == tg, bar);
            __builtin_amdgcn_fence(__ATOMIC_ACQUIRE, "agent");
            xb_add(&bar[XB_XGEN(b.x)], 1u);
            asm volatile("s_waitcnt vmcnt(0)" ::: "memory");
        } else {
            XB_SPIN(xb_ld(&bar[XB_XGEN(b.x)]) == gen, bar);
            __builtin_amdgcn_fence(__ATOMIC_ACQUIRE, "agent");
            asm volatile("s_waitcnt vmcnt(0)" ::: "memory");
        }
    }
    __syncthreads();
}

#ifndef STOP_AT
#define STOP_AT 0
#endif
#define DUMP_BF16(src, ncol_src, coff) do { xcd_barrier(bar); for (size_t i_ = (size_t)bid * NTHR + threadIdx.x; i_ < (size_t)M * D; i_ += (size_t)G * NTHR) { const size_t r_ = i_ >> 10, c_ = i_ & 1023; out[i_] = bf1((src)[r_ * (ncol_src) + (coff) + c_]); } return; } while (0)
#ifndef GMLP_DBG
#define GMLP_DBG 0
#endif
#ifndef DUP_GEMM
#define DUP_GEMM 0
#endif
#ifndef DUP_MASK
#define DUP_MASK 0
#endif
#ifndef SEAM_REPEAT
#define SEAM_REPEAT 1
#endif
#define SEAM() xcd_barrier(bar)
struct Args { const float* in[17]; float* out; unsigned char* ws; int ph_lo, ph_hi; };
__global__ void __launch_bounds__(NTHR, 2) fwd_megakernel(Args args) {
    extern __shared__ __attribute__((aligned(16))) unsigned char lds_raw[];
    cg::grid_group grid = cg::this_grid();
    LAS unsigned char* lds = (LAS unsigned char*)lds_raw;
    const int G = gridDim.x, bid = blockIdx.x, ngw = G * NWAVES;
    volatile LAS unsigned* MISC = (volatile LAS unsigned*)(lds + LDS_MISC_OFF);
    if (threadIdx.x < 16) MISC[threadIdx.x] = 0u;
    __syncthreads();
    XcdBarrier bar = xcd_barrier_post((unsigned*)(args.ws) + CW_BAR, MISC);
    grid.sync();
#define PHASE_IDS() int tid = threadIdx.x; asm volatile("" : "+v"(tid)); const int lane = tid & 63, wave = __builtin_amdgcn_readfirstlane(tid >> 6), gw = bid * NWAVES + wave; (void)lane; (void)gw
    unsigned char* ws = args.ws;
    const float* x = args.in[0];
    float* out = args.out;
    bf16* Wm = (bf16*)(ws + WS_WM);
    float* dec_g = (float*)(ws + WS_DEC);
    bf16* zb = (bf16*)(ws + WS_Z); bf16* f1 = (bf16*)(ws + WS_F1); bf16* ab = (bf16*)(ws + WS_AB); bf16* qe_g = (bf16*)(ws + WS_QE);
    bf16* yb = (bf16*)(ws + WS_Y); bf16* sp_g = (bf16*)(ws + WS_SP); bf16* oi_g = (bf16*)(ws + WS_OI); bf16* mmb = (bf16*)(ws + WS_MM); float* upd_g = (float*)(ws + WS_UPD);

    float* M32 = (float*)(ws + WS_HP); float* Y32 = M32 + 16 * 1024; float* F1_32 = Y32 + 16 * 1024; float* F32o = F1_32 + 16 * 4096; float* AB32 = F32o + 16 * 1024; float* HPP = (float*)(ws + WS_HP + 2 * MiB); float* HPU = (float*)(ws + WS_HP + 11 * MiB); float* YH32 = (float*)(ws + WS_HP + 1 * MiB); float* QKVG32 = YH32 + 16 * 1024; float* MIXP = (float*)(ws + WS_HP + 12 * MiB); float* ZUP = (float*)(ws + WS_HP + 13 * MiB);
    {
        PHASE_IDS();
        LAS float* scr = (LAS float*)(lds + wave * 16384);
        constexpr int I_IN = 16 * 80, I_OUT = 16 * 32, I_1 = 16 * 128, I_2 = 64 * 32, I_G = 512, I_L = I_IN + I_OUT + I_1 + I_2 + I_G;
        for (int it = gw; it < DEPTH * I_L; it += ngw) {
            const int l = it / I_L; int r = it % I_L;
            bf16* WinT = (bf16*)(ws + WS_W + l * W_LAYER_B); bf16* WoutT = (bf16*)(ws + WS_W + l * W_LAYER_B + W_IN_B); bf16* W1T = (bf16*)(ws + WS_W + l * W_LAYER_B + W_IN_B + W_OUT_B); bf16* W2T = (bf16*)(ws + WS_W + l * W_LAYER_B + W_IN_B + W_OUT_B + W_1_B);
            const float* w_in = args.in[2] + (size_t)l * D * D_IN; const float* pre_g = args.in[1] + l * D;
            if (r < I_IN) { p0_transpose_item(w_in, D_IN, 2560, D, WinT, pre_g, ZQ, ZK, scr, r, lane); continue; } r -= I_IN;
            if (r < I_OUT) { p0_transpose_item(args.in[11] + (size_t)l * D * D, D, D, D, WoutT, nullptr, 0, 0, scr, r, lane); continue; } r -= I_OUT;
            if (r < I_1) { p0_transpose_item(args.in[14] + (size_t)l * D * FF, FF, FF, D, W1T, args.in[13] + l * D, 0, 0, scr, r, lane); continue; } r -= I_1;
            if (r < I_2) { p0_transpose_item(args.in[15] + (size_t)l * FF * D, D, D, FF, W2T, nullptr, 0, 0, scr, r, lane); continue; } r -= I_2;
            p0_gate_item(w_in, args.in[8] + (size_t)l * 16 * 256, pre_g, WinT, r, lane);
        }
        const float* wsrc = args.in[5];
        for (int i = bid * NTHR + tid; i < DEPTH * 4 * 128 * 128; i += G * NTHR) { const int ii = (i >> 7) & 127, jj = i & 127; Wm[i] = ((ii >> 6) >= (jj >> 6)) ? (bf16)f2bf(wsrc[i]) : (bf16)0; }
        rows_phase(lds + wave * 16384, x, nullptr, nullptr, nullptr, yb, gw, ngw, lane, nullptr, YH32, args.in[1]);
    }
    SEAM();

#pragma unroll 1
    for (int l = 0; l < DEPTH; ++l) {
        const bf16* WinT = (const bf16*)(ws + WS_W + l * W_LAYER_B); const bf16* WoutT = (const bf16*)(ws + WS_W + l * W_LAYER_B + W_IN_B);
        const bf16* W1T = (const bf16*)(ws + WS_W + l * W_LAYER_B + W_IN_B + W_OUT_B); const bf16* W2T = (const bf16*)(ws + WS_W + l * W_LAYER_B + W_IN_B + W_OUT_B + W_1_B);
        { PHASE_IDS(); pg8::Gemm gm{yb, WinT, M, NZ, D}; pg8::StaticOrder S; S.init(M, NZ, G, bid); pg8::EpiAct<1> E{zb, NZ, 4};
          pg8::gemm_phase<pg8::EpiAct<1>, pg8::StaticOrder, true, true>(lds, gm, S, E, tid);
          hp_gemv_phase<0>(lds, YH32, D, args.in[2] + (size_t)l * D * D_IN + ZQ, D_IN, 1536, QKVG32, G, (G == 256) ? ((bid + 128) & 255) : bid, wave, lane, tid); }
        SEAM();
        if (STOP_AT == 1) DUMP_BF16(zb, NZ, 0);
        if (STOP_AT == 2) DUMP_BF16(zb, NZ, 1792);
        if (STOP_AT == 30) {
            const int lane_ = threadIdx.x & 63, wave_ = threadIdx.x >> 6;
            for (int u = bid; u < M / 128; u += G)
                for (int t_ = 0; t_ < 16; ++t_) { const size_t row_ = (size_t)u * 128 + 16 * wave_ + t_;
                    *(v4u*)(ab + row_ * D + 8 * lane_) = *(const v4u*)(zb + row_ * NZ + ZV + 8 * lane_); }
            xcd_barrier(bar); for (size_t i_ = (size_t)bid * NTHR + threadIdx.x; i_ < (size_t)M * D; i_ += (size_t)G * NTHR) { const size_t r_ = i_ >> 10, c_ = i_ & 511; out[i_] = bf1(ab[r_ * D + c_]); } return; }
        { PHASE_IDS();
        for (int u = bid; u < M / 128; u += G)
            gmlp_unit(lds, AB32, zb, ab, Wm + (size_t)l * 4 * 16384, args.in[3] + l * 512, args.in[4] + l * 512, args.in[6] + l * 512, args.in[7] + l * 512, u, tid);
        if (STOP_AT == 14) { xcd_barrier(bar); for (size_t i_ = (size_t)bid * NTHR + threadIdx.x; i_ < (size_t)M * D; i_ += (size_t)G * NTHR) { out[i_] = bf1(Wm[i_ & 262143]); } return; }
        if (STOP_AT >= 20 && STOP_AT < 24) { xcd_barrier(bar); for (size_t i_ = (size_t)bid * NTHR + threadIdx.x; i_ < (size_t)M * D; i_ += (size_t)G * NTHR) { const size_t r_ = i_ >> 10, c_ = i_ & 127; out[i_] = bf1(ab[r_ * D + (STOP_AT - 20) * 128 + c_]); } return; }
        if (STOP_AT == 13) { xcd_barrier(bar); for (size_t i_ = (size_t)bid * NTHR + threadIdx.x; i_ < (size_t)M * D; i_ += (size_t)G * NTHR) { const size_t r_ = i_ >> 10, c_ = i_ & 511; out[i_] = bf1(ab[r_ * D + c_]); } return; }
        }
        { PHASE_IDS();
        for (int t = bid; t < 256; t += G) gmlp_hp1(lds, l == 0 ? x : out, args.in[2] + (size_t)l * D * D_IN, args.in[1] + l * D, HPP, HPU, t >> 6, (t >> 2) & 15, t & 3, tid);
        }
        { PHASE_IDS();
        for (int ui = 0; ui * G < NCHUNK * 4; ++ui) { const int u = (G == 256) ? (256 * ui + ((bid + 4 * ui) & 255)) : (ui * G + bid); if (u >= NCHUNK * 4) break;
            gla1_unit(lds, QKVG32, args.in[2] + (size_t)l * D * D_IN, args.in[1] + l * D, args.in[10] + l * 512, AB32, zb, args.in[9] + l * 256, qe_g, oi_g, upd_g, dec_g, u, tid); } }
        SEAM();
        { PHASE_IDS(); gla_scan(upd_g, dec_g, sp_g, bid * NTHR + tid, G * NTHR); }
        { PHASE_IDS();
          for (int t = bid; t < 64; t += G) gmlp_hp2a(lds, l == 0 ? x : out, args.in[5] + (size_t)l * 4 * 16384, args.in[3] + l * 512, args.in[4] + l * 512, HPP, HPU, MIXP, ZUP, t >> 4, t & 15, tid); }
        SEAM();
        { PHASE_IDS();
        for (int pu = bid; pu < NCHUNK * 2; pu += G)
            gla3_unit(lds + wave * 1024, zb, qe_g, oi_g, sp_g, args.in[10] + l * 512, ab, 2 * pu + (wave >> 2), wave & 3, lane); }
        { PHASE_IDS();
          for (int b4 = bid; b4 < BATCH; b4 += G) gmlp_hp2b(lds, args.in[6] + l * 512, args.in[7] + l * 512, MIXP, ZUP, AB32, b4, tid); }
        SEAM();
        if (STOP_AT == 3) DUMP_BF16(ab, D, 0);
        if (STOP_AT == 8) { xcd_barrier(bar); for (size_t i_ = (size_t)bid * NTHR + threadIdx.x; i_ < (size_t)M * D; i_ += (size_t)G * NTHR) { const size_t r_ = i_ >> 10, c_ = i_ & 511; out[i_] = bf1(ab[r_ * D + c_]); } return; }
        if (STOP_AT == 9) { xcd_barrier(bar); for (size_t i_ = (size_t)bid * NTHR + threadIdx.x; i_ < (size_t)M * D; i_ += (size_t)G * NTHR) { const size_t r_ = i_ >> 10, c_ = i_ & 511; out[i_] = bf1(ab[r_ * D + 512 + c_]); } return; }
        if (STOP_AT == 10) { xcd_barrier(bar); for (size_t i_ = (size_t)bid * NTHR + threadIdx.x; i_ < (size_t)M * D; i_ += (size_t)G * NTHR) { const size_t r_ = i_ >> 10, c_ = i_ & 511; out[i_] = bf1(oi_g[r_ * 512 + c_]); } return; }
        if (STOP_AT == 11) { xcd_barrier(bar); for (size_t i_ = (size_t)bid * NTHR + threadIdx.x; i_ < (size_t)M * D; i_ += (size_t)G * NTHR) { out[i_] = bf1(sp_g[i_ & (size_t)(2048 * 8192 - 1)]); } return; }
        if (STOP_AT == 12) { xcd_barrier(bar); for (size_t i_ = (size_t)bid * NTHR + threadIdx.x; i_ < (size_t)M * D; i_ += (size_t)G * NTHR) { out[i_] = upd_g[i_ & (size_t)(2048 * 8192 - 1)]; } return; }
        { PHASE_IDS(); pg8::Gemm gm{ab, WoutT, M, D, D}; pg8::StaticOrder S; S.init(M, D, G, bid); pg8::EpiAct<0> E{mmb, D, 0};
          pg8::gemm_phase<pg8::EpiAct<0>, pg8::StaticOrder, true, true>(lds, gm, S, E, tid);
          hp_gemv_phase<0>(lds, AB32, D, args.in[11] + (size_t)l * D * D, D, D, M32, G, bid, wave, lane, tid); }
        SEAM();
        if (STOP_AT == 4) DUMP_BF16(mmb, D, 0);
        { PHASE_IDS(); rows_phase(lds + wave * 1024, l == 0 ? x : out, mmb, args.in[12] + l * D, nullptr, yb, gw, ngw, lane, M32, Y32, args.in[13] + l * D); }
        SEAM();
        if (STOP_AT == 5) DUMP_BF16(yb, D, 0);
        { PHASE_IDS(); pg8::Gemm gm{yb, W1T, M, FF, D}; pg8::StaticOrder S; S.init(M, FF, G, bid); pg8::EpiAct<2> E{f1, FF, 0};
          pg8::gemm_phase<pg8::EpiAct<2>, pg8::StaticOrder, true, true>(lds, gm, S, E, tid);
          hp_gemv_phase<2>(lds, Y32, D, args.in[14] + (size_t)l * D * FF, FF, FF, F1_32, G, bid, wave, lane, tid); }
        SEAM();
        { PHASE_IDS(); pg8::Gemm gm{f1, W2T, M, D, FF}; pg8::StaticOrder S; S.init(M, D, G, bid); pg8::EpiAct<0> E{yb, D, 0};
          pg8::gemm_phase<pg8::EpiAct<0>, pg8::StaticOrder, true, true>(lds, gm, S, E, tid);
          hp_gemv_phase<0>(lds, F1_32, FF, args.in[15] + (size_t)l * FF * D, D, D, F32o, G, bid, wave, lane, tid); }
        SEAM();
        if (STOP_AT == 6) DUMP_BF16(mmb, D, 0);
        if (STOP_AT == 7) DUMP_BF16(f1, FF, 0);
        { PHASE_IDS(); rows_phase(lds + wave * 1024, l == 0 ? x : out, mmb, args.in[12] + l * D, out, (l + 1 < DEPTH) ? yb : nullptr, gw, ngw, lane, M32, YH32, args.in[1] + (l + 1 < DEPTH ? l + 1 : l) * D, yb, args.in[16] + l * D, F32o); }
        if (l + 1 < DEPTH) SEAM();
    }
}

extern "C" void kernel_launch(void* const* d_in, const int* in_sizes, int n_in, void* d_out, int out_size, void* d_ws, size_t ws_size, hipStream_t stream) {
    static int grid = 0;
    if (grid == 0) {
        if (n_in != 17 || out_size != M * D || ws_size < WS_END) { fprintf(stderr, "kernel_launch: unexpected problem (n_in %d, out %d, ws %zu)\n", n_in, out_size, ws_size); grid = -1; return; }
        int dev = 0, cus = 0, per_cu = 0;
        hipGetDevice(&dev); hipDeviceGetAttribute(&cus, hipDeviceAttributeMultiprocessorCount, dev);
        hipFuncSetAttribute((const void*)fwd_megakernel, hipFuncAttributeMaxDynamicSharedMemorySize, LDS_BYTES);
        if (hipOccupancyMaxActiveBlocksPerMultiprocessor(&per_cu, (const void*)fwd_megakernel, NTHR, LDS_BYTES) != hipSuccess || per_cu < 1) per_cu = 1;
        (void)hipGetLastError();
        grid = cus * per_cu;
    }
    if (grid < 0) return;
    if (hipMemsetAsync(d_ws, 0, CTL_ZERO_BYTES, stream) != hipSuccess) { fprintf(stderr, "kernel_launch: memset failed\n"); return; }
    Args a{};
    for (int i = 0; i < 17; ++i) a.in[i] = (const float*)d_in[i];
    a.out = (float*)d_out; a.ws = (unsigned char*)d_ws; a.ph_lo = 0; a.ph_hi = 0;
    void* kargs[] = {&a};
    hipError_t e = hipLaunchCooperativeKernel((const void*)fwd_megakernel, dim3(grid), dim3(NTHR), kargs, LDS_BYTES, stream);
    if (e != hipSuccess) fprintf(stderr, "cooperative launch failed: %s (grid %d)\n", hipGetErrorString(e), grid);
}
```

```cpp
#include <hip/hip_runtime.h>
#include <hip/hip_cooperative_groups.h>
#include <cstdio>
#include <cstdint>
namespace cg = cooperative_groups;
namespace pg8 {
#define PG8_LAS __attribute__((address_space(3)))
typedef unsigned short bf16_t;
typedef short bf16x8 __attribute__((ext_vector_type(8)));
typedef float f32x4 __attribute__((ext_vector_type(4)));
typedef unsigned u32x4 __attribute__((ext_vector_type(4)));
constexpr int BM = 256, BK = 64, HALF = 128, HTB = HALF * BK * 2  , STAGE_BYTES = 8 * HTB, NXCD = 8, WGM = 8;

__host__ __device__ __forceinline__ int lds_byte(int r, int c) { const int st = (r >> 4) * 2 + (c >> 5), rr = r & 15, cc = c & 31, ob = rr * 64 + cc * 2; return st * 1024 + (ob ^ (((ob >> 9) & 1) << 5)); }
__host__ __device__ __forceinline__ void stage_rc(int b, int& R, int& C) { const int st = b / 1024, sb = b % 1024, swz = sb ^ (((sb >> 9) & 1) << 5); R = (st >> 1) * 16 + swz / 64; C = (st & 1) * 32 + (swz % 64) / 2; }
__host__ __device__ __forceinline__ int perm32(int rho) { const int n = rho >> 4, i = rho & 15; return 8 * (i >> 2) + 4 * n + (i & 3); }

struct Unit { int pm, pn; };
struct Gemm { const bf16_t* A; const bf16_t* Bt; int M, N, K; };

struct StaticOrder {
    int nM, nN, nwg, G, c;
    __host__ __device__ void init(int M, int N, int G_, int c_) { nM = M / BM; nN = N / BM; nwg = nM * nN; G = G_; c = c_; }
    __host__ __device__ bool next(int i, Unit& u) const {
        const long L = (long)i * G + c; if (L >= nwg) return false;
        int wgid = (int)L; { const int q = nwg / NXCD, r = nwg % NXCD, xcd = wgid % NXCD, off = wgid / NXCD; wgid = (xcd < r ? xcd * (q + 1) : r * (q + 1) + (xcd - r) * q) + off; }
        const int nig = WGM * nN, gid = wgid / nig, fm = gid * WGM, gsz = (nM - fm) < WGM ? (nM - fm) : WGM;
        u.pm = fm + ((wgid % nig) % gsz); u.pn = (wgid % nig) / gsz; return true;
    }
    __device__ __forceinline__ void a_ready(const Unit&) const {}
    __device__ __forceinline__ void done(const Unit&) const {}
};

typedef __bf16 hwbf2e __attribute__((ext_vector_type(2)));
typedef float hwf2e __attribute__((ext_vector_type(2)));
__device__ __forceinline__ unsigned cvt_pk_bf16(float lo, float hi) { const hwf2e v = {lo, hi}; return __builtin_bit_cast(unsigned, __builtin_convertvector(v, hwbf2e)); }
__device__ __forceinline__ float gelu_tanh(float x) {
    const float u = x * (0.7978845608028654f + 0.035677408136300125f * x * x);
    const float e = __builtin_amdgcn_exp2f(u * -2.885390081777927f);
    return x * __builtin_amdgcn_rcpf(1.0f + e);
}
template <int ACT> struct EpiAct {
    static constexpr bool PERM = true, AFTER_DRAIN = false;
    bf16_t* O; int ldc; int act_tiles;
    __device__ __forceinline__ void operator()(const f32x4 (&acc)[2][2][4][2], const Unit& u, int wr, int wc, int fr, int fq) const {
        const int row0 = u.pm * BM + wr * 64 + fr; const int col0 = u.pn * BM + wc * 32 + 8 * fq;
        const bool act = (ACT == 1) ? (u.pn < act_tiles) : true;
#pragma unroll
        for (int ai = 0; ai < 2; ++ai)
#pragma unroll
            for (int m = 0; m < 4; ++m) { bf16_t* rowp = O + (size_t)(row0 + ai * HALF + m * 16) * ldc + col0;
#pragma unroll
                for (int bj = 0; bj < 2; ++bj) { f32x4 v0 = acc[ai][bj][m][0], v1 = acc[ai][bj][m][1];
                    if (ACT == 1) { if (act) {
#pragma unroll
                        for (int e = 0; e < 4; ++e) { v0[e] = gelu_tanh(v0[e]); v1[e] = gelu_tanh(v1[e]); } } }
                    if (ACT == 2) {
#pragma unroll
                        for (int e = 0; e < 4; ++e) { const float a = fmaxf(v0[e], 0.f), b = fmaxf(v1[e], 0.f); v0[e] = a * a; v1[e] = b * b; } }
                    u32x4 w; w.x = cvt_pk_bf16(v0[0], v0[1]); w.y = cvt_pk_bf16(v0[2], v0[3]); w.z = cvt_pk_bf16(v1[0], v1[1]); w.w = cvt_pk_bf16(v1[2], v1[3]);
                    *(u32x4*)(rowp + bj * HALF) = w; } }
    }
};

template <class Epi, class Sched, bool ALIGN_EPI = false, bool SP2 = false>
__device__ __forceinline__ void gemm_phase(PG8_LAS unsigned char* lds, const Gemm g, const Sched& S, const Epi& E, const int tid) {
    const int wid = __builtin_amdgcn_readfirstlane(tid >> 6), lane = tid & 63, wr = wid >> 2, wc = wid & 3, fr = lane & 15, fq = lane >> 4;
    const int K = g.K, nt = K / BK;
    unsigned voffA[2], voffB[2];
#pragma unroll
    for (int i = 0; i < 2; ++i) { int R, C; stage_rc(tid * 16 + i * 8192, R, C); const int Rb = Epi::PERM ? ((R & ~31) + perm32(R & 31)) : R;
        voffA[i] = (unsigned)(R * K + C) * 2u; voffB[i] = (unsigned)(Rb * K + C) * 2u; }
    const size_t kstep = (size_t)(BK * 2);
    const size_t hstep = (size_t)HALF * K * 2;
    const size_t tstep = 2 * hstep;
    const unsigned ldsw = (unsigned)wid * 1024u;
    const int aoff = lds_byte(wr * 64 + fr, fq * 8), boff = lds_byte(wc * 32 + fr, fq * 8);
#define PG8_SA(b, h) (((b) * 2 + (h)) * HTB)
#define PG8_SB(b, h) ((4 + (b) * 2 + (h)) * HTB)
#define PG8_STAGE(bufoff, gbase, voff) do { _Pragma("unroll") for (int _i = 0; _i < 2; ++_i) \
        __builtin_amdgcn_global_load_lds((const unsigned*)((const char*)(gbase) + (voff)[_i]), (PG8_LAS unsigned*)(lds + (bufoff) + ldsw + _i * 8192), 16, 0, 0); } while (0)
#define PG8_LDA(dst, b, h) do { _Pragma("unroll") for (int m = 0; m < 4; ++m) _Pragma("unroll") for (int k = 0; k < 2; ++k) dst[m][k] = *(const PG8_LAS bf16x8*)(lds + PG8_SA(b, h) + aoff + m * 2048 + k * 1024); } while (0)
#define PG8_LDB(dst, b, h) do { _Pragma("unroll") for (int n = 0; n < 2; ++n) _Pragma("unroll") for (int k = 0; k < 2; ++k) dst[n][k] = *(const PG8_LAS bf16x8*)(lds + PG8_SB(b, h) + boff + n * 2048 + k * 1024); } while (0)
#define PG8_MMA(ai, bj, At, Bt) do { __builtin_amdgcn_s_setprio(1); _Pragma("unroll") for (int m = 0; m < 4; ++m) _Pragma("unroll") for (int n = 0; n < 2; ++n) _Pragma("unroll") for (int k = 0; k < 2; ++k) \
        acc[ai][bj][m][n] = __builtin_amdgcn_mfma_f32_16x16x32_bf16(Bt[n][k], At[m][k], acc[ai][bj][m][n], 0, 0, 0); __builtin_amdgcn_s_setprio(0); } while (0)
#define PG8_WAIT_V(n) asm volatile("s_waitcnt vmcnt(" #n ")" ::: "memory")
#define PG8_WAIT_L(n) asm volatile("s_waitcnt lgkmcnt(" #n ")" ::: "memory")
#define PG8_BAR __builtin_amdgcn_s_barrier()
#define PG8_SCHED __builtin_amdgcn_sched_barrier(0)
    Unit cur, nxt; int ui = 0;
    if (!S.next(0, cur)) return;
    f32x4 acc[2][2][4][2];
#pragma unroll
    for (int a = 0; a < 2; ++a)
#pragma unroll
        for (int b = 0; b < 2; ++b)
#pragma unroll
            for (int m = 0; m < 4; ++m)
#pragma unroll
                for (int n = 0; n < 2; ++n) acc[a][b][m][n] = (f32x4){0.f, 0.f, 0.f, 0.f};
    bf16x8 At[4][2], B0[2][2], B1[2][2];
    const char* cA = (const char*)g.A + (size_t)cur.pm * tstep; const char* cB = (const char*)g.Bt + (size_t)cur.pn * tstep;
    S.a_ready(cur);
    if constexpr (SP2) {
        PG8_STAGE(PG8_SB(0, 0), cB, voffB); PG8_STAGE(PG8_SB(0, 1), cB + hstep, voffB); PG8_STAGE(PG8_SA(0, 0), cA, voffA); PG8_STAGE(PG8_SA(0, 1), cA + hstep, voffA);
        if (wr == 1) PG8_BAR;
        PG8_WAIT_V(2); PG8_BAR;
        PG8_STAGE(PG8_SB(1, 0), cB + kstep, voffB); PG8_STAGE(PG8_SA(1, 0), cA + kstep, voffA); PG8_STAGE(PG8_SB(1, 1), cB + hstep + kstep, voffB);
        PG8_WAIT_V(6); PG8_BAR;
    } else {
        PG8_STAGE(PG8_SB(0, 0), cB, voffB); PG8_STAGE(PG8_SA(0, 0), cA, voffA); PG8_STAGE(PG8_SB(0, 1), cB + hstep, voffB); PG8_STAGE(PG8_SA(0, 1), cA + hstep, voffA);
        if (wr == 1) PG8_BAR;
        PG8_WAIT_V(4); PG8_BAR;
        PG8_STAGE(PG8_SB(1, 0), cB + kstep, voffB); PG8_STAGE(PG8_SA(1, 0), cA + kstep, voffA); PG8_STAGE(PG8_SB(1, 1), cB + hstep + kstep, voffB);
        PG8_WAIT_V(6); PG8_BAR;
    }
    for (;;) {
        const bool has_next = S.next(ui + 1, nxt);
        const char* nA = has_next ? (const char*)g.A + (size_t)nxt.pm * tstep : cA; const char* nB = has_next ? (const char*)g.Bt + (size_t)nxt.pn * tstep : cB;
        for (int t = 0; t < nt; t += 2) {
            const bool last = (t == nt - 2);
            const char* a1 = cA + (size_t)(t + 1) * kstep;
            const char* a2 = last ? nA : cA + (size_t)(t + 2) * kstep; const char* b2 = last ? nB : cB + (size_t)(t + 2) * kstep;
            const char* a3 = a2 + kstep; const char* b3 = b2 + kstep;
            if (last && has_next) S.a_ready(nxt);
            if constexpr (SP2) {
            PG8_LDB(B0, 0, 0); PG8_LDB(B1, 0, 1); PG8_SCHED; PG8_LDA(At, 0, 0); PG8_STAGE(PG8_SA(1, 1), a1 + hstep, voffA);
            PG8_WAIT_V(8); PG8_WAIT_L(0); PG8_BAR; PG8_MMA(0, 0, At, B0); PG8_MMA(0, 1, At, B1); PG8_BAR; PG8_SCHED;
            PG8_LDA(At, 0, 1); PG8_STAGE(PG8_SB(0, 0), b2, voffB); PG8_STAGE(PG8_SB(0, 1), b2 + hstep, voffB); PG8_STAGE(PG8_SA(0, 0), a2, voffA);
            PG8_WAIT_V(8); PG8_WAIT_L(0); PG8_BAR; PG8_MMA(1, 0, At, B0); PG8_MMA(1, 1, At, B1); PG8_BAR; PG8_SCHED;
            PG8_LDB(B0, 1, 0); PG8_LDB(B1, 1, 1); PG8_SCHED; PG8_LDA(At, 1, 0); PG8_STAGE(PG8_SA(0, 1), a2 + hstep, voffA);
            PG8_WAIT_V(8); PG8_WAIT_L(0); PG8_BAR; PG8_MMA(0, 0, At, B0); PG8_MMA(0, 1, At, B1); PG8_BAR; PG8_SCHED;
            PG8_LDA(At, 1, 1); PG8_STAGE(PG8_SB(1, 0), b3, voffB); PG8_STAGE(PG8_SB(1, 1), b3 + hstep, voffB); PG8_STAGE(PG8_SA(1, 0), a3, voffA);
            PG8_WAIT_V(8); PG8_WAIT_L(0); PG8_BAR; PG8_MMA(1, 0, At, B0); PG8_MMA(1, 1, At, B1); PG8_BAR; PG8_SCHED;
            } else {
            PG8_LDB(B0, 0, 0); PG8_SCHED; PG8_LDA(At, 0, 0); PG8_STAGE(PG8_SA(1, 1), a1 + hstep, voffA);
            PG8_WAIT_L(8); PG8_BAR; PG8_WAIT_L(0); PG8_MMA(0, 0, At, B0); PG8_BAR; PG8_SCHED;
            PG8_LDB(B1, 0, 1); PG8_STAGE(PG8_SB(0, 0), b2, voffB);
            PG8_BAR; PG8_WAIT_L(0); PG8_MMA(0, 1, At, B1); PG8_BAR;
            PG8_LDA(At, 0, 1); PG8_STAGE(PG8_SA(0, 0), a2, voffA);
            PG8_BAR; PG8_WAIT_L(0); PG8_MMA(1, 0, At, B0); PG8_BAR; PG8_SCHED;
            PG8_STAGE(PG8_SB(0, 1), b2 + hstep, voffB);
            PG8_WAIT_V(6); PG8_BAR; PG8_MMA(1, 1, At, B1); PG8_BAR;
            PG8_LDB(B0, 1, 0); PG8_SCHED; PG8_LDA(At, 1, 0); PG8_STAGE(PG8_SA(0, 1), a2 + hstep, voffA);
            PG8_WAIT_L(8); PG8_BAR; PG8_WAIT_L(0); PG8_MMA(0, 0, At, B0); PG8_BAR; PG8_SCHED;
            PG8_LDB(B1, 1, 1); PG8_STAGE(PG8_SB(1, 0), b3, voffB);
            PG8_BAR; PG8_WAIT_L(0); PG8_MMA(0, 1, At, B1); PG8_BAR;
            PG8_LDA(At, 1, 1); PG8_STAGE(PG8_SA(1, 0), a3, voffA);
            PG8_BAR; PG8_WAIT_L(0); PG8_MMA(1, 0, At, B0); PG8_BAR; PG8_SCHED;
            PG8_STAGE(PG8_SB(1, 1), b3 + hstep, voffB);
            PG8_WAIT_V(6); PG8_BAR; PG8_MMA(1, 1, At, B1); PG8_BAR;
            }
        }
        if constexpr (ALIGN_EPI) { if (wr == 0) PG8_BAR; }
        if constexpr (!Epi::AFTER_DRAIN) { E(acc, cur, wr, wc, fr, fq); S.done(cur); }
        if (!has_next) break;
#pragma unroll
        for (int a = 0; a < 2; ++a)
#pragma unroll
            for (int b = 0; b < 2; ++b)
#pragma unroll
                for (int m = 0; m < 4; ++m)
#pragma unroll
                    for (int n = 0; n < 2; ++n) acc[a][b][m][n] = (f32x4){0.f, 0.f, 0.f, 0.f};
        cur = nxt; cA = nA; cB = nB; ++ui;
        if constexpr (ALIGN_EPI) { if (wr == 1) PG8_BAR; }
    }
    PG8_WAIT_V(0);
    if constexpr (!ALIGN_EPI) { if (wr == 0) PG8_BAR; }
    PG8_BAR;
    if constexpr (Epi::AFTER_DRAIN) { E.fused(acc, cur, wr, wc, fr, fq, lds, wid, lane); S.done(cur); }
#undef PG8_SA
#undef PG8_SB
#undef PG8_STAGE
#undef PG8_LDA
#undef PG8_LDB
#undef PG8_MMA
#undef PG8_WAIT_V
#undef PG8_WAIT_L
#undef PG8_BAR
#undef PG8_SCHED
}
}

#ifndef GMLP_DBG
#define GMLP_DBG 0
#endif
constexpr int NWAVES = 8, NTHR = 512;
constexpr int BATCH = 4, SEQ = 8192, D = 1024, DEPTH = 4, M = BATCH * SEQ;
constexpr int D_IN = 2576, NZ = 2816;
constexpr int FF = 4096;
constexpr int ZU = 0, ZV = 512, ZQ = 1024, ZK = 1280, ZVB = 1536, ZG = 2048, ZP = 2560;
constexpr float EPS = 1e-6f;
constexpr int NCHUNK = M / 64;
constexpr size_t MiB = 1u << 20;
constexpr size_t WS_WM = 1 * MiB;
constexpr size_t WS_DEC = 1 * MiB + 512 * 1024;
constexpr size_t WS_W = 2 * MiB;
constexpr size_t W_IN_B = (size_t)NZ * D * 2, W_OUT_B = (size_t)D * D * 2, W_1_B = (size_t)FF * D * 2, W_2_B = (size_t)D * FF * 2, W_LAYER_B = W_IN_B + W_OUT_B + W_1_B + W_2_B;
constexpr size_t WS_F1 = 96 * MiB;
constexpr size_t WS_Z = 96 * MiB;
constexpr size_t WS_AB = 272 * MiB;
constexpr size_t WS_QE = 336 * MiB;
constexpr size_t WS_Y = 352 * MiB;
constexpr size_t WS_SP = 352 * MiB;
constexpr size_t WS_OI = 384 * MiB;
constexpr size_t WS_MM = 416 * MiB;
constexpr size_t WS_UPD = 416 * MiB;
constexpr size_t WS_HP = 480 * MiB;
constexpr size_t WS_END = 494 * MiB;
static_assert(WS_W + DEPTH * W_LAYER_B <= WS_F1, "weights fit");
constexpr int LDS_BYTES = 149504;

#define GAS __attribute__((address_space(1)))
#define LAS __attribute__((address_space(3)))
typedef unsigned short bf16;
typedef unsigned v4u __attribute__((ext_vector_type(4)));
typedef unsigned v2u __attribute__((ext_vector_type(2)));
typedef float f32x4 __attribute__((ext_vector_type(4)));
typedef short bf16x8 __attribute__((ext_vector_type(8)));
#define LDS_WAIT() asm volatile("s_waitcnt lgkmcnt(0)" ::: "memory")
#define MFMA_DRAIN() asm volatile("s_nop 15\n\ts_nop 15\n\ts_nop 15\n\ts_nop 15\n\ts_nop 15\n\ts_nop 15\n\ts_nop 15\n\ts_nop 15\n\ts_nop 15\n\ts_nop 15\n\ts_nop 15\n\ts_nop 15\n\ts_nop 15\n\ts_nop 15\n\ts_nop 15\n\ts_nop 15" ::: "memory")
#define FRAG_WAIT() __builtin_amdgcn_sched_barrier(0)
#define MFMA16(a, b, c) __builtin_amdgcn_mfma_f32_16x16x32_bf16((a), (b), (c), 0, 0, 0)

__device__ __forceinline__ unsigned f2bf(float f) { unsigned u = __builtin_bit_cast(unsigned, f); return (u + 0x7fffu + ((u >> 16) & 1u)) >> 16; }
typedef __bf16 hwbf2 __attribute__((ext_vector_type(2)));
typedef float hwf2 __attribute__((ext_vector_type(2)));
__device__ __forceinline__ unsigned pk2(float lo, float hi) { const hwf2 v = {lo, hi}; return __builtin_bit_cast(unsigned, __builtin_convertvector(v, hwbf2)); }
__device__ __forceinline__ float bflo(unsigned w) { return __builtin_bit_cast(float, w << 16); }
__device__ __forceinline__ float bfhi(unsigned w) { return __builtin_bit_cast(float, w & 0xffff0000u); }
__device__ __forceinline__ float bf1(bf16 h) { return __builtin_bit_cast(float, (unsigned)h << 16); }
__device__ __forceinline__ void unpack8(const v4u w, float (&o)[8]) { o[0] = bflo(w.x); o[1] = bfhi(w.x); o[2] = bflo(w.y); o[3] = bfhi(w.y); o[4] = bflo(w.z); o[5] = bfhi(w.z); o[6] = bflo(w.w); o[7] = bfhi(w.w); }
__device__ __forceinline__ v4u pack8(const float (&o)[8]) { v4u w; w.x = pk2(o[0], o[1]); w.y = pk2(o[2], o[3]); w.z = pk2(o[4], o[5]); w.w = pk2(o[6], o[7]); return w; }
__device__ __forceinline__ float wave_sum(float v) {
#pragma unroll
    for (int o = 1; o < 64; o <<= 1) v += __shfl_xor(v, o);
    return v;
}
__device__ __forceinline__ float row16_sum(float v) {
#pragma unroll
    for (int o = 1; o < 16; o <<= 1) v += __shfl_xor(v, o);
    return v;
}

__device__ __forceinline__ void row16_sum4_lds(LAS unsigned char* scr, float (&v)[4], int lane) {
    *(LAS f32x4*)(scr + lane * 16) = (f32x4){v[0], v[1], v[2], v[3]};
    asm volatile("s_waitcnt lgkmcnt(0)" ::: "memory");
    f32x4 s = (f32x4){0.f, 0.f, 0.f, 0.f};
#pragma unroll
    for (int k = 0; k < 16; ++k) s += *(const LAS f32x4*)(scr + ((lane & 48) + k) * 16);
    asm volatile("s_waitcnt lgkmcnt(0)" ::: "memory");
    v[0] = s.x; v[1] = s.y; v[2] = s.z; v[3] = s.w;
}

__device__ __forceinline__ float wave_sum_lds(LAS unsigned char* scr, float v, int lane) {
    *(LAS float*)(scr + lane * 4) = v;
    asm volatile("s_waitcnt lgkmcnt(0)" ::: "memory");
    f32x4 s = (f32x4){0.f, 0.f, 0.f, 0.f};
#pragma unroll
    for (int k = 0; k < 16; ++k) s += *(const LAS f32x4*)(scr + k * 16);
    asm volatile("s_waitcnt lgkmcnt(0)" ::: "memory");
    return (s.x + s.y) + (s.z + s.w);
}
__device__ __forceinline__ void wave_sum4_lds(LAS unsigned char* scr, float (&v)[4], int lane) {
    *(LAS f32x4*)(scr + lane * 16) = (f32x4){v[0], v[1], v[2], v[3]};
    asm volatile("s_waitcnt lgkmcnt(0)" ::: "memory");
    f32x4 s = (f32x4){0.f, 0.f, 0.f, 0.f};
#pragma unroll
    for (int k = 0; k < 16; ++k) s += *(const LAS f32x4*)(scr + ((lane & 48) + k) * 16);
    asm volatile("s_waitcnt lgkmcnt(0)" ::: "memory");
    if ((lane & 15) == 0) *(LAS f32x4*)(scr + (lane >> 4) * 16) = s;
    asm volatile("s_waitcnt lgkmcnt(0)" ::: "memory");
    const f32x4 t0 = *(const LAS f32x4*)(scr), t1 = *(const LAS f32x4*)(scr + 16), t2 = *(const LAS f32x4*)(scr + 32), t3 = *(const LAS f32x4*)(scr + 48);
    asm volatile("s_waitcnt lgkmcnt(0)" ::: "memory");
    const f32x4 t = (t0 + t1) + (t2 + t3);
    v[0] = t.x; v[1] = t.y; v[2] = t.z; v[3] = t.w;
}

constexpr int HPR = 4, HP_ROWS = 16;
__device__ __forceinline__ size_t hp_row(int r16) { return (size_t)(r16 >> 2) * SEQ + (size_t)(r16 & 3); }
template <bool IN_BF16, int ACT>
__device__ __forceinline__ void hp_gemv4(LAS unsigned char* lds, const void* in, int K, const float* W, int ldw, int c0, float* out, int ldo, int wave, int lane) {
    const int c = c0 + (wave & 3), kbeg = (wave >> 2) * (K >> 1), steps = (K >> 1) >> 6;
    float acc[16];
#pragma unroll
    for (int r = 0; r < 16; ++r) acc[r] = 0.f;
#pragma unroll 2
    for (int s = 0; s < steps; ++s) { const int k = kbeg + s * 64 + lane;
        const float w = W[(size_t)k * ldw + c];
#pragma unroll
        for (int r = 0; r < 16; ++r) { const float a = IN_BF16 ? bf1(((const bf16*)in)[hp_row(r) * D + k]) : ((const float*)in)[(size_t)r * K + k]; acc[r] += a * w; } }
    LAS unsigned char* scr = lds + wave * 1024;
#pragma unroll
    for (int q = 0; q < 4; ++q) { float v[4] = {acc[4 * q], acc[4 * q + 1], acc[4 * q + 2], acc[4 * q + 3]}; wave_sum4_lds(scr, v, lane); acc[4 * q] = v[0]; acc[4 * q + 1] = v[1]; acc[4 * q + 2] = v[2]; acc[4 * q + 3] = v[3]; }
    LAS float* X = (LAS float*)(lds + 8192);
    if (lane == 0) {
#pragma unroll
        for (int r = 0; r < 16; ++r) X[wave * 16 + r] = acc[r]; }
    __syncthreads();
    if (wave < 4 && lane < 16) { float v = X[wave * 16 + lane] + X[(wave + 4) * 16 + lane]; if (ACT == 2) { v = fmaxf(v, 0.f); v = v * v; } out[(size_t)lane * ldo + c0 + wave] = v; }
    __syncthreads();
}

template <int ACT>
__device__ __forceinline__ void hp_gemv_phase(LAS unsigned char* lds, const float* in32, int K, const float* W, int ldw, int N, float* out, int G, int bid, int wave, int lane, int tid) {
    LAS float* INS = (LAS float*)(lds + 16384);
    const int nch = K >> 10, half = wave >> 2;
    for (int cg = bid; cg < (N >> 2); cg += G) {
        float acc[16];
#pragma unroll
        for (int r = 0; r < 16; ++r) acc[r] = 0.f;
        const int c = 4 * cg + (wave & 3);
        for (int ch = 0; ch < nch; ++ch) {
            if (nch > 1 || cg == bid) {
                __syncthreads();
#pragma unroll
                for (int i = 0; i < 8; ++i) { const int idx = tid + 512 * i, r = idx >> 8, k4 = idx & 255;
                    *(LAS f32x4*)(INS + r * 1024 + 4 * k4) = *(const f32x4*)(in32 + (size_t)r * K + ch * 1024 + 4 * k4); }
                __syncthreads();
            }
            const int kb = ch * 1024 + half * 512 + lane;
            float w8[8];
#pragma unroll
            for (int s = 0; s < 8; ++s) w8[s] = W[(size_t)(kb + s * 64) * ldw + c];
#pragma unroll
            for (int s = 0; s < 8; ++s)
#pragma unroll
                for (int r = 0; r < 16; ++r) acc[r] += INS[r * 1024 + half * 512 + s * 64 + lane] * w8[s];
        }
        LAS unsigned char* scr = lds + wave * 1024;
#pragma unroll
        for (int q = 0; q < 4; ++q) { float v[4] = {acc[4 * q], acc[4 * q + 1], acc[4 * q + 2], acc[4 * q + 3]}; wave_sum4_lds(scr, v, lane); acc[4 * q] = v[0]; acc[4 * q + 1] = v[1]; acc[4 * q + 2] = v[2]; acc[4 * q + 3] = v[3]; }
        LAS float* X = (LAS float*)(lds + 8192);
        if (lane == 0) {
#pragma unroll
            for (int r = 0; r < 16; ++r) X[wave * 16 + r] = acc[r]; }
        __syncthreads();
        if (wave < 4 && lane < 16) { float v = X[wave * 16 + lane] + X[(wave + 4) * 16 + lane]; if (ACT == 2) { v = fmaxf(v, 0.f); v = v * v; } out[(size_t)lane * N + 4 * cg + wave] = v; }
        __syncthreads();
    }
}

__device__ __forceinline__ void p0_transpose_item(const float* W, int ldw, int ncols, int K, bf16* WT, const float* kscale, int qlo, int qhi, LAS float* scr, int item, int lane) {
    const int nblk = ncols / 32, kb = item / nblk, nb = item % nblk, k0 = 64 * kb, n0 = 32 * nb;
    const float cs = (n0 >= qlo && n0 < qhi) ? 0.125f : 1.0f;
    float wreg[32];
#pragma unroll
    for (int i = 0; i < 32; ++i) wreg[i] = W[(size_t)(k0 + 2 * i + (lane >> 5)) * ldw + n0 + (lane & 31)];
#pragma unroll
    for (int i = 0; i < 32; ++i) { const int kk = 2 * i + (lane >> 5); float w = wreg[i]; if (kscale) w *= kscale[k0 + kk]; scr[kk * 33 + (lane & 31)] = w * cs; }
    LDS_WAIT(); asm volatile("" ::: "memory");
    const int c = lane & 7;
#pragma unroll
    for (int j = 0; j < 4; ++j) { const int n = (lane >> 3) + 8 * j; const LAS float* s = scr + (8 * c) * 33 + n;
        v4u o; o.x = pk2(s[0 * 33], s[1 * 33]); o.y = pk2(s[2 * 33], s[3 * 33]); o.z = pk2(s[4 * 33], s[5 * 33]); o.w = pk2(s[6 * 33], s[7 * 33]);
        *(GAS v4u*)(WT + (size_t)(n0 + n) * K + k0 + 8 * c) = o; }
    LDS_WAIT(); asm volatile("" ::: "memory");
}
__device__ __forceinline__ void p0_gate_item(const float* Win, const float* gw, const float* g, bf16* WT, int item, int lane) {
    const int np = item >> 1, k0 = ((item & 1) * 64 + lane) * 8;
    float gwv[16];
#pragma unroll
    for (int r = 0; r < 16; ++r) gwv[r] = gw[r * 256 + np];
    float o[8];
#pragma unroll
    for (int j = 0; j < 8; ++j) { const float* wr = Win + (size_t)(k0 + j) * D_IN + 2560; float s = 0.f;
#pragma unroll
        for (int r4 = 0; r4 < 4; ++r4) { const f32x4 w = *(const f32x4*)(wr + 4 * r4); s += w.x * gwv[4 * r4] + w.y * gwv[4 * r4 + 1] + w.z * gwv[4 * r4 + 2] + w.w * gwv[4 * r4 + 3]; }
        o[j] = s * g[k0 + j]; }
    *(GAS v4u*)(WT + (size_t)(2560 + np) * D + k0) = pack8(o);
}

__device__ __forceinline__ void rows_add_stream(LAS unsigned char* scr, float (&hv)[16], const v4u mc0, const v4u mc1, const float* m32, const float* g, int row, int lane) {
    float mv[16];
    const int tpos = row & (SEQ - 1); const bool hp = (m32 != nullptr) && (tpos < HPR);
    if (hp) { const float* m3 = m32 + (size_t)((row >> 13) * 4 + tpos) * D + 8 * lane;
#pragma unroll
        for (int e = 0; e < 2; ++e) { const f32x4 a = *(const f32x4*)(m3 + 512 * e), b = *(const f32x4*)(m3 + 512 * e + 4);
            mv[8 * e + 0] = a.x; mv[8 * e + 1] = a.y; mv[8 * e + 2] = a.z; mv[8 * e + 3] = a.w; mv[8 * e + 4] = b.x; mv[8 * e + 5] = b.y; mv[8 * e + 6] = b.z; mv[8 * e + 7] = b.w; }
    } else {
        float t[8]; unpack8(mc0, t);
#pragma unroll
        for (int i = 0; i < 8; ++i) mv[i] = t[i];
        unpack8(mc1, t);
#pragma unroll
        for (int i = 0; i < 8; ++i) mv[8 + i] = t[i]; }
    float ss = 0.f;
#pragma unroll
    for (int i = 0; i < 16; ++i) ss += mv[i] * mv[i];
    const float rstd = 1.0f / sqrtf(wave_sum_lds(scr, ss, lane) * (1.0f / D) + EPS);
#pragma unroll
    for (int e = 0; e < 2; ++e) { const f32x4 ga = *(const f32x4*)(g + 8 * lane + 512 * e), gb = *(const f32x4*)(g + 8 * lane + 512 * e + 4);
        const float gg[8] = {ga.x, ga.y, ga.z, ga.w, gb.x, gb.y, gb.z, gb.w};
#pragma unroll
        for (int i = 0; i < 8; ++i) hv[8 * e + i] += mv[8 * e + i] * rstd * gg[i]; }
}
__device__ __forceinline__ void rows_phase(LAS unsigned char* scr, const float* hin, const bf16* mm, const float* g, float* hout, bf16* y, int gw, int ngw, int lane, const float* m32 = nullptr, float* y32out = nullptr, const float* ygain = nullptr,
                                           const bf16* mm2 = nullptr, const float* g2 = nullptr, const float* m32b = nullptr) {
    f32x4 hn[4]; v4u mn[2] = {(v4u){0u, 0u, 0u, 0u}, (v4u){0u, 0u, 0u, 0u}}, mn2[2] = {(v4u){0u, 0u, 0u, 0u}, (v4u){0u, 0u, 0u, 0u}};
#define NT_LD4F(p) __builtin_nontemporal_load((const f32x4*)(p))
#define NT_LD4U(p) __builtin_nontemporal_load((const v4u*)(p))
    { const float* hr = hin + (size_t)gw * D + 8 * lane; hn[0] = NT_LD4F(hr); hn[1] = NT_LD4F(hr + 4); hn[2] = NT_LD4F(hr + 512); hn[3] = NT_LD4F(hr + 516);
      if (mm) { const bf16* mr = mm + (size_t)gw * D + 8 * lane; mn[0] = NT_LD4U(mr); mn[1] = NT_LD4U(mr + 512); }
      if (mm2) { const bf16* mr = mm2 + (size_t)gw * D + 8 * lane; mn2[0] = NT_LD4U(mr); mn2[1] = NT_LD4U(mr + 512); } }
    for (int row = gw; row < M; row += ngw) {
        float hv[16];
        hv[0] = hn[0].x; hv[1] = hn[0].y; hv[2] = hn[0].z; hv[3] = hn[0].w; hv[4] = hn[1].x; hv[5] = hn[1].y; hv[6] = hn[1].z; hv[7] = hn[1].w;
        hv[8] = hn[2].x; hv[9] = hn[2].y; hv[10] = hn[2].z; hv[11] = hn[2].w; hv[12] = hn[3].x; hv[13] = hn[3].y; hv[14] = hn[3].z; hv[15] = hn[3].w;
        const v4u mc0 = mn[0], mc1 = mn[1], mb0 = mn2[0], mb1 = mn2[1];
        if (row + ngw < M) { const float* hr = hin + (size_t)(row + ngw) * D + 8 * lane; hn[0] = NT_LD4F(hr); hn[1] = NT_LD4F(hr + 4); hn[2] = NT_LD4F(hr + 512); hn[3] = NT_LD4F(hr + 516);
            if (mm) { const bf16* mr = mm + (size_t)(row + ngw) * D + 8 * lane; mn[0] = NT_LD4U(mr); mn[1] = NT_LD4U(mr + 512); }
            if (mm2) { const bf16* mr = mm2 + (size_t)(row + ngw) * D + 8 * lane; mn2[0] = NT_LD4U(mr); mn2[1] = NT_LD4U(mr + 512); } }
        if (mm) rows_add_stream(scr, hv, mc0, mc1, m32, g, row, lane);
        if (mm2) rows_add_stream(scr, hv, mb0, mb1, m32b, g2, row, lane);
        if (hout) { float* orow = hout + (size_t)row * D + 8 * lane;
#pragma unroll
            for (int e = 0; e < 2; ++e) { __builtin_nontemporal_store((f32x4){hv[8 * e], hv[8 * e + 1], hv[8 * e + 2], hv[8 * e + 3]}, (f32x4*)(orow + 512 * e)); __builtin_nontemporal_store((f32x4){hv[8 * e + 4], hv[8 * e + 5], hv[8 * e + 6], hv[8 * e + 7]}, (f32x4*)(orow + 512 * e + 4)); } }
        if (y) {
            float ss = 0.f;
#pragma unroll
            for (int i = 0; i < 16; ++i) ss += hv[i] * hv[i];
            const float rstd = 1.0f / sqrtf(wave_sum_lds(scr, ss, lane) * (1.0f / D) + EPS);
            bf16* yr = y + (size_t)row * D + 8 * lane;
#pragma unroll
            for (int e = 0; e < 2; ++e) { float t[8];
#pragma unroll
                for (int i = 0; i < 8; ++i) t[i] = hv[8 * e + i] * rstd;
                *(v4u*)(yr + 512 * e) = pack8(t); }
            const int tpos2 = row & (SEQ - 1);
            if (y32out != nullptr && tpos2 < HPR) { float* y3 = y32out + (size_t)((row >> 13) * 4 + tpos2) * D + 8 * lane;
#pragma unroll
                for (int e = 0; e < 2; ++e)
#pragma unroll
                    for (int i = 0; i < 8; ++i) y3[512 * e + i] = hv[8 * e + i] * rstd * ygain[8 * lane + 512 * e + i]; }
        }
    }
}

constexpr int VT_ROW = 272, VT_HEAD = 128 * VT_ROW;
__device__ __forceinline__ void gmlp_unit(LAS unsigned char* lds, float* ab32, const bf16* z, bf16* ab, const bf16* Wm, const float* ln_g, const float* ln_b, const float* bs, const float* out_g, int unit, int tid) {
    const int lane = tid & 63, wave = __builtin_amdgcn_readfirstlane(tid >> 6), x = lane & 15, g = lane >> 4;
    const size_t row0 = (size_t)unit * 128;
    {
        float gg[8], bb[8];
        { const f32x4 a = *(const f32x4*)(ln_g + 8 * lane), b = *(const f32x4*)(ln_g + 8 * lane + 4); gg[0] = a.x; gg[1] = a.y; gg[2] = a.z; gg[3] = a.w; gg[4] = b.x; gg[5] = b.y; gg[6] = b.z; gg[7] = b.w; }
        { const f32x4 a = *(const f32x4*)(ln_b + 8 * lane), b = *(const f32x4*)(ln_b + 8 * lane + 4); bb[0] = a.x; bb[1] = a.y; bb[2] = a.z; bb[3] = a.w; bb[4] = b.x; bb[5] = b.y; bb[6] = b.z; bb[7] = b.w; }
        const int h = lane >> 4;
#pragma unroll 1
        for (int it = 0; it < 4; ++it) {
            const int j0 = 16 * wave + 4 * it;
            float val[4][8];
            LAS unsigned char* scr1 = lds + 4 * VT_HEAD + wave * 1024;
            float sm[4];
#pragma unroll
            for (int t = 0; t < 4; ++t) {
                const v4u w = *(const v4u*)(z + (row0 + j0 + t) * NZ + ZV + 8 * lane);
                unpack8(w, val[t]);
                float s = 0.f;
#pragma unroll
                for (int i = 0; i < 8; ++i) s += val[t][i];
                sm[t] = s;
            }
            wave_sum4_lds(scr1, sm, lane);
            float s2[4];
#pragma unroll
            for (int t = 0; t < 4; ++t) { const float mean = sm[t] * (1.0f / 512.0f); float q = 0.f;
#pragma unroll
                for (int i = 0; i < 8; ++i) { val[t][i] -= mean; q += val[t][i] * val[t][i]; }
                s2[t] = q; }
            wave_sum4_lds(scr1, s2, lane);
#pragma unroll
            for (int t = 0; t < 4; ++t) { const float rstd = 1.0f / sqrtf(s2[t] * (1.0f / 512.0f) + EPS);
#pragma unroll
                for (int i = 0; i < 8; ++i) val[t][i] = val[t][i] * rstd * gg[i] + bb[i]; }
#pragma unroll
            for (int i = 0; i < 8; ++i) { v2u o; o.x = pk2(val[0][i], val[1][i]); o.y = pk2(val[2][i], val[3][i]);
                *(LAS v2u*)(lds + h * VT_HEAD + (i * 16 + x) * VT_ROW + j0 * 2) = o; }
        }
    }
    __syncthreads();
    if (GMLP_DBG == 7) {
        const bf16x8 a = (bf16x8){0x3f80, 0x3f00, 0x3e80, 0x3f80, 0x3f00, 0x3e80, 0x3f80, 0x3f00};
        for (int h = 0; h < 4; ++h) {
            f32x4 acc[8];
            for (int nt = 0; nt < 8; ++nt) acc[nt] = (f32x4){0.f, 0.f, 0.f, 0.f};
            for (int ks = 0; ks < 4; ++ks) {
                bf16x8 b[8];
#pragma unroll
                for (int nt = 0; nt < 8; ++nt) b[nt] = *(const LAS bf16x8*)(lds + h * VT_HEAD + (nt * 16 + x) * VT_ROW + (ks * 32 + 8 * g) * 2);
                FRAG_WAIT();
#pragma unroll
                for (int nt = 0; nt < 8; ++nt) acc[nt] = MFMA16(a, b[nt], acc[nt]);
            }
#pragma unroll
            for (int r = 0; r < 4; ++r) { float t[8];
#pragma unroll
                for (int nt = 0; nt < 8; ++nt) t[nt] = acc[nt][r];
                *(v4u*)(ab + (row0 + 16 * wave + 4 * g + r) * D + 128 * h + 8 * x) = pack8(t); }
        }
        __syncthreads();
        return;
    }
    if (GMLP_DBG == 6) {
        for (int h = 0; h < 4; ++h) { float f[8] = {0.f, 0.f, 0.f, 0.f, 0.f, 0.f, 0.f, 0.f};
            for (int nt = 0; nt < 8; ++nt) for (int ks = 0; ks < 4; ++ks) {
                const v4u b = *(const LAS v4u*)(lds + h * VT_HEAD + (nt * 16 + x) * VT_ROW + (ks * 32 + 8 * g) * 2);
                float t[8]; unpack8(b, t);
                for (int q = 0; q < 8; ++q) f[q] += t[q] * (float)(1 + nt + 8 * ks); }
            *(v4u*)(ab + (row0 + 16 * wave + x) * D + 128 * h + 8 * g) = pack8(f); }
        __syncthreads();
        return;
    }
    const int nk = (wave < 4) ? 2 : 4;
    float ssr[4] = {0.f, 0.f, 0.f, 0.f};
#pragma unroll 1
    for (int h = 0; h < 4; ++h) {
        f32x4 acc[8];
#pragma unroll
        for (int nt = 0; nt < 8; ++nt) acc[nt] = (f32x4){0.f, 0.f, 0.f, 0.f};
        bf16x8 a4[4]; v4u uw[4];
#pragma unroll
        for (int ks = 0; ks < 4; ++ks) a4[ks] = *(const bf16x8*)(Wm + h * 16384 + (16 * wave + x) * 128 + ks * 32 + 8 * g);
#pragma unroll
        for (int r = 0; r < 4; ++r) uw[r] = *(const v4u*)(z + (row0 + 16 * wave + 4 * g + r) * NZ + ZU + 128 * h + 8 * x);
#pragma unroll
        for (int ks = 0; ks < 4; ++ks) {
            if (ks < nk) {
#pragma unroll
                for (int nt = 0; nt < 8; ++nt) { const bf16x8 b = *(const LAS bf16x8*)(lds + h * VT_HEAD + (nt * 16 + x) * VT_ROW + (ks * 32 + 8 * g) * 2); acc[nt] = MFMA16(a4[ks], b, acc[nt]); }
            }
        }
        __syncthreads();
#pragma unroll
        for (int r = 0; r < 4; ++r) {
            const int i = 16 * wave + 4 * g + r;
            float uv[8]; unpack8(uw[r], uv);
            const float bias = bs[h * 128 + i];
            float o[8];
#pragma unroll
            for (int nt = 0; nt < 8; ++nt) o[nt] = uv[nt] * (acc[nt][r] + bias);
            const v4u pw = pack8(o);
            float ob[8]; unpack8(pw, ob);
#pragma unroll
            for (int nt = 0; nt < 8; ++nt) ssr[r] += ob[nt] * ob[nt];
            *(LAS v4u*)(lds + h * VT_HEAD + wave * 4096 + r * 1024 + lane * 16) = pw;
        }
    }
    row16_sum4_lds(lds + 4 * VT_HEAD + wave * 1024, ssr, lane);
    float rstd[4];
#pragma unroll
    for (int r = 0; r < 4; ++r) rstd[r] = 1.0f / sqrtf(ssr[r] * (1.0f / 512.0f) + EPS);
#pragma unroll 1
    for (int h = 0; h < 4; ++h) {
        const f32x4 ga = *(const f32x4*)(out_g + 128 * h + 8 * x), gb = *(const f32x4*)(out_g + 128 * h + 8 * x + 4);
        const float gg[8] = {ga.x, ga.y, ga.z, ga.w, gb.x, gb.y, gb.z, gb.w};
#pragma unroll
        for (int r = 0; r < 4; ++r) {
            const int i = 16 * wave + 4 * g + r;
            float t[8]; unpack8(*(const LAS v4u*)(lds + h * VT_HEAD + wave * 4096 + r * 1024 + lane * 16), t);
#pragma unroll
            for (int nt = 0; nt < 8; ++nt) t[nt] = t[nt] * rstd[r] * gg[nt];
            *(v4u*)(ab + (row0 + i) * D + 128 * h + 8 * x) = pack8(t);
        }
    }
    __syncthreads();
}


__device__ __forceinline__ void block_sum16(LAS unsigned char* wscr, LAS float* PW, float (&v)[16], int wave, int lane) {
#pragma unroll
    for (int q = 0; q < 4; ++q) { float t[4] = {v[4 * q], v[4 * q + 1], v[4 * q + 2], v[4 * q + 3]}; wave_sum4_lds(wscr, t, lane); v[4 * q] = t[0]; v[4 * q + 1] = t[1]; v[4 * q + 2] = t[2]; v[4 * q + 3] = t[3]; asm volatile("" ::: "memory"); }
    if (lane == 0) {
#pragma unroll
        for (int i = 0; i < 16; ++i) PW[wave * 16 + i] = v[i]; }
    __syncthreads();
#pragma unroll
    for (int i = 0; i < 16; ++i) v[i] = 0.f;
#pragma unroll
    for (int w2 = 0; w2 < 8; ++w2) {
#pragma unroll
        for (int q = 0; q < 4; ++q) { const f32x4 t = *(const LAS f32x4*)(PW + w2 * 16 + 4 * q); v[4 * q] += t.x; v[4 * q + 1] += t.y; v[4 * q + 2] += t.z; v[4 * q + 3] += t.w; }
        asm volatile("" ::: "memory"); }
    __syncthreads();
}
__device__ __forceinline__ void block_sum4(LAS unsigned char* wscr, LAS float* PW, float (&v)[4], int wave, int lane) {
    wave_sum4_lds(wscr, v, lane);
    if (lane == 0) *(LAS f32x4*)(PW + wave * 4) = (f32x4){v[0], v[1], v[2], v[3]};
    __syncthreads();
    f32x4 s = (f32x4){0.f, 0.f, 0.f, 0.f};
#pragma unroll
    for (int w2 = 0; w2 < 8; ++w2) s += *(const LAS f32x4*)(PW + w2 * 4);
    v[0] = s.x; v[1] = s.y; v[2] = s.z; v[3] = s.w;
    __syncthreads();
}
__device__ __forceinline__ void gmlp_hp1(LAS unsigned char* lds, const float* hsrc, const float* Win32, const float* pre_g, float* part, float* partu, int b, int ks, int rq, int tid_in) {
    int tid = tid_in; asm volatile("" : "+v"(tid));
    const int c = tid;
    const size_t rb = (size_t)b * SEQ + 16 * rq;
    LAS float* Y = (LAS float*)(lds + 1024);
    { const int sj = tid >> 5, skk = (tid & 31) * 2;
      const float* hr = hsrc + (rb + sj) * D + 64 * ks + skk; const float* gr = pre_g + 64 * ks + skk;
      Y[(skk + 0) * 16 + sj] = hr[0] * gr[0]; Y[(skk + 1) * 16 + sj] = hr[1] * gr[1]; }
    __syncthreads();
    const float* wbase = Win32 + (size_t)(64 * ks) * D_IN + c;
    float accv[16], accu[4] = {0.f, 0.f, 0.f, 0.f};
#pragma unroll
    for (int j = 0; j < 16; ++j) accv[j] = 0.f;
#pragma unroll 1
    for (int kb = 0; kb < 64; kb += 8) {
        float wv[8], wu[8];
        const float* wk = wbase + (size_t)kb * D_IN;
#pragma unroll
        for (int e = 0; e < 8; ++e) { wv[e] = wk[(size_t)e * D_IN + ZV]; wu[e] = wk[(size_t)e * D_IN + ZU]; }
#pragma unroll
        for (int e = 0; e < 8; ++e) {
#pragma unroll
            for (int q4 = 0; q4 < 4; ++q4) { const f32x4 y = *(const LAS f32x4*)(Y + (kb + e) * 16 + 4 * q4);
                accv[4 * q4] += y.x * wv[e]; accv[4 * q4 + 1] += y.y * wv[e]; accv[4 * q4 + 2] += y.z * wv[e]; accv[4 * q4 + 3] += y.w * wv[e];
                if (q4 == 0) { accu[0] += y.x * wu[e]; accu[1] += y.y * wu[e]; accu[2] += y.z * wu[e]; accu[3] += y.w * wu[e]; } }
        }
    }
    float* pp = part + ((size_t)(b * 16 + ks) * 64 + 16 * rq) * 512 + c;
#pragma unroll
    for (int j = 0; j < 16; ++j) pp[(size_t)j * 512] = accv[j];
    if (rq == 0) {
#pragma unroll
        for (int i = 0; i < 4; ++i) partu[((size_t)(b * 16 + ks) * 4 + i) * 512 + c] = accu[i]; }
    __syncthreads();
}
__device__ __forceinline__ void gmlp_hp2a(LAS unsigned char* lds, const float* hsrc, const float* ws32, const float* ln_g, const float* ln_b, const float* part, const float* partu, float* mixp, float* zup, int b, int rg, int tid_in) {
    int tid = tid_in; asm volatile("" : "+v"(tid));
    const int lane = tid & 63, wave = __builtin_amdgcn_readfirstlane(tid >> 6), c = tid;
    const size_t rb = (size_t)b * SEQ;
    LAS float* RS = (LAS float*)(lds);
    LAS float* PW = (LAS float*)(lds + 512);
    LAS unsigned char* wscr = lds + 1024 + wave * 1024;
    if (wave < 4) {
        const float* hr = hsrc + (rb + 4 * rg + wave) * D; float s = 0.f;
#pragma unroll
        for (int e = 0; e < 16; ++e) { const float v = hr[lane + 64 * e]; s += v * v; }
        const float tot = wave_sum_lds(wscr, s, lane);
        if (lane == 0) RS[wave] = 1.0f / sqrtf(tot * (1.0f / D) + EPS);
    }
    float s4[4] = {0.f, 0.f, 0.f, 0.f};
    { const float* pb = part + ((size_t)(b * 16) * 64 + 4 * rg) * 512 + c;
#pragma unroll 8
      for (int ks = 0; ks < 16; ++ks) { const float* pk = pb + (size_t)ks * 64 * 512;
#pragma unroll
          for (int i = 0; i < 4; ++i) s4[i] += pk[i * 512]; } }
    __syncthreads();
    const float lg = ln_g[c], lb = ln_b[c];
    const int h = wave >> 1;
    float x4[4], v[4];
#pragma unroll
    for (int i = 0; i < 4; ++i) { x4[i] = pg8::gelu_tanh(s4[i] * RS[i]); v[i] = x4[i]; }
    block_sum4(wscr, PW, v, wave, lane);
#pragma unroll
    for (int i = 0; i < 4; ++i) { x4[i] -= v[i] * (1.0f / 512.0f); v[i] = x4[i] * x4[i]; }
    block_sum4(wscr, PW, v, wave, lane);
#pragma unroll
    for (int i = 0; i < 4; ++i) x4[i] = x4[i] * (1.0f / sqrtf(v[i] * (1.0f / 512.0f) + EPS)) * lg + lb;
#pragma unroll
    for (int i = 0; i < 4; ++i) { const f32x4 w = *(const f32x4*)(ws32 + (size_t)(h * 128 + i) * 128 + 4 * rg);
        mixp[((size_t)(b * 16 + rg) * 4 + i) * 512 + c] = w.x * x4[0] + w.y * x4[1] + w.z * x4[2] + w.w * x4[3]; }
    if (rg == 0) {
        float zu[4] = {0.f, 0.f, 0.f, 0.f};
#pragma unroll 8
        for (int ks = 0; ks < 16; ++ks) { const float* pk = partu + ((size_t)(b * 16 + ks) * 4) * 512 + c;
#pragma unroll
            for (int i = 0; i < 4; ++i) zu[i] += pk[i * 512]; }
#pragma unroll
        for (int i = 0; i < 4; ++i) zup[((size_t)b * 4 + i) * 512 + c] = zu[i] * RS[i];
    }
    __syncthreads();
}
__device__ __forceinline__ void gmlp_hp2b(LAS unsigned char* lds, const float* bs, const float* out_g, const float* mixp, const float* zup, float* ab32, int b, int tid_in) {
    int tid = tid_in; asm volatile("" : "+v"(tid));
    const int lane = tid & 63, wave = __builtin_amdgcn_readfirstlane(tid >> 6), c = tid;
    LAS float* PW = (LAS float*)(lds + 512);
    LAS unsigned char* wscr = lds + 1024 + wave * 1024;
    const int h = wave >> 1;
    __syncthreads();
    float mixed[4] = {0.f, 0.f, 0.f, 0.f};
#pragma unroll 8
    for (int rg = 0; rg < 16; ++rg) { const float* pk = mixp + ((size_t)(b * 16 + rg) * 4) * 512 + c;
#pragma unroll
        for (int i = 0; i < 4; ++i) mixed[i] += pk[i * 512]; }
    float o4[4], sq[4];
#pragma unroll
    for (int i = 0; i < 4; ++i) { o4[i] = pg8::gelu_tanh(zup[((size_t)b * 4 + i) * 512 + c]) * (mixed[i] + bs[h * 128 + i]); sq[i] = o4[i] * o4[i]; }
    block_sum4(wscr, PW, sq, wave, lane);
    const float og = out_g[c];
#pragma unroll
    for (int i = 0; i < 4; ++i) ab32[(size_t)(b * 4 + i) * D + c] = o4[i] * (1.0f / sqrtf(sq[i] * (1.0f / 512.0f) + EPS)) * og;
    __syncthreads();
}

constexpr int G_ROW = 144;
constexpr int G_QE = 0, G_KE = 9216, G_KDT = 18432, G_VT = 27648, G_P = 46080, G_SEG = 55296, G_SC = 57344, G_SCR = 57600, G_HROW = 65536, G_PART = 81920  , G_WSCR = 131072  , G_PSS = 139264;
constexpr int HP_R = 4;
__device__ __forceinline__ float log_sigmoid(float p) { return fminf(p, 0.f) - __logf(1.0f + __expf(-fabsf(p))); }
__device__ __forceinline__ void gla1_unit(LAS unsigned char* lds, const float* hsrc, const float* Win32, const float* pre_g, const float* gla_og, float* ab32, const bf16* z, const float* gate_b, bf16* qe_g, bf16* oi_g, bf16* upd_g, float* dec_g, int unit, int tid) {
    const int lane = tid & 63, wave = __builtin_amdgcn_readfirstlane(tid >> 6), x = lane & 15, g = lane >> 4;
    const int cidx = unit >> 2, h = unit & 3;
    const size_t rbase = (size_t)cidx * 64;
    const int sidx = ((cidx >> 7) * 4 + h) * 128 + (cidx & 127);
    LAS float* SEG = (LAS float*)(lds + G_SEG);
    float c[8], qv[8], kv[8];
    {
        const float gb = gate_b[h * 64 + lane];
        float run = 0.f;
#pragma unroll
        for (int tt = 0; tt < 8; ++tt) {
            const bf16* zr = z + (rbase + 8 * wave + tt) * NZ;
            const float p = bf1(zr[ZP + h * 64 + lane]) + gb;
            qv[tt] = bf1(zr[ZQ + h * 64 + lane]); kv[tt] = bf1(zr[ZK + h * 64 + lane]);
            run += log_sigmoid(p) * (1.0f / 16.0f); c[tt] = run;
        }
        SEG[wave * 64 + lane] = run;
    }
    {
#pragma unroll
        for (int e = 0; e < 2; ++e) { const int v = lane + 64 * e; float t[8];
#pragma unroll
            for (int tt = 0; tt < 8; ++tt) t[tt] = bf1(z[(rbase + 8 * wave + tt) * NZ + ZVB + h * 128 + v]);
            *(LAS v4u*)(lds + G_VT + ((v & 7) * 16 + (v >> 3)) * G_ROW + 16 * wave) = pack8(t); }
    }
    const bool hp = ((cidx & 127) == 0);
    __syncthreads();
    float vf[HP_R][2] = {{0.f, 0.f}, {0.f, 0.f}, {0.f, 0.f}, {0.f, 0.f}}, gf[HP_R][2] = {{0.f, 0.f}, {0.f, 0.f}, {0.f, 0.f}, {0.f, 0.f}};
    if (hp && wave == 0) {
#pragma unroll
        for (int tt = 0; tt < HP_R; ++tt) { const float* qr = hsrc   + (size_t)((cidx >> 7) * 4 + tt) * 1536;
            qv[tt] = qr[h * 64 + lane] * 0.125f; kv[tt] = qr[256 + h * 64 + lane];
            vf[tt][0] = qr[512 + h * 128 + lane]; vf[tt][1] = qr[512 + h * 128 + lane + 64]; gf[tt][0] = qr[1024 + h * 128 + lane]; gf[tt][1] = qr[1024 + h * 128 + lane + 64]; }
    }
    {
        float off = 0.f, tot = 0.f;
#pragma unroll
        for (int w2 = 0; w2 < 8; ++w2) { const float s = SEG[w2 * 64 + lane]; tot += s; if (w2 < wave) off += s; }
        if (wave == 0) dec_g[(size_t)sidx * 64 + lane] = __expf(tot);
        float kd[8];
#pragma unroll
        for (int tt = 0; tt < 8; ++tt) {
            const float cum = off + c[tt]; const int t = 8 * wave + tt;
            const float qe = qv[tt] * __expf(cum), ke = kv[tt] * __expf(-cum); kd[tt] = kv[tt] * __expf(tot - cum);
            const bf16 qb = (bf16)f2bf(qe);
            *(LAS bf16*)(lds + G_QE + t * G_ROW + 2 * lane) = qb;
            *(LAS bf16*)(lds + G_KE + t * G_ROW + 2 * lane) = (bf16)f2bf(ke);
            qe_g[(rbase + t) * 256 + h * 64 + lane] = qb;
        }
        *(LAS v4u*)(lds + G_KDT + lane * G_ROW + 16 * wave) = pack8(kd);
        if (hp && wave == 0) {
            float qf[HP_R], kf[HP_R];
#pragma unroll
            for (int tt = 0; tt < HP_R; ++tt) { const float cum = off + c[tt]; qf[tt] = qv[tt] * __expf(cum); kf[tt] = kv[tt] * __expf(-cum); }
            float s0[4] = {qf[0] * kf[0], qf[1] * kf[0], qf[1] * kf[1], qf[2] * kf[0]};
            float s1[4] = {qf[2] * kf[1], qf[2] * kf[2], qf[3] * kf[0], qf[3] * kf[1]};
            float s2[4] = {qf[3] * kf[2], qf[3] * kf[3], 0.f, 0.f};
            wave_sum4_lds(lds + G_SCR, s0, lane); wave_sum4_lds(lds + G_SCR, s1, lane); wave_sum4_lds(lds + G_SCR, s2, lane);
            if (lane == 0) { LAS float* SC = (LAS float*)(lds + G_SC);
                SC[0] = s0[0]; SC[1] = 0.f; SC[2] = 0.f; SC[3] = 0.f;
                SC[4] = s0[1]; SC[5] = s0[2]; SC[6] = 0.f; SC[7] = 0.f;
                SC[8] = s0[3]; SC[9] = s1[0]; SC[10] = s1[1]; SC[11] = 0.f;
                SC[12] = s1[2]; SC[13] = s1[3]; SC[14] = s2[0]; SC[15] = s2[1]; }
            float o[HP_R][2];
#pragma unroll
            for (int e = 0; e < 2; ++e) {
                o[0][e] = s0[0] * vf[0][e];
                o[1][e] = s0[1] * vf[0][e] + s0[2] * vf[1][e];
                o[2][e] = s0[3] * vf[0][e] + s1[0] * vf[1][e] + s1[1] * vf[2][e];
                o[3][e] = s1[2] * vf[0][e] + s1[3] * vf[1][e] + s2[0] * vf[2][e] + s2[1] * vf[3][e]; }
            float so[4];
#pragma unroll
            for (int i = 0; i < HP_R; ++i) so[i] = o[i][0] * o[i][0] + o[i][1] * o[i][1];
            wave_sum4_lds(lds + G_SCR, so, lane);
#pragma unroll
            for (int i = 0; i < HP_R; ++i) { const float rs = 1.0f / sqrtf(so[i] * (1.0f / 128.0f) + EPS);
#pragma unroll
                for (int e = 0; e < 2; ++e) { const float zg = gf[i][e]; const float sg = zg / (1.0f + __expf(-zg));
                    ab32[(size_t)((cidx >> 7) * 4 + i) * D + 512 + h * 128 + lane + 64 * e] = o[i][e] * rs * gla_og[h * 128 + lane + 64 * e] * sg; } }
        }
    }
    __syncthreads();
    {
        const int it = wave >> 1;
#pragma unroll
        for (int jj = 0; jj < 2; ++jj) {
            const int jt = 2 * (wave & 1) + jj;
            f32x4 s = (f32x4){0.f, 0.f, 0.f, 0.f};
            if (jt <= it) {
                bf16x8 a[2], b[2];
#pragma unroll
                for (int ks = 0; ks < 2; ++ks) {
                    a[ks] = *(const LAS bf16x8*)(lds + G_QE + (16 * it + x) * G_ROW + (ks * 32 + 8 * g) * 2);
                    b[ks] = *(const LAS bf16x8*)(lds + G_KE + (16 * jt + x) * G_ROW + (ks * 32 + 8 * g) * 2); }
                FRAG_WAIT();
                s = MFMA16(a[0], b[0], s); s = MFMA16(a[1], b[1], s);
            }
#pragma unroll
            for (int r = 0; r < 4; ++r) { const int i = 16 * it + 4 * g + r, j = 16 * jt + x;
                float sv = (j <= i) ? s[r] : 0.f;
                if (hp && i < HP_R && j < HP_R) sv = ((const LAS float*)(lds + G_SC))[i * 4 + j];
                *(LAS bf16*)(lds + G_P + i * G_ROW + 2 * j) = (bf16)f2bf(sv); }
        }
    }
    __syncthreads();
    if (wave < 4) {
        f32x4 acc[8];
#pragma unroll
        for (int vt = 0; vt < 8; ++vt) acc[vt] = (f32x4){0.f, 0.f, 0.f, 0.f};
        {
            bf16x8 a[2], b[2][8];
#pragma unroll
            for (int ks = 0; ks < 2; ++ks) {
                a[ks] = *(const LAS bf16x8*)(lds + G_P + (16 * wave + x) * G_ROW + (ks * 32 + 8 * g) * 2);
#pragma unroll
                for (int vt = 0; vt < 8; ++vt) b[ks][vt] = *(const LAS bf16x8*)(lds + G_VT + (vt * 16 + x) * G_ROW + (ks * 32 + 8 * g) * 2); }
            FRAG_WAIT();
#pragma unroll
            for (int ks = 0; ks < 2; ++ks)
#pragma unroll
                for (int vt = 0; vt < 8; ++vt) acc[vt] = MFMA16(a[ks], b[ks][vt], acc[vt]);
        }
#pragma unroll
        for (int r = 0; r < 4; ++r) { float t[8];
#pragma unroll
            for (int vt = 0; vt < 8; ++vt) t[vt] = acc[vt][r];
            *(v4u*)(oi_g + (rbase + 16 * wave + 4 * g + r) * 512 + h * 128 + 8 * x) = pack8(t); }
    } else {
        const int w2 = wave - 4;
        f32x4 acc[2][4];
#pragma unroll
        for (int a = 0; a < 2; ++a)
#pragma unroll
            for (int dt = 0; dt < 4; ++dt) acc[a][dt] = (f32x4){0.f, 0.f, 0.f, 0.f};
        {
            bf16x8 kf[2][4], vfr[2][2];
#pragma unroll
            for (int ks = 0; ks < 2; ++ks) {
#pragma unroll
                for (int dt = 0; dt < 4; ++dt) kf[ks][dt] = *(const LAS bf16x8*)(lds + G_KDT + (16 * dt + x) * G_ROW + (ks * 32 + 8 * g) * 2);
#pragma unroll
                for (int a = 0; a < 2; ++a) vfr[ks][a] = *(const LAS bf16x8*)(lds + G_VT + (16 * (2 * w2 + a) + x) * G_ROW + (ks * 32 + 8 * g) * 2); }
            FRAG_WAIT();
#pragma unroll
            for (int ks = 0; ks < 2; ++ks)
#pragma unroll
                for (int a = 0; a < 2; ++a)
#pragma unroll
                    for (int dt = 0; dt < 4; ++dt) acc[a][dt] = MFMA16(kf[ks][dt], vfr[ks][a], acc[a][dt]);
        }
#pragma unroll
        for (int a = 0; a < 2; ++a)
#pragma unroll
            for (int dt = 0; dt < 4; ++dt) { const int v = 8 * x + (2 * w2 + a); v2u o; o.x = pk2(acc[a][dt][0], acc[a][dt][1]); o.y = pk2(acc[a][dt][2], acc[a][dt][3]);
                *(v2u*)(upd_g + (size_t)sidx * 8192 + v * 64 + 16 * dt + 4 * g) = o; }
    }
    __syncthreads();
}

__device__ __forceinline__ void gla_scan(const bf16* __restrict__ upd_g, const float* __restrict__ dec_g, bf16* __restrict__ sp_g, int gtid, int ngt) {
    for (int e = gtid; e < 16 * 8192; e += ngt) {
        const int bh = e >> 13, off = e & 8191, d = off & 63;
        float S = 0.f;
#pragma unroll 16
        for (int n = 0; n < 128; ++n) {
            const size_t s = (size_t)bh * 128 + n;
            const float u = bf1(upd_g[s * 8192 + off]), dc = dec_g[s * 64 + d];
            sp_g[s * 8192 + off] = (bf16)f2bf(S);
            S = dc * S + u;
        }
    }
}

__device__ __forceinline__ void gla3_unit(LAS unsigned char* scr, const bf16* z, const bf16* qe_g, const bf16* oi_g, const bf16* sp_g, const float* out_g, bf16* ab, int unit, int it, int lane) {
    const int x = lane & 15, g = lane >> 4;
    const int cidx = unit >> 2, h = unit & 3;
    const size_t rbase = (size_t)cidx * 64;
    const int sidx = ((cidx >> 7) * 4 + h) * 128 + (cidx & 127);
    f32x4 acc[8];
#pragma unroll
    for (int vt = 0; vt < 8; ++vt) acc[vt] = (f32x4){0.f, 0.f, 0.f, 0.f};
    {
        bf16x8 a[2], b[2][8];
#pragma unroll
        for (int ks = 0; ks < 2; ++ks) {
            a[ks] = *(const bf16x8*)(qe_g + (rbase + 16 * it + x) * 256 + h * 64 + ks * 32 + 8 * g);
#pragma unroll
            for (int vt = 0; vt < 8; ++vt) b[ks][vt] = *(const bf16x8*)(sp_g + (size_t)sidx * 8192 + (8 * x + vt) * 64 + ks * 32 + 8 * g); }
        FRAG_WAIT();
#pragma unroll
        for (int ks = 0; ks < 2; ++ks)
#pragma unroll
            for (int vt = 0; vt < 8; ++vt) acc[vt] = MFMA16(a[ks], b[ks][vt], acc[vt]);
    }
    const f32x4 ga = *(const f32x4*)(out_g + h * 128 + 8 * x), gb = *(const f32x4*)(out_g + h * 128 + 8 * x + 4);
    const float gg[8] = {ga.x, ga.y, ga.z, ga.w, gb.x, gb.y, gb.z, gb.w};
    float ss[4];
#pragma unroll
    for (int r = 0; r < 4; ++r) {
        const size_t row = rbase + 16 * it + 4 * g + r;
        float oi[8]; unpack8(*(const v4u*)(oi_g + row * 512 + h * 128 + 8 * x), oi);
        float s = 0.f;
#pragma unroll
        for (int vt = 0; vt < 8; ++vt) { const float o = acc[vt][r] + oi[vt]; acc[vt][r] = o; s += o * o; }
        ss[r] = s;
    }
    row16_sum4_lds(scr, ss, lane);
#pragma unroll
    for (int r = 0; r < 4; ++r) {
        const size_t row = rbase + 16 * it + 4 * g + r;
        float zg[8]; unpack8(*(const v4u*)(z + row * NZ + ZG + h * 128 + 8 * x), zg);
        const float rstd = 1.0f / sqrtf(ss[r] * (1.0f / 128.0f) + EPS);
        float t[8];
#pragma unroll
        for (int vt = 0; vt < 8; ++vt) { const float sg = zg[vt] / (1.0f + __expf(-zg[vt])); t[vt] = acc[vt][r] * rstd * gg[vt] * sg; }
        *(v4u*)(ab + row * D + 512 + h * 128 + 8 * x) = pack8(t);
    }
}


#define RLX_AGENT __ATOMIC_RELAXED, __HIP_MEMORY_SCOPE_AGENT
constexpr int CW_BAR = 4096;
constexpr size_t CTL_ZERO_BYTES = 65536;
constexpr int LDS_MISC_OFF = LDS_BYTES - 64;
#define XB_TMO      128
#define XB_XCNT(j)  (256  + 64 * (j))
#define XB_XSUB(j)  (1280 + 64 * (j))
#define XB_XGEN(j)  (2304 + 64 * (j))
#define XB_TOP      3328
#define XB_TOPGEN   3392
#define XCD_BAR_WORDS 3456
#define XB_SPIN_CAP (1u << 18)

__device__ __forceinline__ unsigned xb_ld(unsigned* p)              { return __hip_atomic_load(p, __ATOMIC_RELAXED, __HIP_MEMORY_SCOPE_AGENT); }
__device__ __forceinline__ unsigned xb_add(unsigned* p, unsigned v) { return __hip_atomic_fetch_add(p, v, __ATOMIC_RELAXED, __HIP_MEMORY_SCOPE_AGENT); }
__device__ __forceinline__ unsigned xb_xcc_id() { return (unsigned)__builtin_amdgcn_s_getreg((3 << 11) | 20) & 0xFu; }
#define XB_SPIN(cond, bar) do { unsigned _sp = 0; while (cond) { __builtin_amdgcn_s_sleep(1); \
    if ((++_sp & 255u) == 0u) { if (xb_ld(&(bar)[XB_TMO])) break; if (_sp > XB_SPIN_CAP) { atomicAdd(&(bar)[XB_TMO], 1u); break; } } } } while (0)

struct XcdBarrier {
    unsigned* bar; unsigned x;
    volatile LAS unsigned* st;
};

__device__ __forceinline__ XcdBarrier xcd_barrier_post(unsigned* bar, volatile LAS unsigned* st) {
    XcdBarrier b; b.bar = bar; b.x = xb_xcc_id(); b.st = st;
    if (threadIdx.x == 0) (void)xb_add(&bar[XB_XCNT(b.x)], 1u);
    return b;
}
__device__ __forceinline__ void xcd_barrier_complete(unsigned* bar, unsigned x, unsigned& nloc, unsigned& nx) {
    const unsigned G = gridDim.x * gridDim.y * gridDim.z;
    unsigned sum, cnt, mine, sp = 0u;
    for (;;) {
        sum = 0u; cnt = 0u; mine = 0u;
#pragma unroll
        for (unsigned j = 0; j < 16; ++j) { const unsigned c = xb_ld(&bar[XB_XCNT(j)]); sum += c; cnt += (c > 0u) ? 1u : 0u; mine = (j == x) ? c : mine; }
        if (sum == G) break;
        __builtin_amdgcn_s_sleep(1);
        if ((++sp & 255u) == 0u) { if (xb_ld(&bar[XB_TMO])) break; if (sp > XB_SPIN_CAP) { atomicAdd(&bar[XB_TMO], 1u); break; } }
    }
    nloc = mine > 0u ? mine : 1u; nx = cnt > 0u ? cnt : 1u;
}

__device__ __forceinline__ void xcd_barrier(const XcdBarrier& b) {
    asm volatile("s_waitcnt vmcnt(0)" ::: "memory");
    __syncthreads();
    if (threadIdx.x == 0) {
        unsigned* bar = b.bar;
        __builtin_amdgcn_s_waitcnt(0);
        unsigned nloc = b.st[0], nx = b.st[1];
        if (nloc == 0u) { xcd_barrier_complete(bar, b.x, nloc, nx); b.st[0] = nloc; b.st[1] = nx; }
        const unsigned old = xb_add(&bar[XB_XSUB(b.x)], 1u);
        const unsigned gen = old / nloc;
        if (old + 1u == (gen + 1u) * nloc) {
            __builtin_amdgcn_fence(__ATOMIC_RELEASE, "agent");
            asm volatile("s_waitcnt vmcnt(0)" ::: "memory");
            const unsigned og = xb_add(&bar[XB_TOP], 1u);
            const unsigned tg = og / nx;
            if (og + 1u == (tg + 1u) * nx) xb_add(&bar[XB_TOPGEN], 1u);
            else XB_SPIN(xb_ld(&bar[XB_TOPGEN]) == tg, bar);
            __builtin_amdgcn_fence(__ATOMIC_ACQUIRE, "agent");
            xb_add(&bar[XB_XGEN(b.x)], 1u);
            asm volatile("s_waitcnt vmcnt(0)" ::: "memory");
        } else {
            XB_SPIN(xb_ld(&bar[XB_XGEN(b.x)]) == gen, bar);
            __builtin_amdgcn_fence(__ATOMIC_ACQUIRE, "agent");
            asm volatile("s_waitcnt vmcnt(0)" ::: "memory");
        }
    }
    __syncthreads();
}

#ifndef STOP_AT
#define STOP_AT 0
#endif
#define DUMP_BF16(src, ncol_src, coff) do { xcd_barrier(bar); for (size_t i_ = (size_t)bid * NTHR + threadIdx.x; i_ < (size_t)M * D; i_ += (size_t)G * NTHR) { const size_t r_ = i_ >> 10, c_ = i_ & 1023; out[i_] = bf1((src)[r_ * (ncol_src) + (coff) + c_]); } return; } while (0)
#ifndef GMLP_DBG
#define GMLP_DBG 0
#endif
#ifndef DUP_GEMM
#define DUP_GEMM 0
#endif
#ifndef DUP_MASK
#define DUP_MASK 0
#endif
#ifndef SEAM_REPEAT
#define SEAM_REPEAT 1
#endif
#define SEAM() xcd_barrier(bar)
struct Args { const float* in[17]; float* out; unsigned char* ws; int ph_lo, ph_hi; };
__global__ void __launch_bounds__(NTHR, 2) fwd_megakernel(Args args) {
    extern __shared__ __attribute__((aligned(16))) unsigned char lds_raw[];
    cg::grid_group grid = cg::this_grid();
    LAS unsigned char* lds = (LAS unsigned char*)lds_raw;
    const int G = gridDim.x, bid = blockIdx.x, ngw = G * NWAVES;
    volatile LAS unsigned* MISC = (volatile LAS unsigned*)(lds + LDS_MISC_OFF);
    if (threadIdx.x < 16) MISC[threadIdx.x] = 0u;
    __syncthreads();
    XcdBarrier bar = xcd_barrier_post((unsigned*)(args.ws) + CW_BAR, MISC);
    grid.sync();
#define PHASE_IDS() int tid = threadIdx.x; asm volatile("" : "+v"(tid)); const int lane = tid & 63, wave = __builtin_amdgcn_readfirstlane(tid >> 6), gw = bid * NWAVES + wave; (void)lane; (void)gw
    unsigned char* ws = args.ws;
    const float* x = args.in[0];
    float* out = args.out;
    bf16* Wm = (bf16*)(ws + WS_WM);
    float* dec_g = (float*)(ws + WS_DEC);
    bf16* zb = (bf16*)(ws + WS_Z); bf16* f1 = (bf16*)(ws + WS_F1); bf16* ab = (bf16*)(ws + WS_AB); bf16* qe_g = (bf16*)(ws + WS_QE);
    bf16* yb = (bf16*)(ws + WS_Y); bf16* sp_g = (bf16*)(ws + WS_SP); bf16* oi_g = (bf16*)(ws + WS_OI); bf16* mmb = (bf16*)(ws + WS_MM); bf16* upd_g = (bf16*)(ws + WS_UPD);

    float* M32 = (float*)(ws + WS_HP); float* Y32 = M32 + 16 * 1024; float* F1_32 = Y32 + 16 * 1024; float* F32o = F1_32 + 16 * 4096; float* AB32 = F32o + 16 * 1024; float* HPP = (float*)(ws + WS_HP + 2 * MiB); float* HPU = (float*)(ws + WS_HP + 11 * MiB); float* YH32 = (float*)(ws + WS_HP + 1 * MiB); float* QKVG32 = YH32 + 16 * 1024; float* MIXP = (float*)(ws + WS_HP + 12 * MiB); float* ZUP = (float*)(ws + WS_HP + 13 * MiB);
    {
        PHASE_IDS();
        LAS float* scr = (LAS float*)(lds + wave * 16384);
        constexpr int I_IN = 16 * 80, I_OUT = 16 * 32, I_1 = 16 * 128, I_2 = 64 * 32, I_G = 512, I_L = I_IN + I_OUT + I_1 + I_2 + I_G;
        for (int it = gw; it < DEPTH * I_L; it += ngw) {
            const int l = it / I_L; int r = it % I_L;
            bf16* WinT = (bf16*)(ws + WS_W + l * W_LAYER_B); bf16* WoutT = (bf16*)(ws + WS_W + l * W_LAYER_B + W_IN_B); bf16* W1T = (bf16*)(ws + WS_W + l * W_LAYER_B + W_IN_B + W_OUT_B); bf16* W2T = (bf16*)(ws + WS_W + l * W_LAYER_B + W_IN_B + W_OUT_B + W_1_B);
            const float* w_in = args.in[2] + (size_t)l * D * D_IN; const float* pre_g = args.in[1] + l * D;
            if (r < I_IN) { p0_transpose_item(w_in, D_IN, 2560, D, WinT, pre_g, ZQ, ZK, scr, r, lane); continue; } r -= I_IN;
            if (r < I_OUT) { p0_transpose_item(args.in[11] + (size_t)l * D * D, D, D, D, WoutT, nullptr, 0, 0, scr, r, lane); continue; } r -= I_OUT;
            if (r < I_1) { p0_transpose_item(args.in[14] + (size_t)l * D * FF, FF, FF, D, W1T, args.in[13] + l * D, 0, 0, scr, r, lane); continue; } r -= I_1;
            if (r < I_2) { p0_transpose_item(args.in[15] + (size_t)l * FF * D, D, D, FF, W2T, nullptr, 0, 0, scr, r, lane); continue; } r -= I_2;
            p0_gate_item(w_in, args.in[8] + (size_t)l * 16 * 256, pre_g, WinT, r, lane);
        }
        const float* wsrc = args.in[5];
        for (int i = bid * NTHR + tid; i < DEPTH * 4 * 128 * 128; i += G * NTHR) { const int ii = (i >> 7) & 127, jj = i & 127; Wm[i] = ((ii >> 6) >= (jj >> 6)) ? (bf16)f2bf(wsrc[i]) : (bf16)0; }
        rows_phase(lds + wave * 16384, x, nullptr, nullptr, nullptr, yb, gw, ngw, lane, nullptr, YH32, args.in[1]);
    }
    SEAM();

#pragma unroll 1
    for (int l = 0; l < DEPTH; ++l) {
        const bf16* WinT = (const bf16*)(ws + WS_W + l * W_LAYER_B); const bf16* WoutT = (const bf16*)(ws + WS_W + l * W_LAYER_B + W_IN_B);
        const bf16* W1T = (const bf16*)(ws + WS_W + l * W_LAYER_B + W_IN_B + W_OUT_B); const bf16* W2T = (const bf16*)(ws + WS_W + l * W_LAYER_B + W_IN_B + W_OUT_B + W_1_B);
        { PHASE_IDS(); pg8::Gemm gm{yb, WinT, M, NZ, D}; pg8::StaticOrder S; S.init(M, NZ, G, bid); pg8::EpiAct<1> E{zb, NZ, 4};
          pg8::gemm_phase<pg8::EpiAct<1>, pg8::StaticOrder, true, true>(lds, gm, S, E, tid);
          hp_gemv_phase<0>(lds, YH32, D, args.in[2] + (size_t)l * D * D_IN + ZQ, D_IN, 1536, QKVG32, G, (G == 256) ? ((bid + 128) & 255) : bid, wave, lane, tid); }
        SEAM();
        if (STOP_AT == 1) DUMP_BF16(zb, NZ, 0);
        if (STOP_AT == 2) DUMP_BF16(zb, NZ, 1792);
        if (STOP_AT == 30) {
            const int lane_ = threadIdx.x & 63, wave_ = threadIdx.x >> 6;
            for (int u = bid; u < M / 128; u += G)
                for (int t_ = 0; t_ < 16; ++t_) { const size_t row_ = (size_t)u * 128 + 16 * wave_ + t_;
                    *(v4u*)(ab + row_ * D + 8 * lane_) = *(const v4u*)(zb + row_ * NZ + ZV + 8 * lane_); }
            xcd_barrier(bar); for (size_t i_ = (size_t)bid * NTHR + threadIdx.x; i_ < (size_t)M * D; i_ += (size_t)G * NTHR) { const size_t r_ = i_ >> 10, c_ = i_ & 511; out[i_] = bf1(ab[r_ * D + c_]); } return; }
        { PHASE_IDS();
        for (int u = bid; u < M / 128; u += G)
            gmlp_unit(lds, AB32, zb, ab, Wm + (size_t)l * 4 * 16384, args.in[3] + l * 512, args.in[4] + l * 512, args.in[6] + l * 512, args.in[7] + l * 512, u, tid);
        if (STOP_AT == 14) { xcd_barrier(bar); for (size_t i_ = (size_t)bid * NTHR + threadIdx.x; i_ < (size_t)M * D; i_ += (size_t)G * NTHR) { out[i_] = bf1(Wm[i_ & 262143]); } return; }
        if (STOP_AT >= 20 && STOP_AT < 24) { xcd_barrier(bar); for (size_t i_ = (size_t)bid * NTHR + threadIdx.x; i_ < (size_t)M * D; i_ += (size_t)G * NTHR) { const size_t r_ = i_ >> 10, c_ = i_ & 127; out[i_] = bf1(ab[r_ * D + (STOP_AT - 20) * 128 + c_]); } return; }
        if (STOP_AT == 13) { xcd_barrier(bar); for (size_t i_ = (size_t)bid * NTHR + threadIdx.x; i_ < (size_t)M * D; i_ += (size_t)G * NTHR) { const size_t r_ = i_ >> 10, c_ = i_ & 511; out[i_] = bf1(ab[r_ * D + c_]); } return; }
        }
        { PHASE_IDS();
        for (int t = bid; t < 256; t += G) gmlp_hp1(lds, l == 0 ? x : out, args.in[2] + (size_t)l * D * D_IN, args.in[1] + l * D, HPP, HPU, t >> 6, (t >> 2) & 15, t & 3, tid);
        }
        { PHASE_IDS();
        for (int ui = 0; ui * G < NCHUNK * 4; ++ui) { const int u = (G == 256) ? (256 * ui + ((bid + 4 * ui) & 255)) : (ui * G + bid); if (u >= NCHUNK * 4) break;
            gla1_unit(lds, QKVG32, args.in[2] + (size_t)l * D * D_IN, args.in[1] + l * D, args.in[10] + l * 512, AB32, zb, args.in[9] + l * 256, qe_g, oi_g, upd_g, dec_g, u, tid); } }
        SEAM();
        { PHASE_IDS(); gla_scan(upd_g, dec_g, sp_g, bid * NTHR + tid, G * NTHR); }
        { PHASE_IDS();
          for (int t = bid; t < 64; t += G) gmlp_hp2a(lds, l == 0 ? x : out, args.in[5] + (size_t)l * 4 * 16384, args.in[3] + l * 512, args.in[4] + l * 512, HPP, HPU, MIXP, ZUP, t >> 4, t & 15, tid); }
        SEAM();
        { PHASE_IDS();
        for (int pu = bid; pu < NCHUNK * 2; pu += G)
            gla3_unit(lds + wave * 1024, zb, qe_g, oi_g, sp_g, args.in[10] + l * 512, ab, 2 * pu + (wave >> 2), wave & 3, lane); }
        { PHASE_IDS();
          for (int b4 = bid; b4 < BATCH; b4 += G) gmlp_hp2b(lds, args.in[6] + l * 512, args.in[7] + l * 512, MIXP, ZUP, AB32, b4, tid); }
        SEAM();
        if (STOP_AT == 3) DUMP_BF16(ab, D, 0);
        if (STOP_AT == 8) { xcd_barrier(bar); for (size_t i_ = (size_t)bid * NTHR + threadIdx.x; i_ < (size_t)M * D; i_ += (size_t)G * NTHR) { const size_t r_ = i_ >> 10, c_ = i_ & 511; out[i_] = bf1(ab[r_ * D + c_]); } return; }
        if (STOP_AT == 9) { xcd_barrier(bar); for (size_t i_ = (size_t)bid * NTHR + threadIdx.x; i_ < (size_t)M * D; i_ += (size_t)G * NTHR) { const size_t r_ = i_ >> 10, c_ = i_ & 511; out[i_] = bf1(ab[r_ * D + 512 + c_]); } return; }
        if (STOP_AT == 10) { xcd_barrier(bar); for (size_t i_ = (size_t)bid * NTHR + threadIdx.x; i_ < (size_t)M * D; i_ += (size_t)G * NTHR) { const size_t r_ = i_ >> 10, c_ = i_ & 511; out[i_] = bf1(oi_g[r_ * 512 + c_]); } return; }
        if (STOP_AT == 11) { xcd_barrier(bar); for (size_t i_ = (size_t)bid * NTHR + threadIdx.x; i_ < (size_t)M * D; i_ += (size_t)G * NTHR) { out[i_] = bf1(sp_g[i_ & (size_t)(2048 * 8192 - 1)]); } return; }
        if (STOP_AT == 12) { xcd_barrier(bar); for (size_t i_ = (size_t)bid * NTHR + threadIdx.x; i_ < (size_t)M * D; i_ += (size_t)G * NTHR) { out[i_] = upd_g[i_ & (size_t)(2048 * 8192 - 1)]; } return; }
        { PHASE_IDS(); pg8::Gemm gm{ab, WoutT, M, D, D}; pg8::StaticOrder S; S.init(M, D, G, bid); pg8::EpiAct<0> E{mmb, D, 0};
          pg8::gemm_phase<pg8::EpiAct<0>, pg8::StaticOrder, true, true>(lds, gm, S, E, tid);
          hp_gemv_phase<0>(lds, AB32, D, args.in[11] + (size_t)l * D * D, D, D, M32, G, bid, wave, lane, tid); }
        SEAM();
        if (STOP_AT == 4) DUMP_BF16(mmb, D, 0);
        { PHASE_IDS(); rows_phase(lds + wave * 1024, l == 0 ? x : out, mmb, args.in[12] + l * D, nullptr, yb, gw, ngw, lane, M32, Y32, args.in[13] + l * D); }
        SEAM();
        if (STOP_AT == 5) DUMP_BF16(yb, D, 0);
        { PHASE_IDS(); pg8::Gemm gm{yb, W1T, M, FF, D}; pg8::StaticOrder S; S.init(M, FF, G, bid); pg8::EpiAct<2> E{f1, FF, 0};
          pg8::gemm_phase<pg8::EpiAct<2>, pg8::StaticOrder, true, true>(lds, gm, S, E, tid);
          hp_gemv_phase<2>(lds, Y32, D, args.in[14] + (size_t)l * D * FF, FF, FF, F1_32, G, bid, wave, lane, tid); }
        SEAM();
        { PHASE_IDS(); pg8::Gemm gm{f1, W2T, M, D, FF}; pg8::StaticOrder S; S.init(M, D, G, bid); pg8::EpiAct<0> E{yb, D, 0};
          pg8::gemm_phase<pg8::EpiAct<0>, pg8::StaticOrder, true, true>(lds, gm, S, E, tid);
          hp_gemv_phase<0>(lds, F1_32, FF, args.in[15] + (size_t)l * FF * D, D, D, F32o, G, bid, wave, lane, tid); }
        SEAM();
        if (STOP_AT == 6) DUMP_BF16(mmb, D, 0);
        if (STOP_AT == 7) DUMP_BF16(f1, FF, 0);
        { PHASE_IDS(); rows_phase(lds + wave * 1024, l == 0 ? x : out, mmb, args.in[12] + l * D, out, (l + 1 < DEPTH) ? yb : nullptr, gw, ngw, lane, M32, YH32, args.in[1] + (l + 1 < DEPTH ? l + 1 : l) * D, yb, args.in[16] + l * D, F32o); }
        if (l + 1 < DEPTH) SEAM();
    }
}

extern "C" void kernel_launch(void* const* d_in, const int* in_sizes, int n_in, void* d_out, int out_size, void* d_ws, size_t ws_size, hipStream_t stream) {
    static int grid = 0;
    if (grid == 0) {
        if (n_in != 17 || out_size != M * D || ws_size < WS_END) { fprintf(stderr, "kernel_launch: unexpected problem (n_in %d, out %d, ws %zu)\n", n_in, out_size, ws_size); grid = -1; return; }
        int dev = 0, cus = 0, per_cu = 0;
        hipGetDevice(&dev); hipDeviceGetAttribute(&cus, hipDeviceAttributeMultiprocessorCount, dev);
        hipFuncSetAttribute((const void*)fwd_megakernel, hipFuncAttributeMaxDynamicSharedMemorySize, LDS_BYTES);
        if (hipOccupancyMaxActiveBlocksPerMultiprocessor(&per_cu, (const void*)fwd_megakernel, NTHR, LDS_BYTES) != hipSuccess || per_cu < 1) per_cu = 1;
        (void)hipGetLastError();
        grid = cus * per_cu;
    }
    if (grid < 0) return;
    if (hipMemsetAsync(d_ws, 0, CTL_ZERO_BYTES, stream) != hipSuccess) { fprintf(stderr, "kernel_launch: memset failed\n"); return; }
    Args a{};
    for (int i = 0; i < 17; ++i) a.in[i] = (const float*)d_in[i];
    a.out = (float*)d_out; a.ws = (unsigned char*)d_ws; a.ph_lo = 0; a.ph_hi = 0;
    void* kargs[] = {&a};
    hipError_t e = hipLaunchCooperativeKernel((const void*)fwd_megakernel, dim3(grid), dim3(NTHR), kargs, LDS_BYTES, stream);
    if (e != hipSuccess) fprintf(stderr, "cooperative launch failed: %s (grid %d)\n", hipGetErrorString(e), grid);
}
```
